# Optimizing an MI355X kernel written in HIP

```python
import math
import jax, jax.numpy as jnp
from jax import lax
import numpy as np

D_MODEL = 2048
BATCH = 16
SEQ = 2048
DEPTH = 2

N_META = 16
ATTN_WIDTH = D_MODEL // 2
POOL_WIDTH = D_MODEL // 2
HEAD_DIM = 64
N_HEADS = ATTN_WIDTH // (2 * HEAD_DIM)
POOL_WINDOWS = (2, 4, 8, 16)
N_POOL_GROUPS = len(POOL_WINDOWS)
POOL_GROUP = POOL_WIDTH // N_POOL_GROUPS
D_FF = 256 * ((8 * D_MODEL // 3 + 255) // 256)
N_EXPERTS = 8
TOP_K = 2
ROPE_THETA = 10000.0
EPS = 1e-5
Q_BLOCK = 128
N_DENSE = (DEPTH + 1) // 2
N_MOE = DEPTH // 2
IN_COLS = 3 * ATTN_WIDTH + POOL_WIDTH + 2 * D_MODEL

kernel_name = "hybrid_diffattn_pool_moe_encoder"


def rmsnorm(x, g):
    xf = x.astype(jnp.float32)
    y = xf * lax.rsqrt(jnp.mean(xf * xf, axis=-1, keepdims=True) + EPS)
    return (y * g.astype(jnp.float32)).astype(x.dtype)


def rope(t, pos):
    half = HEAD_DIM // 2
    inv = ROPE_THETA ** (-2.0 * jnp.arange(half, dtype=jnp.float32) / HEAD_DIM)
    ang = pos.astype(jnp.float32)[:, None] * inv[None, :]
    cos = jnp.cos(ang)[None, :, None, :]
    sin = jnp.sin(ang)[None, :, None, :]
    tf = t.astype(jnp.float32)
    t1, t2 = tf[..., :half], tf[..., half:]
    return jnp.concatenate([t1 * cos - t2 * sin, t2 * cos + t1 * sin], axis=-1).astype(t.dtype)


def diff_attention(q, k, v, lam_full, lambda_init, subln_g):
    B, L = q.shape[0], q.shape[1]
    n_blocks = -(-L // Q_BLOCK)
    Lp = n_blocks * Q_BLOCK
    q = q * (HEAD_DIM ** -0.5)
    qp = jnp.pad(q, ((0, 0), (0, Lp - L), (0, 0), (0, 0)))
    qb = qp.reshape(B, n_blocks, Q_BLOCK, 2 * N_HEADS, HEAD_DIM).transpose(1, 0, 2, 3, 4)

    def one_block(qblk):
        s = jnp.einsum('bqhd,bkhd->bhqk', qblk, k, preferred_element_type=jnp.float32)
        p = jax.nn.softmax(s, axis=-1).reshape(B, N_HEADS, 2, Q_BLOCK, L)
        w = p[:, :, 0] - lam_full * p[:, :, 1]
        return jnp.einsum('bhqk,bkhe->bqhe', w.astype(v.dtype), v)

    o = lax.map(one_block, qb)
    o = o.transpose(1, 0, 2, 3, 4).reshape(B, Lp, N_HEADS, 2 * HEAD_DIM)[:, :L]
    o = rmsnorm(o, subln_g) * (1.0 - lambda_init)
    return o.reshape(B, L, ATTN_WIDTH)


def pool_mixer(u, pool_w, pool_scale):
    B, L, C = u.shape
    uf = u.astype(jnp.float32)
    cs = jnp.concatenate([jnp.zeros((B, 1, C), jnp.float32), jnp.cumsum(uf, axis=1)], axis=1)
    pos = jnp.arange(L)
    outs = []
    for gi, w in enumerate(POOL_WINDOWS):
        lo = jnp.clip(pos - w // 2, 0, L)
        hi = jnp.clip(pos + w // 2, 0, L)
        cs_g = cs[:, :, gi * POOL_GROUP:(gi + 1) * POOL_GROUP]
        win_sum = jnp.take(cs_g, hi, axis=1) - jnp.take(cs_g, lo, axis=1)
        cnt = (hi - lo).astype(jnp.float32)[None, :, None]
        outs.append(win_sum / cnt - uf[:, :, gi * POOL_GROUP:(gi + 1) * POOL_GROUP])
    m = jnp.stack(outs, axis=2)
    y = jnp.einsum('blgc,gce->blge', m, pool_w.astype(jnp.float32)).reshape(B, L, C)
    return (y * pool_scale.astype(jnp.float32)).astype(u.dtype)


def token_mixer(h, pos, layer_idx, w_in, b_gate, lam_q1, lam_k1, lam_q2, lam_k2, subln_g,
                pool_w, pool_scale, w_br_attn, w_br_pool, w_out):
    B, L, _ = h.shape
    z = h @ w_in
    A, P, D = ATTN_WIDTH, POOL_WIDTH, D_MODEL
    q, k, v, u, gates = jnp.split(z, [A, 2 * A, 3 * A, 3 * A + P], axis=-1)
    q = rope(q.reshape(B, L, 2 * N_HEADS, HEAD_DIM), pos)
    k = rope(k.reshape(B, L, 2 * N_HEADS, HEAD_DIM), pos)
    v = v.reshape(B, L, N_HEADS, 2 * HEAD_DIM)
    lambda_init = 0.8 - 0.6 * math.exp(-0.3 * layer_idx)
    lam_full = (jnp.exp(jnp.sum(lam_q1.astype(jnp.float32) * lam_k1.astype(jnp.float32)))
                - jnp.exp(jnp.sum(lam_q2.astype(jnp.float32) * lam_k2.astype(jnp.float32)))
                + lambda_init)
    a = diff_attention(q, k, v, lam_full, lambda_init, subln_g)
    p = pool_mixer(u, pool_w, pool_scale)
    g = jax.nn.sigmoid(gates + b_gate)
    y = g[..., :D] * (a @ w_br_attn) + g[..., D:] * (p @ w_br_pool)
    return y @ w_out


def swiglu(t, wg, wu, wd):
    return (jax.nn.silu(t @ wg) * (t @ wu)) @ wd


def moe_swiglu(h, router, wg, wu, wd):
    B, L, D = h.shape
    t = h.reshape(B * L, D)
    logits = (t @ router).astype(jnp.float32)
    top_v, top_i = lax.top_k(logits, TOP_K)
    top_w = jax.nn.softmax(top_v, axis=-1)
    combine = jnp.sum(jax.nn.one_hot(top_i, N_EXPERTS, dtype=jnp.float32) * top_w[..., None], axis=1)
    out = jnp.zeros_like(t)
    for e in range(N_EXPERTS):
        out = out + combine[:, e:e + 1].astype(t.dtype) * swiglu(t, wg[e], wu[e], wd[e])
    return out.reshape(B, L, D)


def setup_inputs(seed: int = 0) -> dict:
    key = jax.random.key(seed)
    ks = jax.random.split(key, 24)
    f32 = jnp.float32
    nrm = lambda k, shape, s: jax.random.normal(k, shape, f32) * s
    gain = lambda k, shape: 1.0 + 0.02 * jax.random.normal(k, shape, f32)
    return {
        "x": nrm(ks[0], (BATCH, SEQ, D_MODEL), 1.0),
        "meta_tokens": nrm(ks[1], (N_META, D_MODEL), 1.0),
        "norm_mix": gain(ks[2], (DEPTH, D_MODEL)),
        "w_in": nrm(ks[3], (DEPTH, D_MODEL, IN_COLS), D_MODEL ** -0.5),
        "b_gate": nrm(ks[4], (DEPTH, 2 * D_MODEL), 0.02),
        "lambda_q1": nrm(ks[5], (DEPTH, HEAD_DIM), 0.1),
        "lambda_k1": nrm(ks[6], (DEPTH, HEAD_DIM), 0.1),
        "lambda_q2": nrm(ks[7], (DEPTH, HEAD_DIM), 0.1),
        "lambda_k2": nrm(ks[8], (DEPTH, HEAD_DIM), 0.1),
        "subln": gain(ks[9], (DEPTH, 2 * HEAD_DIM)),
        "pool_w": nrm(ks[10], (DEPTH, N_POOL_GROUPS, POOL_GROUP, POOL_GROUP), POOL_GROUP ** -0.5),
        "pool_scale": gain(ks[11], (DEPTH, POOL_WIDTH)),
        "w_branch_attn": nrm(ks[12], (DEPTH, ATTN_WIDTH, D_MODEL), ATTN_WIDTH ** -0.5),
        "w_branch_pool": nrm(ks[13], (DEPTH, POOL_WIDTH, D_MODEL), POOL_WIDTH ** -0.5),
        "w_out": nrm(ks[14], (DEPTH, D_MODEL, D_MODEL), D_MODEL ** -0.5),
        "norm_ffn": gain(ks[15], (DEPTH, D_MODEL)),
        "dense_w_gate": nrm(ks[16], (N_DENSE, D_MODEL, D_FF), D_MODEL ** -0.5),
        "dense_w_up": nrm(ks[17], (N_DENSE, D_MODEL, D_FF), D_MODEL ** -0.5),
        "dense_w_down": nrm(ks[18], (N_DENSE, D_FF, D_MODEL), D_FF ** -0.5),
        "router": nrm(ks[19], (N_MOE, D_MODEL, N_EXPERTS), D_MODEL ** -0.5),
        "moe_w_gate": nrm(ks[20], (N_MOE, N_EXPERTS, D_MODEL, D_FF), D_MODEL ** -0.5),
        "moe_w_up": nrm(ks[21], (N_MOE, N_EXPERTS, D_MODEL, D_FF), D_MODEL ** -0.5),
        "moe_w_down": nrm(ks[22], (N_MOE, N_EXPERTS, D_FF, D_MODEL), D_FF ** -0.5),
        "norm_final": gain(ks[23], (D_MODEL,)),
    }


def reference(x, meta_tokens, norm_mix, w_in, b_gate, lambda_q1, lambda_k1, lambda_q2, lambda_k2,
              subln, pool_w, pool_scale, w_branch_attn, w_branch_pool, w_out, norm_ffn,
              dense_w_gate, dense_w_up, dense_w_down, router, moe_w_gate, moe_w_up, moe_w_down,
              norm_final):
    B = x.shape[0]
    meta = jnp.broadcast_to(meta_tokens[None].astype(x.dtype), (B, N_META, D_MODEL))
    h_res = jnp.concatenate([meta, x], axis=1)
    L = h_res.shape[1]
    pos = jnp.arange(L)
    for i in range(DEPTH):
        h = rmsnorm(h_res, norm_mix[i])
        h_res = h_res + token_mixer(h, pos, i, w_in[i], b_gate[i], lambda_q1[i], lambda_k1[i],
                                    lambda_q2[i], lambda_k2[i], subln[i], pool_w[i], pool_scale[i],
                                    w_branch_attn[i], w_branch_pool[i], w_out[i])
        h = rmsnorm(h_res, norm_ffn[i])
        if i % 2 == 0:
            j = i // 2
            h_res = h_res + swiglu(h, dense_w_gate[j], dense_w_up[j], dense_w_down[j])
        else:
            j = i // 2
            h_res = h_res + moe_swiglu(h, router[j], moe_w_gate[j], moe_w_up[j], moe_w_down[j])
    out = rmsnorm(h_res, norm_final)
    return out[:, N_META:]
```

```cpp
#include <hip/hip_runtime.h>
#include <cstdio>
#include <cstdint>

#ifndef MK_ONE_LAUNCH
#define MK_ONE_LAUNCH 1
#endif
#ifndef MK_REP_P0
#define MK_REP_P0 1
#endif
#ifndef MK_REP_P5
#define MK_REP_P5 1
#endif
#ifndef MK_REP_ATT
#define MK_REP_ATT 1
#endif
#ifndef MK_REP_M
#define MK_REP_M 1
#endif
#ifndef MK_REP_P1
#define MK_REP_P1 1
#endif
#ifndef MK_REP_P3
#define MK_REP_P3 1
#endif
#ifndef MK_REP_N1
#define MK_REP_N1 1
#endif
#ifndef MK_REP_P4
#define MK_REP_P4 1
#endif
#ifndef MK_REP_P6
#define MK_REP_P6 1
#endif
#ifndef MK_REP_MUP
#define MK_REP_MUP 1
#endif
#ifndef MK_F8_DENSE
#define MK_F8_DENSE 1
#endif
#ifndef MK_REP_MOE
#define MK_REP_MOE 1
#endif
#ifndef MK_HRES16
#define MK_HRES16 1
#endif
#ifndef MK_REP_EPI
#define MK_REP_EPI 1
#endif
#ifndef MK_PROBE_META
#define MK_PROBE_META 0
#endif
#ifndef MK_PROBE_BUF
#define MK_PROBE_BUF 0
#endif
#ifndef MK_LAST_PHASE
#define MK_LAST_PHASE 17
#endif

#define LAS __attribute__((address_space(3)))
#define GAS __attribute__((address_space(1)))
typedef unsigned short bf16_t;
typedef short bf16x8 __attribute__((ext_vector_type(8)));
typedef short s16x4 __attribute__((ext_vector_type(4)));
typedef float f32x2 __attribute__((ext_vector_type(2)));
typedef float f32x4 __attribute__((ext_vector_type(4)));
typedef float f32x16 __attribute__((ext_vector_type(16)));
typedef unsigned u32x2 __attribute__((ext_vector_type(2)));
typedef unsigned u32x4 __attribute__((ext_vector_type(4)));

constexpr int NB = 16, SEQ = 2048, NMETA = 16, LTOK = SEQ + NMETA, DM = 2048;
constexpr int T = NB * LTOK;
constexpr int TX = NB * SEQ;
constexpr int NPAN = T / 256;
constexpr int AW = 1024, NH = 8, DFF = 5632, NE = 8, INC = 8192;
constexpr int NHID2 = 2 * DFF;
constexpr float EPS = 1e-5f;
constexpr float LOG2E = 1.4426950408889634f;
constexpr float QSCALE = 0.125f * LOG2E;
constexpr int MOE_MAXPAN = 264, MOE_MAXROWS = MOE_MAXPAN * 256;
constexpr int NWAVES = 8;

__device__ __forceinline__ int row_pos(int r) { return r < TX ? NMETA + (r & (SEQ - 1)) : ((r - TX) & (NMETA - 1)); }
__device__ __forceinline__ int row_batch(int r) { return r < TX ? (r >> 11) : ((r - TX) >> 4); }
__device__ __forceinline__ int row_of(int b, int pos) { return pos < NMETA ? TX + b * NMETA + pos : b * SEQ + pos - NMETA; }

constexpr size_t MiB = 1u << 20;
constexpr size_t WS_CTL = 0, CTL_ZERO_BYTES = 1 * MiB;
constexpr size_t WS_ROPE = 1 * MiB;
constexpr size_t WS_TOKE = 2 * MiB, WS_TOKS = 2 * MiB + 320 * 1024, WS_TOKW = 2 * MiB + 640 * 1024;
constexpr size_t WS_ROWL = 3 * MiB, WS_ROWW = 3 * MiB + 320 * 1024;
constexpr size_t WS_WIN = 5 * MiB;
constexpr size_t WS_WBA = 69 * MiB;
constexpr size_t WS_WC = 77 * MiB;
constexpr size_t WS_WOUT = 85 * MiB;
constexpr size_t WS_DWGU = 101 * MiB;
constexpr size_t WS_DWD = 145 * MiB;
constexpr size_t WS_MWGU = 167 * MiB;
constexpr size_t WS_MWD = 519 * MiB;
constexpr size_t WS_HRES = 695 * MiB;
constexpr size_t WS_H = 953 * MiB;
constexpr size_t WS_Z = 1082 * MiB;
constexpr size_t ZSTEP = (size_t)T * 1024 * 2;
constexpr size_t WS_Q = WS_Z, WS_K = WS_Z + ZSTEP, WS_V = WS_Z + 2 * ZSTEP, WS_U = WS_Z + 3 * ZSTEP, WS_G = WS_Z + 4 * ZSTEP;
constexpr size_t WS_Y = WS_K;
constexpr size_t WS_HID = WS_Z;
constexpr size_t WS_OUT2A = WS_WIN, WS_OUT2B = WS_H;
static_assert(WS_OUT2A + (size_t)T * 2048 * 2 <= WS_MWGU, "OUT2A over dead weights");
constexpr size_t WS_H8S = WS_Z + 368 * MiB;
constexpr size_t WS_END = WS_Z + 8 * ZSTEP;
static_assert(WS_MWD + (size_t)8 * 2048 * 5632 * 2 <= WS_HRES && WS_HRES + (size_t)T * 2048 * 4 <= WS_H && WS_H + (size_t)T * 2048 * 2 <= WS_Z, "ws map");
static_assert((size_t)MOE_MAXROWS * DFF <= 368 * MiB && WS_H8S + (size_t)MOE_MAXROWS * DM <= WS_END && (size_t)T * DFF * 2 <= 8 * ZSTEP, "hidden / gathered rows fit Z"); static_assert((size_t)MOE_MAXROWS * 4 <= 320 * 1024, "row tables");
constexpr int CW_BAR = 4096;
constexpr int CW_CNT = 8192;

typedef __bf16 bf16x2_t __attribute__((ext_vector_type(2)));
__device__ __forceinline__ unsigned cvt_pk_bf16(float lo, float hi) { const f32x2 v = {lo, hi}; const bf16x2_t b = __builtin_convertvector(v, bf16x2_t); return __builtin_bit_cast(unsigned, b); }
__device__ __forceinline__ float bf_lo(unsigned u) { return __uint_as_float(u << 16); }
__device__ __forceinline__ float bf_hi(unsigned u) { return __uint_as_float(u & 0xffff0000u); }
__device__ __forceinline__ float shfl_xor_l(float v, int o, int lane) { return __int_as_float(__builtin_amdgcn_ds_bpermute((lane ^ o) << 2, __float_as_int(v))); }
__device__ __forceinline__ float wave_sum(float v, int lane) {
#pragma unroll
    for (int o = 1; o < 64; o <<= 1) v += shfl_xor_l(v, o, lane);
    return v;
}
__device__ __forceinline__ float fast_sigmoid(float x) { return __builtin_amdgcn_rcpf(1.0f + __builtin_amdgcn_exp2f(-x * LOG2E)); }
constexpr float F8_SA = 16.0f, F8_SW = 256.0f, F8_SH = 8.0f;
__device__ __forceinline__ float f8_clamp(float x) { return __builtin_fminf(__builtin_fmaxf(x, -448.0f), 448.0f); }
__device__ __forceinline__ unsigned cvt4_fp8(float a, float b, float c, float d) {
    int r = __builtin_amdgcn_cvt_pk_fp8_f32(f8_clamp(a), f8_clamp(b), 0, false); r = __builtin_amdgcn_cvt_pk_fp8_f32(f8_clamp(c), f8_clamp(d), r, true); return (unsigned)r; }
#define NT_STORE16(p, v) __builtin_nontemporal_store((v), (u32x4*)(p))
#define LDS_WAIT() asm volatile("s_waitcnt lgkmcnt(0)" ::: "memory")
#define VM_WAIT() asm volatile("s_waitcnt vmcnt(0)" ::: "memory")

namespace pg8 {
constexpr int BM = 256, BK = 64, HALF = 128, HTB = HALF * BK * 2, STAGE_BYTES = 8 * HTB, NXCD = 8, WGM = 8;
__host__ __device__ __forceinline__ int lds_byte(int r, int c) { const int st = (r >> 4) * 2 + (c >> 5), rr = r & 15, cc = c & 31, ob = rr * 64 + cc * 2; return st * 1024 + (ob ^ (((ob >> 9) & 1) << 5)); }
__host__ __device__ __forceinline__ void stage_rc(int b, int& R, int& C) { const int st = b / 1024, sb = b % 1024, swz = sb ^ (((sb >> 9) & 1) << 5); R = (st >> 1) * 16 + swz / 64; C = (st & 1) * 32 + (swz % 64) / 2; }
__host__ __device__ __forceinline__ int perm32(int rho) { const int n = rho >> 4, i = rho & 15; return 8 * (i >> 2) + 4 * n + (i & 3); }

struct Unit { const char* a; const char* b; int pm, pn, aux; };
template <class E, class = void> struct epi_chain { static constexpr bool value = false; };
template <class E> struct epi_chain<E, decltype((void)E::CHAIN)> { static constexpr bool value = E::CHAIN; };

struct TileOrder {
    int nM, nN, nwg, G, c, pnfast;
    __device__ __forceinline__ void init(int nM_, int nN_, int G_, int c_, int pnfast_ = 0) { nM = nM_; nN = nN_; nwg = nM * nN; G = G_; c = c_; pnfast = pnfast_; }
    __device__ __forceinline__ bool tile(int i, int& pm, int& pn) const { return tileL((long)i * G + c, pm, pn); }
    __device__ __forceinline__ bool tileL(const long L, int& pm, int& pn) const {
        if (L >= nwg) return false;
        int wgid = (int)L; { const int q = nwg / NXCD, r = nwg % NXCD, xcd = wgid % NXCD, off = wgid / NXCD; wgid = (xcd < r ? xcd * (q + 1) : r * (q + 1) + (xcd - r) * q) + off; }
        const int nig = WGM * nN, gid = wgid / nig, fm = gid * WGM, gsz = (nM - fm) < WGM ? (nM - fm) : WGM;
        if (pnfast) { pn = (wgid % nig) % nN; pm = fm + (wgid % nig) / nN; }
        else { pm = fm + ((wgid % nig) % gsz); pn = (wgid % nig) / gsz; }
        return true;
    }
};

typedef int i32x8 __attribute__((ext_vector_type(8)));
template <class Epi, class Sched, bool GATHER, bool F8 = false>
__device__ __forceinline__ void gemm_phase(LAS unsigned char* lds, const int nt, const int ldaB, const int ldbB, const Sched& S, const Epi& E) {
    int tid_ = threadIdx.x; asm volatile("" : "+v"(tid_));
    const int tid = tid_, wid = __builtin_amdgcn_readfirstlane(tid >> 6), lane = tid & 63, wr = wid >> 2, wc = wid & 3, fr = lane & 15, fq = lane >> 4;
    unsigned voffA[2], voffB[2]; int RA[2], CA[2];
#pragma unroll
    for (int i = 0; i < 2; ++i) { int R, C; stage_rc(tid * 16 + i * 8192, R, C); const int Rb = Epi::PERM ? ((R & ~31) + perm32(R & 31)) : R;
        voffA[i] = (unsigned)(R * ldaB + C * 2); voffB[i] = (unsigned)(Rb * ldbB + C * 2); RA[i] = R; CA[i] = C * 2; }
    const size_t kstep = (size_t)(BK * 2);
    const size_t hstepA = (size_t)HALF * ldaB, hstepB = (size_t)HALF * ldbB;
    const unsigned ldsw = (unsigned)wid * 1024u;
    const int aoff = lds_byte(wr * 64 + fr, fq * 8), boff = lds_byte(wc * 32 + fr, fq * 8);
    unsigned cO[2][2], nO[2][2], sO[2][2];
#define PG8_SA(b, h) (((b) * 2 + (h)) * HTB)
#define PG8_SB(b, h) ((4 + (b) * 2 + (h)) * HTB)
#define PG8_STAGE_B(bufoff, gbase) do { _Pragma("unroll") for (int _i = 0; _i < 2; ++_i) \
        __builtin_amdgcn_global_load_lds((const unsigned*)((const char*)(gbase) + voffB[_i]), (LAS unsigned*)(lds + (bufoff) + ldsw + _i * 8192), 16, 0, 0); } while (0)
#define PG8_STAGE_A(bufoff, gbase, h, O) do { _Pragma("unroll") for (int _i = 0; _i < 2; ++_i) { \
        const char* _p = GATHER ? ((const char*)(gbase) + (O)[h][_i]) : ((const char*)(gbase) + (size_t)(h) * hstepA + voffA[_i]); \
        __builtin_amdgcn_global_load_lds((const unsigned*)_p, (LAS unsigned*)(lds + (bufoff) + ldsw + _i * 8192), 16, 0, 0); } } while (0)
#define PG8_LD16(off) (*(const LAS u32x4*)(lds + (off)))
#define PG8_CAT(lo, hi) __builtin_bit_cast(i32x8, __builtin_shufflevector(lo, hi, 0, 1, 2, 3, 4, 5, 6, 7))
#define PG8_LDA(dst, b, h) do { _Pragma("unroll") for (int m = 0; m < 4; ++m) { if constexpr (F8) dst##8[m] = PG8_CAT(PG8_LD16(PG8_SA(b, h) + aoff + m * 2048), PG8_LD16(PG8_SA(b, h) + aoff + m * 2048 + 1024)); \
        else { _Pragma("unroll") for (int k = 0; k < 2; ++k) dst[m][k] = *(const LAS bf16x8*)(lds + PG8_SA(b, h) + aoff + m * 2048 + k * 1024); } } } while (0)
#define PG8_LDB(dst, b, h) do { _Pragma("unroll") for (int n = 0; n < 2; ++n) { if constexpr (F8) dst##8[n] = PG8_CAT(PG8_LD16(PG8_SB(b, h) + boff + n * 2048), PG8_LD16(PG8_SB(b, h) + boff + n * 2048 + 1024)); \
        else { _Pragma("unroll") for (int k = 0; k < 2; ++k) dst[n][k] = *(const LAS bf16x8*)(lds + PG8_SB(b, h) + boff + n * 2048 + k * 1024); } } } while (0)
#define PG8_MMA(ai, bj, At, Bt) do { __builtin_amdgcn_s_setprio(1); _Pragma("unroll") for (int m = 0; m < 4; ++m) _Pragma("unroll") for (int n = 0; n < 2; ++n) { \
        if constexpr (F8) asm volatile("v_mfma_scale_f32_16x16x128_f8f6f4 %0, %1, %2, %0, %3, %3 op_sel_hi:[0,0,0]" : "+v"(acc[ai][bj][m][n]) : "v"(Bt##8[n]), "v"(At##8[m]), "v"(f8one));   \
        else { _Pragma("unroll") for (int k = 0; k < 2; ++k) acc[ai][bj][m][n] = __builtin_amdgcn_mfma_f32_16x16x32_bf16(Bt[n][k], At[m][k], acc[ai][bj][m][n], 0, 0, 0); } } \
        __builtin_amdgcn_s_setprio(0); } while (0)
#define PG8_WAIT_V(n) asm volatile("s_waitcnt vmcnt(" #n ")" ::: "memory")
#define PG8_WAIT_L(n) asm volatile("s_waitcnt lgkmcnt(" #n ")" ::: "memory")
#define PG8_BAR __builtin_amdgcn_s_barrier()
#define PG8_SCHED __builtin_amdgcn_sched_barrier(0)
#define PG8_ROWS(dst, u) do { const int* _rw = S.rows(u); _Pragma("unroll") for (int _h = 0; _h < 2; ++_h) _Pragma("unroll") for (int _i = 0; _i < 2; ++_i) { \
        int _t = _rw[_h * HALF + RA[_i]]; _t = _t < 0 ? 0 : (_t >= T ? T - 1 : _t); dst[_h][_i] = (unsigned)_t * (unsigned)ldaB + (unsigned)CA[_i]; } } while (0)
    Unit cur, nxt; int ui = 0;
    if (!S.next(0, cur)) return;
    f32x4 acc[2][2][4][2];
#pragma unroll
    for (int a = 0; a < 2; ++a)
#pragma unroll
        for (int b = 0; b < 2; ++b)
#pragma unroll
            for (int m = 0; m < 4; ++m)
#pragma unroll
                for (int n = 0; n < 2; ++n) acc[a][b][m][n] = (f32x4){0.f, 0.f, 0.f, 0.f};
    int f8one = 0x7F7F7F7F; asm volatile("" : "+v"(f8one));
    bf16x8 At[4][2], B0[2][2], B1[2][2]; i32x8 At8[4], B08[2], B18[2];
    const char* cA = cur.a; const char* cB = cur.b;
    if constexpr (GATHER) { PG8_ROWS(cO, cur); }
    PG8_STAGE_B(PG8_SB(0, 0), cB); PG8_STAGE_B(PG8_SB(0, 1), cB + hstepB); PG8_STAGE_A(PG8_SA(0, 0), cA, 0, cO); PG8_STAGE_A(PG8_SA(0, 1), cA, 1, cO);
    if (wr == 1) PG8_BAR;
    PG8_WAIT_V(2); PG8_BAR;
    PG8_STAGE_B(PG8_SB(1, 0), cB + kstep); PG8_STAGE_A(PG8_SA(1, 0), cA + kstep, 0, cO); PG8_STAGE_B(PG8_SB(1, 1), cB + hstepB + kstep);
    PG8_WAIT_V(6); PG8_BAR;
    for (;;) {
        const bool has_next = S.next(ui + 1, nxt);
        const char* nA = has_next ? nxt.a : cA; const char* nB = has_next ? nxt.b : cB;
        if constexpr (GATHER) { if (has_next) { PG8_ROWS(nO, nxt); } else {
#pragma unroll
            for (int h = 0; h < 2; ++h)
#pragma unroll
                for (int i = 0; i < 2; ++i) nO[h][i] = cO[h][i]; } }
        for (int t = 0; t < nt; t += 2) {
            const bool last = (t == nt - 2);
            const char* a1 = cA + (size_t)(t + 1) * kstep;
            const char* a2 = last ? nA : cA + (size_t)(t + 2) * kstep; const char* b2 = last ? nB : cB + (size_t)(t + 2) * kstep;
            const char* a3 = a2 + kstep; const char* b3 = b2 + kstep;
            if constexpr (GATHER) {
#pragma unroll
                for (int h = 0; h < 2; ++h)
#pragma unroll
                    for (int i = 0; i < 2; ++i) sO[h][i] = last ? nO[h][i] : cO[h][i]; }
            PG8_LDB(B0, 0, 0); PG8_LDB(B1, 0, 1); PG8_SCHED; PG8_LDA(At, 0, 0); PG8_STAGE_A(PG8_SA(1, 1), a1, 1, cO);
            PG8_WAIT_V(8); PG8_WAIT_L(0); PG8_BAR; PG8_MMA(0, 0, At, B0); PG8_MMA(0, 1, At, B1); PG8_BAR; PG8_SCHED;
            PG8_LDA(At, 0, 1); PG8_STAGE_B(PG8_SB(0, 0), b2); PG8_STAGE_B(PG8_SB(0, 1), b2 + hstepB); PG8_STAGE_A(PG8_SA(0, 0), a2, 0, sO);
            PG8_WAIT_V(8); PG8_WAIT_L(0); PG8_BAR; PG8_MMA(1, 0, At, B0); PG8_MMA(1, 1, At, B1); PG8_BAR; PG8_SCHED;
            PG8_LDB(B0, 1, 0); PG8_LDB(B1, 1, 1); PG8_SCHED; PG8_LDA(At, 1, 0); PG8_STAGE_A(PG8_SA(0, 1), a2, 1, sO);
            PG8_WAIT_V(8); PG8_WAIT_L(0); PG8_BAR; PG8_MMA(0, 0, At, B0); PG8_MMA(0, 1, At, B1); PG8_BAR; PG8_SCHED;
            PG8_LDA(At, 1, 1); PG8_STAGE_B(PG8_SB(1, 0), b3); PG8_STAGE_B(PG8_SB(1, 1), b3 + hstepB); PG8_STAGE_A(PG8_SA(1, 0), a3, 0, sO);
            PG8_WAIT_V(8); PG8_WAIT_L(0); PG8_BAR; PG8_MMA(1, 0, At, B0); PG8_MMA(1, 1, At, B1); PG8_BAR; PG8_SCHED;
        }
        if (wr == 0) PG8_BAR;
        if constexpr (F8) asm volatile("s_nop 15\n\ts_nop 15" ::: "memory");
        bool keep = false;
        if constexpr (epi_chain<Epi>::value) { if (cur.aux == 0) { E.mid(acc, cur, wr, wc, fr, fq); keep = true; } else E(acc, cur, wr, wc, fr, fq); }
        else E(acc, cur, wr, wc, fr, fq);
        if (!has_next) break;
        if (!keep) {
#pragma unroll
        for (int a = 0; a < 2; ++a)
#pragma unroll
            for (int b = 0; b < 2; ++b)
#pragma unroll
                for (int m = 0; m < 4; ++m)
#pragma unroll
                    for (int n = 0; n < 2; ++n) acc[a][b][m][n] = (f32x4){0.f, 0.f, 0.f, 0.f}; }
        cur = nxt; cA = nA; cB = nB; ++ui;
        if constexpr (GATHER) {
#pragma unroll
            for (int h = 0; h < 2; ++h)
#pragma unroll
                for (int i = 0; i < 2; ++i) cO[h][i] = nO[h][i]; }
        if (wr == 1) PG8_BAR;
    }
    PG8_WAIT_V(0);
    PG8_BAR;
#undef PG8_SA
#undef PG8_SB
#undef PG8_STAGE_A
#undef PG8_STAGE_B
#undef PG8_LDA
#undef PG8_LDB
#undef PG8_MMA
#undef PG8_CAT
#undef PG8_LD16
#undef PG8_WAIT_V
#undef PG8_WAIT_L
#undef PG8_BAR
#undef PG8_SCHED
#undef PG8_ROWS
}
}

using pg8::Unit;
typedef f32x4 Acc[2][2][4][2];

struct EpiIn {
    static constexpr bool PERM = true;
    bf16_t *Q, *Kb, *V, *U, *G; const float* bgate; const float* rope;
    __device__ __forceinline__ void operator()(const Acc& acc, const Unit& u, int wr, int wc, int fr, int fq) const {
        const int row0 = u.pm * 256 + wr * 64 + fr;
        if (u.pn < 8) {
            bf16_t* base = u.pn < 4 ? Q : Kb; const float sc = u.pn < 4 ? QSCALE : 1.0f; const int ct = (u.pn & 3) * 256 + wc * 64 + 8 * fq;
            f32x4 cs[2][2][4];
#define ROPE_LD(bf, st) do { _Pragma("unroll") for (int g = 0; g < 2; ++g) { const int gi = (st) * 2 + g, row = row0 + (gi >> 2) * 128 + (gi & 3) * 16; const float* tb = rope + row_pos(row) * 64 + 8 * fq; \
                cs[bf][g][0] = *(const f32x4*)tb; cs[bf][g][1] = *(const f32x4*)(tb + 4); cs[bf][g][2] = *(const f32x4*)(tb + 32); cs[bf][g][3] = *(const f32x4*)(tb + 36); } } while (0)
#define ROPE_DO(bf, st) do { _Pragma("unroll") for (int g = 0; g < 2; ++g) { const int gi = (st) * 2 + g, ai = gi >> 2, m = gi & 3, row = row0 + ai * 128 + m * 16; \
                const f32x4 c0 = cs[bf][g][0], c1 = cs[bf][g][1], s0 = cs[bf][g][2], s1 = cs[bf][g][3]; \
                const f32x4 t1a = acc[ai][0][m][0], t1b = acc[ai][0][m][1], t2a = acc[ai][1][m][0], t2b = acc[ai][1][m][1]; \
                const f32x4 o1a = (t1a * c0 - t2a * s0) * sc, o1b = (t1b * c1 - t2b * s1) * sc, o2a = (t2a * c0 + t1a * s0) * sc, o2b = (t2b * c1 + t1b * s1) * sc; \
                u32x4 w1, w2; w1.x = cvt_pk_bf16(o1a[0], o1a[1]); w1.y = cvt_pk_bf16(o1a[2], o1a[3]); w1.z = cvt_pk_bf16(o1b[0], o1b[1]); w1.w = cvt_pk_bf16(o1b[2], o1b[3]); \
                w2.x = cvt_pk_bf16(o2a[0], o2a[1]); w2.y = cvt_pk_bf16(o2a[2], o2a[3]); w2.z = cvt_pk_bf16(o2b[0], o2b[1]); w2.w = cvt_pk_bf16(o2b[2], o2b[3]); \
                bf16_t* rp = base + (size_t)row * 1024 + ct; NT_STORE16(rp, w1); NT_STORE16(rp + 32, w2); } } while (0)
            ROPE_LD(0, 0); ROPE_LD(1, 1); __builtin_amdgcn_sched_barrier(0);
            ROPE_DO(0, 0); __builtin_amdgcn_sched_barrier(0); ROPE_LD(0, 2); __builtin_amdgcn_sched_barrier(0);
            ROPE_DO(1, 1); __builtin_amdgcn_sched_barrier(0); ROPE_LD(1, 3); __builtin_amdgcn_sched_barrier(0);
            ROPE_DO(0, 2); __builtin_amdgcn_sched_barrier(0); ROPE_DO(1, 3);
#undef ROPE_LD
#undef ROPE_DO
        } else if (u.pn < 16) {
            bf16_t* base = u.pn < 12 ? V : U; const int ct = (u.pn & 3) * 256 + wc * 32 + 8 * fq;
#pragma unroll
            for (int ai = 0; ai < 2; ++ai)
#pragma unroll
                for (int m = 0; m < 4; ++m) { bf16_t* rp = base + (size_t)(row0 + ai * 128 + m * 16) * 1024 + ct;
#pragma unroll
                    for (int bj = 0; bj < 2; ++bj) { const f32x4 v0 = acc[ai][bj][m][0], v1 = acc[ai][bj][m][1];
                        u32x4 w; w.x = cvt_pk_bf16(v0[0], v0[1]); w.y = cvt_pk_bf16(v0[2], v0[3]); w.z = cvt_pk_bf16(v1[0], v1[1]); w.w = cvt_pk_bf16(v1[2], v1[3]);
                        NT_STORE16(rp + bj * 128, w); } }
        } else {
            const int ct = (u.pn - 16) * 128 + wc * 32 + 8 * fq;
            float nba[8], nbp[8];
#pragma unroll
            for (int n = 0; n < 2; ++n) { const f32x4 a_ = *(const f32x4*)(bgate + ct + 4 * n), p_ = *(const f32x4*)(bgate + 2048 + ct + 4 * n);
#pragma unroll
                for (int j = 0; j < 4; ++j) { nba[n * 4 + j] = a_[j] * -LOG2E; nbp[n * 4 + j] = p_[j] * -LOG2E; } }
#pragma unroll
            for (int ai = 0; ai < 2; ++ai)
#pragma unroll
                for (int m = 0; m < 4; ++m) { bf16_t* rp = G + (size_t)(row0 + ai * 128 + m * 16) * 4096 + ct;
                    float ea[8], ep[8], sp[8];
#pragma unroll
                    for (int j = 0; j < 8; ++j) { ea[j] = __builtin_fmaf(acc[ai][0][m][j >> 2][j & 3], -LOG2E, nba[j]); ep[j] = __builtin_fmaf(acc[ai][1][m][j >> 2][j & 3], -LOG2E, nbp[j]); }
                    __builtin_amdgcn_sched_barrier(0);
#pragma unroll
                    for (int j = 0; j < 8; ++j) { ea[j] = __builtin_amdgcn_exp2f(ea[j]); ep[j] = __builtin_amdgcn_exp2f(ep[j]); }
                    __builtin_amdgcn_sched_barrier(0);
#pragma unroll
                    for (int j = 0; j < 8; ++j) { ea[j] += 1.0f; ep[j] += 1.0f; }
                    __builtin_amdgcn_sched_barrier(0);
#pragma unroll
                    for (int j = 0; j < 8; ++j) { ea[j] = __builtin_amdgcn_rcpf(ea[j]); sp[j] = __builtin_amdgcn_rcpf(ep[j]); }
                    __builtin_amdgcn_sched_barrier(0);
#pragma unroll
                    for (int j = 0; j < 8; ++j) ea[j] *= ep[j];
                    u32x4 w0, w1; w0.x = cvt_pk_bf16(ea[0], ea[1]); w0.y = cvt_pk_bf16(ea[2], ea[3]); w0.z = cvt_pk_bf16(ea[4], ea[5]); w0.w = cvt_pk_bf16(ea[6], ea[7]);
                    w1.x = cvt_pk_bf16(sp[0], sp[1]); w1.y = cvt_pk_bf16(sp[2], sp[3]); w1.z = cvt_pk_bf16(sp[4], sp[5]); w1.w = cvt_pk_bf16(sp[6], sp[7]);
                    NT_STORE16(rp, w0); NT_STORE16(rp + 2048, w1); }
        }
    }
};
struct SchedIn {
    pg8::TileOrder o; const char* A; const char* B;
    __device__ __forceinline__ bool next(int i, Unit& u) const { int pm, pn; if (!o.tile(i, pm, pn)) return false;
        u.pm = pm; u.pn = pn; u.aux = 0; u.a = A + (size_t)pm * 256 * 2048 * 2; u.b = B + (size_t)pn * 256 * 2048 * 2; return true; }
    __device__ __forceinline__ const int* rows(const Unit&) const { return nullptr; }
};

struct SchedInA {
    pg8::TileOrder o; const char* A; const char* B;
    __device__ __forceinline__ bool next(int i, Unit& u) const { int pm, pn;
        if (!o.tile(i, pm, pn)) { const long j = (long)i * o.G + o.c - o.nwg; if (j >= 32) return false; pm = NPAN - 1; pn = (int)j; }
        u.pm = pm; u.pn = pn; u.aux = 0; u.a = A + (size_t)pm * 256 * 2048 * 2; u.b = B + (size_t)pn * 256 * 2048 * 2; return true; }
    __device__ __forceinline__ const int* rows(const Unit&) const { return nullptr; }
};
struct SchedIn8 {
    pg8::TileOrder o; const char* A; const char* B;
    __device__ __forceinline__ bool next(int i, Unit& u) const { int pm, pn; long L;
        if (o.G == 256 && o.nwg == 2048) { if (o.c >= 32) { L = (long)i * 224 + (o.c - 32); if (L >= 2048 - 192) return false; } else { if (i >= 6) return false; L = 2048 - 192 + i * 32 + o.c; } }
        else L = (long)i * o.G + o.c;
        if (!o.tileL(L, pm, pn)) return false;
        u.pm = pm; u.pn = pn; u.aux = 0; u.a = A + (size_t)pm * 256 * 2048; u.b = B + (size_t)pn * 256 * 2048; return true; }
    __device__ __forceinline__ const int* rows(const Unit&) const { return nullptr; }
};
struct EpiGate8 {
    static constexpr bool PERM = true;
    bf16_t* G; const float* bgate;
    __device__ __forceinline__ void operator()(const Acc& acc, const Unit& u, int wr, int wc, int fr, int fq) const {
        const int row0 = u.pm * 256 + wr * 64 + fr, ct = u.pn * 128 + wc * 32 + 8 * fq; constexpr float NS = -LOG2E / (F8_SA * F8_SW);
        float nba[8], nbp[8];
#pragma unroll
        for (int n = 0; n < 2; ++n) { const f32x4 a_ = *(const f32x4*)(bgate + ct + 4 * n), p_ = *(const f32x4*)(bgate + 2048 + ct + 4 * n);
#pragma unroll
            for (int j = 0; j < 4; ++j) { nba[n * 4 + j] = a_[j] * -LOG2E; nbp[n * 4 + j] = p_[j] * -LOG2E; } }
#pragma unroll
        for (int ai = 0; ai < 2; ++ai)
#pragma unroll
            for (int m = 0; m < 4; ++m) { bf16_t* rp = G + (size_t)(row0 + ai * 128 + m * 16) * 4096 + ct;
                float ea[8], ep[8], sp[8];
#pragma unroll
                for (int j = 0; j < 8; ++j) { ea[j] = __builtin_fmaf(acc[ai][0][m][j >> 2][j & 3], NS, nba[j]); ep[j] = __builtin_fmaf(acc[ai][1][m][j >> 2][j & 3], NS, nbp[j]); }
                __builtin_amdgcn_sched_barrier(0);
#pragma unroll
                for (int j = 0; j < 8; ++j) { ea[j] = __builtin_amdgcn_exp2f(ea[j]); ep[j] = __builtin_amdgcn_exp2f(ep[j]); }
                __builtin_amdgcn_sched_barrier(0);
#pragma unroll
                for (int j = 0; j < 8; ++j) { ea[j] += 1.0f; ep[j] += 1.0f; }
                __builtin_amdgcn_sched_barrier(0);
#pragma unroll
                for (int j = 0; j < 8; ++j) { ea[j] = __builtin_amdgcn_rcpf(ea[j]); sp[j] = __builtin_amdgcn_rcpf(ep[j]); }
                __builtin_amdgcn_sched_barrier(0);
#pragma unroll
                for (int j = 0; j < 8; ++j) ea[j] *= ep[j];
                u32x4 w0, w1; w0.x = cvt_pk_bf16(ea[0], ea[1]); w0.y = cvt_pk_bf16(ea[2], ea[3]); w0.z = cvt_pk_bf16(ea[4], ea[5]); w0.w = cvt_pk_bf16(ea[6], ea[7]);
                w1.x = cvt_pk_bf16(sp[0], sp[1]); w1.y = cvt_pk_bf16(sp[2], sp[3]); w1.z = cvt_pk_bf16(sp[4], sp[5]); w1.w = cvt_pk_bf16(sp[6], sp[7]);
                NT_STORE16(rp, w0); NT_STORE16(rp + 2048, w1); }
    }
};

struct EpiY {
    static constexpr bool PERM = true, CHAIN = true;
    bf16_t* Y; const bf16_t* G;
    __device__ __forceinline__ void mid(Acc& acc, const Unit& u, int wr, int wc, int fr, int fq) const {
        const int row0 = u.pm * 256 + wr * 64 + fr, ct = u.pn * 256 + wc * 32 + 8 * fq;
        u32x4 g[2][4][2];
#pragma unroll
        for (int ai = 0; ai < 2; ++ai)
#pragma unroll
            for (int m = 0; m < 4; ++m)
#pragma unroll
                for (int bj = 0; bj < 2; ++bj) g[ai][m][bj] = *(const u32x4*)(G + (size_t)(row0 + ai * 128 + m * 16) * 4096 + ct + bj * 128);
        __builtin_amdgcn_sched_barrier(0);
#pragma unroll
        for (int ai = 0; ai < 2; ++ai)
#pragma unroll
            for (int m = 0; m < 4; ++m)
#pragma unroll
                for (int bj = 0; bj < 2; ++bj) { const u32x4 gg = g[ai][m][bj];
                    f32x4& v0 = acc[ai][bj][m][0]; f32x4& v1 = acc[ai][bj][m][1];
                    v0[0] *= bf_lo(gg.x); v0[1] *= bf_hi(gg.x); v0[2] *= bf_lo(gg.y); v0[3] *= bf_hi(gg.y); v1[0] *= bf_lo(gg.z); v1[1] *= bf_hi(gg.z); v1[2] *= bf_lo(gg.w); v1[3] *= bf_hi(gg.w); }
    }
    __device__ __forceinline__ void operator()(const Acc& acc, const Unit& u, int wr, int wc, int fr, int fq) const {
        const int row0 = u.pm * 256 + wr * 64 + fr, ct = u.pn * 256 + wc * 32 + 8 * fq;
        u32x4 g[2][4][2];
#pragma unroll
        for (int ai = 0; ai < 2; ++ai)
#pragma unroll
            for (int m = 0; m < 4; ++m)
#pragma unroll
                for (int bj = 0; bj < 2; ++bj) g[ai][m][bj] = *(const u32x4*)(G + (size_t)(row0 + ai * 128 + m * 16) * 4096 + 2048 + ct + bj * 128);
        __builtin_amdgcn_sched_barrier(0);
#pragma unroll
        for (int ai = 0; ai < 2; ++ai)
#pragma unroll
            for (int m = 0; m < 4; ++m) { const size_t row = (size_t)(row0 + ai * 128 + m * 16);
#pragma unroll
                for (int bj = 0; bj < 2; ++bj) { const u32x4 gg = g[ai][m][bj];
                    f32x4 v0 = acc[ai][bj][m][0], v1 = acc[ai][bj][m][1];
                    v0[0] *= bf_lo(gg.x); v0[1] *= bf_hi(gg.x); v0[2] *= bf_lo(gg.y); v0[3] *= bf_hi(gg.y); v1[0] *= bf_lo(gg.z); v1[1] *= bf_hi(gg.z); v1[2] *= bf_lo(gg.w); v1[3] *= bf_hi(gg.w);
                    u32x4 w; w.x = cvt_pk_bf16(v0[0], v0[1]); w.y = cvt_pk_bf16(v0[2], v0[3]); w.z = cvt_pk_bf16(v1[0], v1[1]); w.w = cvt_pk_bf16(v1[2], v1[3]);
                    *(u32x4*)(Y + row * 2048 + ct + bj * 128) = w; } }
    }
};
struct SchedY {
    pg8::TileOrder o; const char* A0; const char* A1; const char* B0; const char* B1;
    __device__ __forceinline__ bool next(int i, Unit& u) const { int pm, pn; if (!o.tile(i >> 1, pm, pn)) return false;
        u.pm = pm; u.pn = pn; u.aux = i & 1; u.a = ((i & 1) ? A1 : A0) + (size_t)pm * 256 * 1024 * 2; u.b = ((i & 1) ? B1 : B0) + (size_t)pn * 256 * 1024 * 2; return true; }
    __device__ __forceinline__ const int* rows(const Unit&) const { return nullptr; }
};

struct EpiRes {
    static constexpr bool PERM = false;
    float* HR; float sc;
    __device__ __forceinline__ void operator()(const Acc& acc, const Unit& u, int wr, int wc, int fr, int fq) const {
        const int row0 = u.pm * 256 + wr * 64 + fr, col0 = u.pn * 256 + wc * 32 + 4 * fq;
#pragma unroll
        for (int ai = 0; ai < 2; ++ai)
#pragma unroll
            for (int m = 0; m < 4; ++m) { float* rp = HR + (size_t)(row0 + ai * 128 + m * 16) * 2048 + col0;
#pragma unroll
                for (int bj = 0; bj < 2; ++bj)
#pragma unroll
                    for (int n = 0; n < 2; ++n) { f32x4* p = (f32x4*)(rp + bj * 128 + n * 16); *p = *p + acc[ai][bj][m][n] * sc; } }
    }
};
struct EpiDelta {
    static constexpr bool PERM = true;
    bf16_t* D; float sc;
    __device__ __forceinline__ void operator()(const Acc& acc, const Unit& u, int wr, int wc, int fr, int fq) const {
        const int row0 = u.pm * 256 + wr * 64 + fr, col0 = u.pn * 256 + wc * 32 + 8 * fq;
#pragma unroll
        for (int ai = 0; ai < 2; ++ai)
#pragma unroll
            for (int m = 0; m < 4; ++m) { bf16_t* rp = D + (size_t)(row0 + ai * 128 + m * 16) * 2048 + col0;
#pragma unroll
                for (int bj = 0; bj < 2; ++bj) { const f32x4 v0 = acc[ai][bj][m][0] * sc, v1 = acc[ai][bj][m][1] * sc;
                    u32x4 o; o.x = cvt_pk_bf16(v0[0], v0[1]); o.y = cvt_pk_bf16(v0[2], v0[3]); o.z = cvt_pk_bf16(v1[0], v1[1]); o.w = cvt_pk_bf16(v1[2], v1[3]);
                    NT_STORE16(rp + bj * 128, o); } }
    }
};
struct SchedPlain {
    pg8::TileOrder o; const char* A; const char* B; size_t astep, bstep;
    __device__ __forceinline__ bool next(int i, Unit& u) const { int pm, pn; if (!o.tile(i, pm, pn)) return false;
        u.pm = pm; u.pn = pn; u.aux = 0; u.a = A + (size_t)pm * astep; u.b = B + (size_t)pn * bstep; return true; }
    __device__ __forceinline__ const int* rows(const Unit&) const { return nullptr; }
};

struct EpiSwi {
    static constexpr bool PERM = true;
    bf16_t* HID;
    __device__ __forceinline__ void operator()(const Acc& acc, const Unit& u, int wr, int wc, int fr, int fq) const {
        const int row0 = u.pm * 256 + wr * 64 + fr, ct = u.pn * 128 + wc * 32 + 8 * fq;
#pragma unroll
        for (int ai = 0; ai < 2; ++ai)
#pragma unroll
            for (int m = 0; m < 4; ++m) { f32x4 h0, h1; const f32x4 g0 = acc[ai][0][m][0], g1 = acc[ai][0][m][1], u0 = acc[ai][1][m][0], u1 = acc[ai][1][m][1];
#pragma unroll
                for (int j = 0; j < 4; ++j) { h0[j] = g0[j] * fast_sigmoid(g0[j]) * u0[j]; h1[j] = g1[j] * fast_sigmoid(g1[j]) * u1[j]; }
                u32x4 w; w.x = cvt_pk_bf16(h0[0], h0[1]); w.y = cvt_pk_bf16(h0[2], h0[3]); w.z = cvt_pk_bf16(h1[0], h1[1]); w.w = cvt_pk_bf16(h1[2], h1[3]);
                *(u32x4*)(HID + (size_t)(row0 + ai * 128 + m * 16) * DFF + ct) = w; }
    }
};
struct EpiSwi8 {
    static constexpr bool PERM = true;
    unsigned char* HID8;
    __device__ __forceinline__ void operator()(const Acc& acc, const Unit& u, int wr, int wc, int fr, int fq) const {
        const int row0 = u.pm * 256 + wr * 64 + fr, ct = u.pn * 128 + wc * 32 + 8 * fq;
        constexpr float dq = 1.0f / (F8_SA * F8_SW), C = 1.0f / (dq * dq * F8_SH);
#pragma unroll
        for (int ai = 0; ai < 2; ++ai)
#pragma unroll
            for (int m = 0; m < 4; ++m) { float t[8], p[8];
#pragma unroll
                for (int j = 0; j < 8; ++j) t[j] = acc[ai][0][m][j >> 2][j & 3] * (-LOG2E * dq);
                __builtin_amdgcn_sched_barrier(0);
#pragma unroll
                for (int j = 0; j < 8; ++j) t[j] = __builtin_amdgcn_exp2f(t[j]);
#pragma unroll
                for (int j = 0; j < 8; ++j) p[j] = acc[ai][0][m][j >> 2][j & 3] * acc[ai][1][m][j >> 2][j & 3];
                __builtin_amdgcn_sched_barrier(0);
#pragma unroll
                for (int j = 0; j < 8; ++j) t[j] = __builtin_fmaf(t[j], C, C);
                __builtin_amdgcn_sched_barrier(0);
#pragma unroll
                for (int j = 0; j < 8; ++j) t[j] = __builtin_amdgcn_rcpf(t[j]);
                __builtin_amdgcn_sched_barrier(0);
#pragma unroll
                for (int j = 0; j < 8; ++j) p[j] *= t[j];
                u32x2 w; w.x = cvt4_fp8(p[0], p[1], p[2], p[3]); w.y = cvt4_fp8(p[4], p[5], p[6], p[7]);
                *(u32x2*)(HID8 + (size_t)(row0 + ai * 128 + m * 16) * DFF + ct) = w; }
    }
};
struct MoeMap { int pb[9]; };
__device__ __forceinline__ int moe_expert(const MoeMap& mm, int pm) { int e = 0;
#pragma unroll
    for (int j = 1; j < 8; ++j) e += (pm >= mm.pb[j]) ? 1 : 0;
    return e; }
struct SchedMoeUp {
    pg8::TileOrder o; const char* A; const char* B; MoeMap mm;
    __device__ __forceinline__ bool next(int i, Unit& u) const { int pm, pn; if (!o.tile(i, pm, pn)) return false;
        u.pm = pm; u.pn = pn; u.aux = 0; u.a = A + (size_t)pm * 256 * DM; u.b = B + (size_t)moe_expert(mm, pm) * ((size_t)NHID2 * DM) + (size_t)pn * 256 * DM; return true; }
    __device__ __forceinline__ const int* rows(const Unit&) const { return nullptr; }
};
struct SchedMoeDown {
    pg8::TileOrder o; const char* A; const char* B; MoeMap mm;
    __device__ __forceinline__ bool next(int i, Unit& u) const { int pm, pn; if (!o.tile(i, pm, pn)) return false;
        u.pm = pm; u.pn = pn; u.aux = 0; u.a = A + (size_t)pm * 256 * DFF; u.b = B + (size_t)moe_expert(mm, pm) * ((size_t)DM * DFF) + (size_t)pn * 256 * DFF; return true; }
    __device__ __forceinline__ const int* rows(const Unit&) const { return nullptr; }
};
struct EpiMoeDown {
    static constexpr bool PERM = true;
    bf16_t* O2A; bf16_t* O2B; const int* rowl; const float* roww; float sc;
    __device__ __forceinline__ void operator()(const Acc& acc, const Unit& u, int wr, int wc, int fr, int fq) const {
        const int row0 = u.pm * 256 + wr * 64 + fr, col0 = u.pn * 256 + wc * 32 + 8 * fq;
        int tvs[8]; float wvs[8];
#pragma unroll
        for (int i = 0; i < 8; ++i) { const int sr = row0 + (i >> 2) * 128 + (i & 3) * 16; tvs[i] = rowl[sr]; wvs[i] = roww[sr]; }
        __builtin_amdgcn_sched_barrier(0);
#pragma unroll
        for (int ai = 0; ai < 2; ++ai)
#pragma unroll
            for (int m = 0; m < 4; ++m) { const int tv = tvs[ai * 4 + m]; const int tok = tv & 0x3fffffff; const float w = wvs[ai * 4 + m] * sc;
                if (tv >= 0 && tok < T) { bf16_t* rp = ((tv >> 30) ? O2B : O2A) + (size_t)tok * 2048 + col0;
#pragma unroll
                    for (int bj = 0; bj < 2; ++bj) { const f32x4 v0 = acc[ai][bj][m][0] * w, v1 = acc[ai][bj][m][1] * w;
                        u32x4 o; o.x = cvt_pk_bf16(v0[0], v0[1]); o.y = cvt_pk_bf16(v0[2], v0[3]); o.z = cvt_pk_bf16(v1[0], v1[1]); o.w = cvt_pk_bf16(v1[2], v1[3]);
                        NT_STORE16(rp + bj * 128, o); } } }
    }
};

namespace att {
constexpr int SHM_V = 16384, SHM_K = 8192;
constexpr int OFF_V = 0, OFF_K = 32768, OFF_WS = 49152, OFF_ST = 51200, LDS_BYTES = OFF_ST + 65536;
constexpr int NT = 33;
constexpr float THR2 = 11.5f;
#define SBAR() __builtin_amdgcn_sched_barrier(0)
__device__ __forceinline__ int kswz(int row, int ch) { return row * 128 + ((ch ^ ((row >> 1) & 7)) << 4); }
__device__ __forceinline__ int crow(int r, int hi) { return (r & 3) + 8 * (r >> 2) + 4 * hi; }
__device__ __forceinline__ void partialSM(f32x16& p0, f32x16& p1, float& m_reg, float& alpha) {
    float pmax = p0[0];
#pragma unroll
    for (int r = 1; r < 16; ++r) pmax = fmaxf(pmax, p0[r]);
#pragma unroll
    for (int r = 0; r < 16; ++r) pmax = fmaxf(pmax, p1[r]);
    { auto rr = __builtin_amdgcn_permlane32_swap(__float_as_uint(pmax), __float_as_uint(pmax), false, false); pmax = fmaxf(__uint_as_float(rr[0]), __uint_as_float(rr[1])); }
    float mn;
    if (__builtin_expect(__all(pmax - m_reg <= THR2), 1)) { mn = m_reg; alpha = 1.f; }
    else { mn = fmaxf(m_reg, pmax); alpha = __builtin_amdgcn_exp2f(m_reg - mn); m_reg = mn; }
#pragma unroll
    for (int r = 0; r < 16; ++r) { p0[r] -= mn; p1[r] -= mn; }
#pragma unroll
    for (int r = 0; r < 16; ++r) p0[r] = __builtin_amdgcn_exp2f(p0[r]);
}
__device__ __forceinline__ void finishSM(f32x16& p0, f32x16& p1, float alpha, float& l_reg, bf16x8& pa0, bf16x8& pa1, bf16x8& pa2, bf16x8& pa3) {
#pragma unroll
    for (int r = 0; r < 16; ++r) p1[r] = __builtin_amdgcn_exp2f(p1[r]);
    float ps = 0;
#pragma unroll
    for (int r = 0; r < 16; ++r) ps += p0[r];
#pragma unroll
    for (int r = 0; r < 16; ++r) ps += p1[r];
    { auto rr = __builtin_amdgcn_permlane32_swap(__float_as_uint(ps), __float_as_uint(ps), false, false); ps = __uint_as_float(rr[0]) + __uint_as_float(rr[1]); }
    l_reg = l_reg * alpha + ps;
#define PK4(P, BASE, OUT) do { unsigned a0 = cvt_pk_bf16(P[BASE + 0], P[BASE + 1]), a1 = cvt_pk_bf16(P[BASE + 2], P[BASE + 3]);   \
    unsigned b0 = cvt_pk_bf16(P[BASE + 4], P[BASE + 5]), b1 = cvt_pk_bf16(P[BASE + 6], P[BASE + 7]);                              \
    auto r0 = __builtin_amdgcn_permlane32_swap(a0, b0, false, false); auto r1 = __builtin_amdgcn_permlane32_swap(a1, b1, false, false); \
    u32x4 w = {r0[0], r1[0], r0[1], r1[1]}; OUT = __builtin_bit_cast(bf16x8, w); } while (0)
    PK4(p0, 0, pa0); PK4(p0, 8, pa1); PK4(p1, 0, pa2); PK4(p1, 8, pa3);
#undef PK4
}
__device__ __forceinline__ void exp_first(f32x16& p0, f32x16& p1, float m_reg) {
#pragma unroll
    for (int r = 0; r < 16; ++r) { p0[r] -= m_reg; p1[r] -= m_reg; }
#pragma unroll
    for (int r = 0; r < 16; ++r) p0[r] = __builtin_amdgcn_exp2f(p0[r]);
}
__device__ __forceinline__ float exp_second_sum(f32x16& p0, f32x16& p1) {
#pragma unroll
    for (int r = 0; r < 16; ++r) p1[r] = __builtin_amdgcn_exp2f(p1[r]);
    float ps = 0;
#pragma unroll
    for (int r = 0; r < 16; ++r) ps += p0[r];
#pragma unroll
    for (int r = 0; r < 16; ++r) ps += p1[r];
    { auto rr = __builtin_amdgcn_permlane32_swap(__float_as_uint(ps), __float_as_uint(ps), false, false); ps = __uint_as_float(rr[0]) + __uint_as_float(rr[1]); }
    return ps;
}
__device__ __forceinline__ void pack_p(const f32x16& p0, const f32x16& p1, bf16x8& pa0, bf16x8& pa1, bf16x8& pa2, bf16x8& pa3) {
#define PK4(P, BASE, OUT) do { unsigned a0 = cvt_pk_bf16(P[BASE + 0], P[BASE + 1]), a1 = cvt_pk_bf16(P[BASE + 2], P[BASE + 3]);   \
    unsigned b0 = cvt_pk_bf16(P[BASE + 4], P[BASE + 5]), b1 = cvt_pk_bf16(P[BASE + 6], P[BASE + 7]);                              \
    auto r0 = __builtin_amdgcn_permlane32_swap(a0, b0, false, false); auto r1 = __builtin_amdgcn_permlane32_swap(a1, b1, false, false); \
    u32x4 w = {r0[0], r1[0], r0[1], r1[1]}; OUT = __builtin_bit_cast(bf16x8, w); } while (0)
    PK4(p0, 0, pa0); PK4(p0, 8, pa1); PK4(p1, 0, pa2); PK4(p1, 8, pa3);
#undef PK4
}
__device__ __forceinline__ void qkt(f32x16& p0, f32x16& p1, const LAS unsigned char* Ks, const bf16x8* qr, int r32, int hi) {
    p0 = f32x16{}; p1 = f32x16{};
#pragma unroll
    for (int d0 = 0; d0 < 4; ++d0) {
        const bf16x8 b0 = *(const LAS bf16x8*)(Ks + kswz(r32, d0 * 2 + hi));
        const bf16x8 b1 = *(const LAS bf16x8*)(Ks + kswz(32 + r32, d0 * 2 + hi));
        p0 = __builtin_amdgcn_mfma_f32_32x32x16_bf16(b0, qr[d0], p0, 0, 0, 0);
        p1 = __builtin_amdgcn_mfma_f32_32x32x16_bf16(b1, qr[d0], p1, 0, 0, 0); }
}
__device__ __forceinline__ int v_st(int k, int c) { const int kk = (k & ~0xC) | ((k & 4) << 1) | ((k & 8) >> 1); return ((kk >> 3) * 4 + (c >> 5)) * 512 + ((kk & 7) * 32 + (c & 31)) * 2; }
__device__ __forceinline__ int v_rd_base(int lane) { return ((lane & 3) << 3) | (((lane >> 2) & 3) << 6) | (((lane >> 4) & 1) << 5) | (((lane >> 5) & 1) << 8); }
constexpr int v_rd_off(int d0, int ks, int half) { return d0 * 512 + ks * 4096 + half * 2048; }
template <int OFF> __device__ __forceinline__ s16x4 tr_read(int vb) { s16x4 r; asm volatile("ds_read_b64_tr_b16 %0, %1 offset:%2" : "=&v"(r) : "v"(vb), "i"(OFF) : "memory"); return r; }
template <int D0> __device__ __forceinline__ void pv_one(f32x16& od, int vb, bf16x8 pa0, bf16x8 pa1, bf16x8 pa2, bf16x8 pa3) {
    const s16x4 l0 = tr_read<v_rd_off(D0, 0, 0)>(vb), h0 = tr_read<v_rd_off(D0, 0, 1)>(vb), l1 = tr_read<v_rd_off(D0, 1, 0)>(vb), h1 = tr_read<v_rd_off(D0, 1, 1)>(vb);
    const s16x4 l2 = tr_read<v_rd_off(D0, 2, 0)>(vb), h2 = tr_read<v_rd_off(D0, 2, 1)>(vb), l3 = tr_read<v_rd_off(D0, 3, 0)>(vb), h3 = tr_read<v_rd_off(D0, 3, 1)>(vb);
    asm volatile("s_waitcnt lgkmcnt(0)" ::: "memory"); SBAR();
#define PK(L, H) (bf16x8){L[0], L[1], L[2], L[3], H[0], H[1], H[2], H[3]}
    od = __builtin_amdgcn_mfma_f32_32x32x16_bf16(pa0, PK(l0, h0), od, 0, 0, 0);
    od = __builtin_amdgcn_mfma_f32_32x32x16_bf16(pa1, PK(l1, h1), od, 0, 0, 0);
    od = __builtin_amdgcn_mfma_f32_32x32x16_bf16(pa2, PK(l2, h2), od, 0, 0, 0);
    od = __builtin_amdgcn_mfma_f32_32x32x16_bf16(pa3, PK(l3, h3), od, 0, 0, 0);
#undef PK
}
__device__ __forceinline__ void pv_d0(f32x16* o, int vb, bf16x8 pa0, bf16x8 pa1, bf16x8 pa2, bf16x8 pa3) {
    pv_one<0>(o[0], vb, pa0, pa1, pa2, pa3); pv_one<1>(o[1], vb, pa0, pa1, pa2, pa3); pv_one<2>(o[2], vb, pa0, pa1, pa2, pa3); pv_one<3>(o[3], vb, pa0, pa1, pa2, pa3);
}

__device__ __forceinline__ void attn_pass_exact(const bf16_t* __restrict__ Qb, const bf16_t* __restrict__ Kb, const bf16_t* __restrict__ Vb, int b, int h, int mp, int qrow,
                                          f32x16 (&o)[4], float& l_out, LAS unsigned char* lds) {
    int tid_ = threadIdx.x; asm volatile("" : "+v"(tid_));
    const int tid = tid_, wid = tid >> 6, lane = tid & 63, r32 = lane & 31, hi = lane >> 5;
    LAS unsigned char* V_lds = lds + OFF_V; LAS unsigned char* K_lds = lds + OFF_K;
    LAS float* ws = (LAS float*)(lds + OFF_WS) + wid * 64; LAS float* al_l = ws + 32;
    float m_reg = -1e30f, l_reg = 0.f;
#pragma unroll
    for (int d = 0; d < 4; ++d) o[d] = f32x16{};
    bf16x8 qr[4];
    { const bf16_t* Qw = Qb + (size_t)qrow * 1024 + h * 128 + mp * 64 + hi * 8;
#pragma unroll
      for (int d0 = 0; d0 < 4; ++d0) qr[d0] = *(const bf16x8*)(Qw + d0 * 16); }
    const int sr = tid >> 4, sc = (tid & 15) * 8, vst0 = v_st(sr, sc), vst1 = v_st(32 + sr, sc);
    const int kk = tid >> 3, kch = tid & 7, kst = kswz(kk, kch);
    const int vb0 = (int)(uintptr_t)V_lds + v_rd_base(lane);
    const bf16_t* Kcol = Kb + h * 128 + mp * 64 + kch * 8; const bf16_t* Vcol = Vb + h * 128 + sc;
    const int mrow = TX + b * NMETA, xrow = b * SEQ - 64;
    struct { bf16x8 vs0, vs1, ks; } st_[2];
#define KROW(t, k) ((t) == 0 ? mrow + ((k) & 15) : xrow + (t) * 64 + (k))
#define SLOAD(i, t) do { st_[i].vs0 = *(const bf16x8*)(Vcol + (size_t)KROW(t, sr) * 1024); st_[i].vs1 = *(const bf16x8*)(Vcol + (size_t)KROW(t, 32 + sr) * 1024); \
        st_[i].ks = *(const bf16x8*)(Kcol + (size_t)KROW(t, kk) * 1024); } while (0)
#define SWRITE(bf, i) do { *(LAS bf16x8*)(V_lds + (bf) * SHM_V + vst0) = st_[i].vs0; *(LAS bf16x8*)(V_lds + (bf) * SHM_V + vst1) = st_[i].vs1; \
        *(LAS bf16x8*)(K_lds + (bf) * SHM_K + kst) = st_[i].ks; } while (0)
#define RESC(a) do { if (__any((a) < 1.f)) { if (hi == 0) al_l[r32] = (a); LDS_WAIT(); \
        _Pragma("unroll") for (int d = 0; d < 4; ++d) _Pragma("unroll") for (int r = 0; r < 16; ++r) o[d][r] *= al_l[crow(r, hi)]; } } while (0)
    f32x16 pA0, pA1, pB0, pB1; float alA, alB; bf16x8 pa0, pa1, pa2, pa3;
    constexpr int SE = 0, SO = 1;
    SLOAD(SE, 0); SWRITE(0, SE); __syncthreads();
    qkt(pA0, pA1, K_lds, qr, r32, hi);
#pragma unroll
    for (int r = 8; r < 16; ++r) pA0[r] = -INFINITY;
#pragma unroll
    for (int r = 0; r < 16; ++r) pA1[r] = -INFINITY;
    partialSM(pA0, pA1, m_reg, alA);
    SLOAD(SO, 1); SLOAD(SE, 2);
    SWRITE(1, SO); __syncthreads();
#define HALF_STEP(PN0, PN1, ALN, PP0, PP1, ALP, KBUF, VBUF, LD, LDSLOT, LDT, WR, WRBUF, WRSLOT) do { \
        SBAR(); qkt(PN0, PN1, K_lds + (KBUF) * SHM_K, qr, r32, hi); \
        finishSM(PP0, PP1, ALP, l_reg, pa0, pa1, pa2, pa3); SBAR(); \
        if (LD) { SLOAD(LDSLOT, LDT); } SBAR(); \
        pv_d0(o, vb0 + (VBUF) * SHM_V, pa0, pa1, pa2, pa3); partialSM(PN0, PN1, m_reg, ALN); \
        __syncthreads(); if (WR) { SWRITE(WRBUF, WRSLOT); } \
        RESC(ALN); __syncthreads(); } while (0)
    for (int j = 1; j + 3 < NT; j += 2) {
        HALF_STEP(pB0, pB1, alB, pA0, pA1, alA, 1, 0, true, SO, j + 2, true, 0, SE);
        HALF_STEP(pA0, pA1, alA, pB0, pB1, alB, 0, 1, true, SE, j + 3, true, 1, SO);
    }
    {
        HALF_STEP(pB0, pB1, alB, pA0, pA1, alA, 1, 0, false, SO, 0, true, 0, SE);
        HALF_STEP(pA0, pA1, alA, pB0, pB1, alB, 0, 1, false, SE, 0, false, 1, SO);
    }
    finishSM(pA0, pA1, alA, l_reg, pa0, pa1, pa2, pa3); SBAR();
    pv_d0(o, vb0, pa0, pa1, pa2, pa3);
    l_out = l_reg;
    __syncthreads();
#undef KROW
#undef SLOAD
#undef SWRITE
#undef RESC
#undef HALF_STEP
}

__device__ __forceinline__ bool attn_pass_fast(const bf16_t* __restrict__ Qb, const bf16_t* __restrict__ Kb, const bf16_t* __restrict__ Vb, int b, int h, int mp, int qrow,
                                          f32x16 (&o)[4], float& l_out, LAS unsigned char* lds) {
    int tid_ = threadIdx.x; asm volatile("" : "+v"(tid_));
    const int tid = tid_, wid = tid >> 6, lane = tid & 63, r32 = lane & 31, hi = lane >> 5;
    LAS unsigned char* V_lds = lds + OFF_V; LAS unsigned char* K_lds = lds + OFF_K;
    LAS float* ws = (LAS float*)(lds + OFF_WS) + wid * 64; LAS float* al_l = ws + 32;
    float m_reg = -1e30f, l_reg = 0.f;
#pragma unroll
    for (int d = 0; d < 4; ++d) o[d] = f32x16{};
    bf16x8 qr[4];
    { const bf16_t* Qw = Qb + (size_t)qrow * 1024 + h * 128 + mp * 64 + hi * 8;
#pragma unroll
      for (int d0 = 0; d0 < 4; ++d0) qr[d0] = *(const bf16x8*)(Qw + d0 * 16); }
    const int sr = tid >> 4, sc = (tid & 15) * 8, vst0 = v_st(sr, sc), vst1 = v_st(32 + sr, sc);
    const int kk = tid >> 3, kch = tid & 7, kst = kswz(kk, kch);
    const int vb0 = (int)(uintptr_t)V_lds + v_rd_base(lane);
    const bf16_t* Kcol = Kb + h * 128 + mp * 64 + kch * 8; const bf16_t* Vcol = Vb + h * 128 + sc;
    const int mrow = TX + b * NMETA, xrow = b * SEQ - 64;
    struct { bf16x8 vs0, vs1, ks; } st_[2];
#define KROW(t, k) ((t) == 0 ? mrow + ((k) & 15) : xrow + (t) * 64 + (k))
#define SLOAD(i, t) do { st_[i].vs0 = *(const bf16x8*)(Vcol + (size_t)KROW(t, sr) * 1024); st_[i].vs1 = *(const bf16x8*)(Vcol + (size_t)KROW(t, 32 + sr) * 1024); \
        st_[i].ks = *(const bf16x8*)(Kcol + (size_t)KROW(t, kk) * 1024); } while (0)
#define SWRITE(bf, i) do { *(LAS bf16x8*)(V_lds + (bf) * SHM_V + vst0) = st_[i].vs0; *(LAS bf16x8*)(V_lds + (bf) * SHM_V + vst1) = st_[i].vs1; \
        *(LAS bf16x8*)(K_lds + (bf) * SHM_K + kst) = st_[i].ks; } while (0)
#define RESC(a) do { if (__any((a) < 1.f)) { if (hi == 0) al_l[r32] = (a); LDS_WAIT(); \
        _Pragma("unroll") for (int d = 0; d < 4; ++d) _Pragma("unroll") for (int r = 0; r < 16; ++r) o[d][r] *= al_l[crow(r, hi)]; } } while (0)
    f32x16 pA0, pA1, pB0, pB1; float alA; bf16x8 pa0, pa1, pa2, pa3;
    constexpr int SE = 0, SO = 1;
    SLOAD(SE, 0); SLOAD(SO, 1); SWRITE(0, SE); SLOAD(SE, 2); __syncthreads();
    qkt(pA0, pA1, K_lds, qr, r32, hi);
#pragma unroll
    for (int r = 8; r < 16; ++r) pA0[r] = -INFINITY;
#pragma unroll
    for (int r = 0; r < 16; ++r) pA1[r] = -INFINITY;
    partialSM(pA0, pA1, m_reg, alA);
    SWRITE(1, SO); __syncthreads();
#define HALF_STEP(PN0, PN1, PP0, PP1, KBUF, VBUF, LD, LDSLOT, LDT, WR, WRBUF, WRSLOT, TILE0) do { \
        SBAR(); qkt(PN0, PN1, K_lds + (KBUF) * SHM_K, qr, r32, hi); \
        float ps_ = exp_second_sum(PP0, PP1); \
        l_reg += ps_; pack_p(PP0, PP1, pa0, pa1, pa2, pa3); SBAR(); \
        if (LD) { SLOAD(LDSLOT, LDT); } SBAR(); \
        pv_d0(o, vb0 + (VBUF) * SHM_V, pa0, pa1, pa2, pa3); exp_first(PN0, PN1, m_reg); \
        __syncthreads(); if (WR) { SWRITE(WRBUF, WRSLOT); } \
        __syncthreads(); } while (0)
    for (int j = 1; j + 3 < NT; j += 2) {
        HALF_STEP(pB0, pB1, pA0, pA1, 1, 0, true, SO, j + 2, true, 0, SE, false);
        HALF_STEP(pA0, pA1, pB0, pB1, 0, 1, true, SE, j + 3, true, 1, SO, false);
    }
    {
        HALF_STEP(pB0, pB1, pA0, pA1, 1, 0, false, SO, 0, true, 0, SE, false);
        HALF_STEP(pA0, pA1, pB0, pB1, 0, 1, false, SE, 0, false, 1, SO, false);
    }
    { float ps_ = exp_second_sum(pA0, pA1);
      l_reg += ps_; pack_p(pA0, pA1, pa0, pa1, pa2, pa3); SBAR(); }
    pv_d0(o, vb0, pa0, pa1, pa2, pa3);
    l_out = l_reg;
    if (lane == 0) al_l[0] = __any(!(l_reg <= 1.1529215e18f)) ? 1.0f : 0.0f;
    LDS_WAIT();
    __syncthreads();
    float bad_ = 0.f;
#pragma unroll
    for (int w = 0; w < 8; ++w) bad_ += ((const LAS float*)(lds + OFF_WS))[w * 64 + 32];
    const bool redo = bad_ != 0.f;
#undef KROW
#undef SLOAD
#undef SWRITE
#undef RESC
#undef HALF_STEP
    return redo;
}

struct AttnArgs { const bf16_t* Q; const bf16_t* K; const bf16_t* V; bf16_t* A; const float* subln; float lam, oml; };

__device__ __forceinline__ void attn_unit(const AttnArgs& P, int b, int h, int qb  , LAS unsigned char* lds) {
    int tid_ = threadIdx.x; asm volatile("" : "+v"(tid_));
    const int tid = tid_, wid = tid >> 6, lane = tid & 63, r32 = lane & 31, hi = lane >> 5;
    const bool meta = qb == 8;
    const int qrow = meta ? TX + b * NMETA + (r32 & 15) : b * SEQ + qb * 256 + wid * 32 + r32;
    LAS float* ws = (LAS float*)(lds + OFF_WS) + wid * 64;
    unsigned stb = (unsigned)(uintptr_t)(lds + OFF_ST) + (unsigned)tid * 4u; asm volatile("" : "+v"(stb));
    f32x16 o[4]; float l_reg;
    if (attn_pass_fast(P.Q, P.K, P.V, b, h, 0, qrow, o, l_reg, lds)) attn_pass_exact(P.Q, P.K, P.V, b, h, 0, qrow, o, l_reg, lds);
    if (hi == 0) ws[r32] = l_reg; LDS_WAIT();
    {
#pragma unroll
        for (int r = 0; r < 16; ++r) { const float rl = __builtin_amdgcn_rcpf(ws[crow(r, hi)]);
            *(LAS unsigned*)(stb + (r * 2 + 0) * 2048) = cvt_pk_bf16(o[0][r] * rl, o[1][r] * rl); *(LAS unsigned*)(stb + (r * 2 + 1) * 2048) = cvt_pk_bf16(o[2][r] * rl, o[3][r] * rl); }
    }
    LDS_WAIT();
    if (attn_pass_fast(P.Q, P.K, P.V, b, h, 1, qrow, o, l_reg, lds)) attn_pass_exact(P.Q, P.K, P.V, b, h, 1, qrow, o, l_reg, lds);
    if (hi == 0) ws[r32] = l_reg; LDS_WAIT();
    float ss[16];
#pragma unroll
    for (int r = 0; r < 16; ++r) { const float rl = __builtin_amdgcn_rcpf(ws[crow(r, hi)]) * P.lam;
        const unsigned s0 = *(LAS unsigned*)(stb + (r * 2 + 0) * 2048), s1 = *(LAS unsigned*)(stb + (r * 2 + 1) * 2048);
        o[0][r] = bf_lo(s0) - o[0][r] * rl; o[1][r] = bf_hi(s0) - o[1][r] * rl; o[2][r] = bf_lo(s1) - o[2][r] * rl; o[3][r] = bf_hi(s1) - o[3][r] * rl;
        ss[r] = (o[0][r] * o[0][r] + o[1][r] * o[1][r]) + (o[2][r] * o[2][r] + o[3][r] * o[3][r]); }
#pragma unroll
    for (int r = 0; r < 16; ++r) {
#pragma unroll
        for (int s = 1; s < 32; s <<= 1) ss[r] += shfl_xor_l(ss[r], s, lane);
        ss[r] = __builtin_amdgcn_rsqf(ss[r] * (1.0f / 128.0f) + EPS) * P.oml; }
    float gsub[4];
#pragma unroll
    for (int d = 0; d < 4; ++d) gsub[d] = P.subln[d * 32 + r32];
    __syncthreads();
    { const unsigned sg = (unsigned)(uintptr_t)(lds + OFF_ST) + (unsigned)wid * 8192u + (unsigned)((4 * hi * 128 + r32) * 2);
#pragma unroll
      for (int r = 0; r < 16; ++r)
#pragma unroll
          for (int d = 0; d < 4; ++d) *(LAS unsigned short*)(sg + (unsigned)((((r & 3) + 8 * (r >> 2)) * 128 + d * 32) * 2)) = (unsigned short)(cvt_pk_bf16(o[d][r] * ss[r] * gsub[d], 0.f) & 0xffffu);
      LDS_WAIT();
      const unsigned rg = (unsigned)(uintptr_t)(lds + OFF_ST) + (unsigned)wid * 8192u + (unsigned)(((lane >> 4) * 128 + (lane & 15) * 8) * 2);
      const bool wst = !meta || wid == 0;
#pragma unroll
      for (int i = 0; i < 8; ++i) { const int row = i * 4 + (lane >> 4); const u32x4 v = *(const LAS u32x4*)(rg + (unsigned)(i * 4 * 128 * 2));
          if (wst && (!meta || row < 16)) { const int orow = meta ? TX + b * NMETA + row : b * SEQ + qb * 256 + wid * 32 + row;
              *(u32x4*)(P.A + (size_t)orow * 1024 + h * 128 + (lane & 15) * 8) = v; } } }
    LDS_WAIT(); __syncthreads();
}
#undef SBAR
}

#define XB_TMO      128
#define XB_XCNT(j)  (256  + 64 * (j))
#define XB_XSUB(j)  (1280 + 64 * (j))
#define XB_XGEN(j)  (2304 + 64 * (j))
#define XB_TOP      3328
#define XB_TOPGEN   3392
#define XCD_BAR_WORDS 3456
#define XB_SPIN_CAP (1u << 22)
__device__ __forceinline__ unsigned xb_ld(unsigned* p)              { return __hip_atomic_load(p, __ATOMIC_RELAXED, __HIP_MEMORY_SCOPE_AGENT); }
__device__ __forceinline__ unsigned xb_add(unsigned* p, unsigned v) { return __hip_atomic_fetch_add(p, v, __ATOMIC_RELAXED, __HIP_MEMORY_SCOPE_AGENT); }
__device__ __forceinline__ unsigned xb_xcc_id() { return (unsigned)__builtin_amdgcn_s_getreg((3 << 11) | 20) & 0xFu; }
#define XB_SPIN(cond, bar) do { unsigned _sp = 0; while (cond) { __builtin_amdgcn_s_sleep(1); \
    if ((++_sp & 255u) == 0u) { if (xb_ld(&(bar)[XB_TMO])) break; if (_sp > XB_SPIN_CAP) { atomicAdd(&(bar)[XB_TMO], 1u); break; } } } } while (0)
struct XcdBarrier { unsigned* bar; unsigned x; volatile LAS unsigned* st; };
__device__ __forceinline__ XcdBarrier xcd_barrier_post(unsigned* bar, volatile LAS unsigned* st) {
    XcdBarrier b; b.bar = bar; b.x = xb_xcc_id(); b.st = st;
    if (threadIdx.x == 0) (void)xb_add(&bar[XB_XCNT(b.x)], 1u);
    return b;
}
__device__ __forceinline__ void xcd_barrier_complete(unsigned* bar, unsigned x, unsigned& nloc, unsigned& nx) {
    const unsigned G = gridDim.x * gridDim.y * gridDim.z;
    unsigned sum, cnt, mine, sp = 0u;
    for (;;) {
        sum = 0u; cnt = 0u; mine = 0u;
#pragma unroll
        for (unsigned j = 0; j < 16; ++j) { const unsigned c = xb_ld(&bar[XB_XCNT(j)]); sum += c; cnt += (c > 0u) ? 1u : 0u; mine = (j == x) ? c : mine; }
        if (sum == G) break;
        __builtin_amdgcn_s_sleep(1);
        if ((++sp & 255u) == 0u) { if (xb_ld(&bar[XB_TMO])) break; if (sp > XB_SPIN_CAP) { atomicAdd(&bar[XB_TMO], 1u); break; } }
    }
    nloc = mine > 0u ? mine : 1u; nx = cnt > 0u ? cnt : 1u;
}
__device__ __forceinline__ void xcd_barrier(const XcdBarrier& b) {
    asm volatile("s_waitcnt vmcnt(0)" ::: "memory");
    __syncthreads();
    if (threadIdx.x == 0) {
        unsigned* bar = b.bar;
        __builtin_amdgcn_s_waitcnt(0);
        unsigned nloc = b.st[0], nx = b.st[1];
        if (nloc == 0u) { xcd_barrier_complete(bar, b.x, nloc, nx); b.st[0] = nloc; b.st[1] = nx; }
        const unsigned old = xb_add(&bar[XB_XSUB(b.x)], 1u);
        const unsigned gen = old / nloc;
        if (old + 1u == (gen + 1u) * nloc) {
            __builtin_amdgcn_fence(__ATOMIC_RELEASE, "agent");
            asm volatile("s_waitcnt vmcnt(0)" ::: "memory");
            const unsigned og = xb_add(&bar[XB_TOP], 1u);
            const unsigned tg = og / nx;
            if (og + 1u == (tg + 1u) * nx) xb_add(&bar[XB_TOPGEN], 1u);
            else XB_SPIN(xb_ld(&bar[XB_TOPGEN]) == tg, bar);
            __builtin_amdgcn_fence(__ATOMIC_ACQUIRE, "agent");
            xb_add(&bar[XB_XGEN(b.x)], 1u);
            asm volatile("s_waitcnt vmcnt(0)" ::: "memory");
        } else {
            XB_SPIN(xb_ld(&bar[XB_XGEN(b.x)]) == gen, bar);
            __builtin_amdgcn_fence(__ATOMIC_ACQUIRE, "agent");
            asm volatile("s_waitcnt vmcnt(0)" ::: "memory");
        }
    }
    __syncthreads();
}

constexpr int RING_BYTES = 131072, LDSCTL_OFF = RING_BYTES, LDS_BYTES = 147456;
static_assert(att::LDS_BYTES <= RING_BYTES, "attention scratch inside the ring region");
constexpr int NPHASE = 18;

struct Args { const float* in[24]; float* out; unsigned char* ws; int ph_lo, ph_hi; };

template <int MODE> __device__ __forceinline__ int rowmap(int n) {
    if (MODE == 1) return (n >> 7) * 256 + (n & 127);
    if (MODE == 2) return (n >> 7) * 256 + 128 + (n & 127);
    if (MODE == 3) { if (n < 2048) { const int tile = n >> 8, hh = (n >> 6) & 3, bj = (n >> 5) & 1, i = n & 31; return tile * 256 + bj * 128 + hh * 32 + i; }
                     if (n >= 4096) { const int pool = n >= 6144 ? 1 : 0, c = n - 4096 - pool * 2048; return 4096 + (c >> 7) * 256 + pool * 128 + (c & 127); }
                     return n; }
    return n;
}
template <int MODE> __device__ __forceinline__ void transpose_item(const float* __restrict__ W, int K, int N, bf16_t* __restrict__ WT, LAS float* scr, int item, int lane, unsigned char* __restrict__ W8 = nullptr) {
    const int nblk = N / 32, kb = item / nblk, nb = item % nblk, k0 = 64 * kb, n0 = 32 * nb;
#pragma unroll 8
    for (int i = 0; i < 32; ++i) { const int kk = 2 * i + (lane >> 5); scr[kk * 33 + (lane & 31)] = W[(size_t)(k0 + kk) * N + n0 + (lane & 31)]; }
    LDS_WAIT(); asm volatile("" ::: "memory");
    const int c = lane & 7;
#pragma unroll
    for (int j = 0; j < 4; ++j) { const int n = (lane >> 3) + 8 * j; const LAS float* s = scr + (8 * c) * 33 + n;
        u32x4 o; o.x = cvt_pk_bf16(s[0 * 33], s[1 * 33]); o.y = cvt_pk_bf16(s[2 * 33], s[3 * 33]); o.z = cvt_pk_bf16(s[4 * 33], s[5 * 33]); o.w = cvt_pk_bf16(s[6 * 33], s[7 * 33]);
        *(u32x4*)(WT + (size_t)rowmap<MODE>(n0 + n) * K + k0 + 8 * c) = o;
        if (MODE == 3 && n0 >= 4096) {
            u32x2 o8; o8.x = cvt4_fp8(s[0 * 33] * F8_SW, s[1 * 33] * F8_SW, s[2 * 33] * F8_SW, s[3 * 33] * F8_SW); o8.y = cvt4_fp8(s[4 * 33] * F8_SW, s[5 * 33] * F8_SW, s[6 * 33] * F8_SW, s[7 * 33] * F8_SW);
            *(u32x2*)(W8 + (size_t)(rowmap<MODE>(n0 + n) - 4096) * K + k0 + 8 * c) = o8; } }
    LDS_WAIT(); asm volatile("" ::: "memory");
}

template <int MODE> __device__ __forceinline__ void transpose_item_f8(const float* __restrict__ W, int K, int N, unsigned char* __restrict__ WT, LAS float* scr, int item, int lane, float scale) {
    const int nblk = N / 32, kb = item / nblk, nb = item % nblk, k0 = 64 * kb, n0 = 32 * nb;
#pragma unroll 8
    for (int i = 0; i < 32; ++i) { const int kk = 2 * i + (lane >> 5); scr[kk * 33 + (lane & 31)] = W[(size_t)(k0 + kk) * N + n0 + (lane & 31)] * scale; }
    LDS_WAIT(); asm volatile("" ::: "memory");
    const int c = lane & 7;
#pragma unroll
    for (int j = 0; j < 4; ++j) { const int n = (lane >> 3) + 8 * j; const LAS float* s = scr + (8 * c) * 33 + n;
        u32x2 o; o.x = cvt4_fp8(s[0 * 33], s[1 * 33], s[2 * 33], s[3 * 33]); o.y = cvt4_fp8(s[4 * 33], s[5 * 33], s[6 * 33], s[7 * 33]);
        *(u32x2*)(WT + (size_t)rowmap<MODE>(n0 + n) * K + k0 + 8 * c) = o; }
    LDS_WAIT(); asm volatile("" ::: "memory");
}

__device__ __forceinline__ float half_sum(float v, int lane) {
#pragma unroll
    for (int o = 1; o < 32; o <<= 1) v += shfl_xor_l(v, o, lane);
    return v;
}
template <bool HAS0, bool HAS1, bool SRC16 = false, bool OUT16 = false, bool PRELOADED = false>
__device__ __forceinline__ void norm_row2(const void* src, void* hres_out, const float* __restrict__ gain, bf16_t* hout, int lane, bool valid, f32x4 (&v)[16], float& rstd,
                                          const bf16_t* add0 = nullptr, const bf16_t* add1 = nullptr) {
    const int l32 = lane & 31; const f32x4* xr = (const f32x4*)src + l32; float s = 0.f; u32x2 a_[16], b_[16], s_[16];
#pragma unroll
    for (int j = 0; j < 16; ++j) { if (SRC16) s_[j] = ((const u32x2*)src)[l32 + 32 * j]; else if (!PRELOADED) v[j] = xr[32 * j]; if (HAS0) a_[j] = ((const u32x2*)add0)[l32 + 32 * j]; if (HAS1) b_[j] = ((const u32x2*)add1)[l32 + 32 * j]; }
#pragma unroll
    for (int j = 0; j < 16; ++j) {
        if (SRC16) { const u32x2 q = s_[j]; v[j].x = bf_lo(q.x); v[j].y = bf_hi(q.x); v[j].z = bf_lo(q.y); v[j].w = bf_hi(q.y); }
        if (HAS0) { const u32x2 a = a_[j]; v[j].x += bf_lo(a.x); v[j].y += bf_hi(a.x); v[j].z += bf_lo(a.y); v[j].w += bf_hi(a.y); }
        if (HAS1) { const u32x2 b = b_[j]; v[j].x += bf_lo(b.x); v[j].y += bf_hi(b.x); v[j].z += bf_lo(b.y); v[j].w += bf_hi(b.y); }
        s += (v[j].x * v[j].x + v[j].y * v[j].y) + (v[j].z * v[j].z + v[j].w * v[j].w); }
    if (hres_out && valid) {
        if (OUT16) { u32x2* hr = (u32x2*)hres_out + l32;
#pragma unroll
            for (int j = 0; j < 16; ++j) { u32x2 w; w.x = cvt_pk_bf16(v[j].x, v[j].y); w.y = cvt_pk_bf16(v[j].z, v[j].w); hr[32 * j] = w; } }
        else { f32x4* hr = (f32x4*)hres_out + l32;
#pragma unroll
            for (int j = 0; j < 16; ++j) hr[32 * j] = v[j]; } }
    rstd = __builtin_amdgcn_rsqf(half_sum(s, lane) * (1.0f / DM) + EPS);
    const f32x4* gr = (const f32x4*)gain + l32;
#pragma unroll
    for (int j = 0; j < 16; ++j) { const f32x4 g = gr[32 * j]; v[j] = v[j] * rstd * g; }
    if (hout && valid) { u32x2* o8 = (u32x2*)hout + l32;
#pragma unroll
        for (int j = 0; j < 16; ++j) { u32x2 w; w.x = cvt_pk_bf16(v[j].x, v[j].y); w.y = cvt_pk_bf16(v[j].z, v[j].w); o8[32 * j] = w; } }
}

__global__ void __launch_bounds__(NWAVES * 64, 2) fwd_kernel(Args args) {
    extern __shared__ __attribute__((aligned(16))) unsigned char lds_raw[];
    LAS unsigned char* lds = (LAS unsigned char*)lds_raw;
    const int tid = threadIdx.x, lane = tid & 63, wave = __builtin_amdgcn_readfirstlane(tid >> 6);
    const int G = gridDim.x; const int bx = blockIdx.x; const int vcu = (G % 8 == 0) ? (bx % 8) * (G / 8) + bx / 8 : bx;
    unsigned* ctl = (unsigned*)(GAS unsigned*)(args.ws + WS_CTL);
    volatile LAS unsigned* MISC = (volatile LAS unsigned*)(lds + LDSCTL_OFF);
    for (int u = tid; u < (LDS_BYTES - LDSCTL_OFF) / 4; u += NWAVES * 64) ((LAS unsigned*)(lds + LDSCTL_OFF))[u] = 0u;
    __syncthreads();
    const int lo = args.ph_lo, hi = args.ph_hi; (void)lo;
    XcdBarrier bar; bar.bar = ctl + CW_BAR; bar.x = 0; bar.st = nullptr;
    if (hi - lo > 1) bar = xcd_barrier_post(ctl + CW_BAR, MISC + 8);
#if MK_ONE_LAUNCH && MK_PROBE_BUF == 0 && MK_LAST_PHASE == 17
#define IN(k) ((k) < NPHASE)
#define SEAM(k) do { if ((k) + 1 < NPHASE) xcd_barrier(bar); } while (0)
#else
#ifdef ONLY_MASK
#define IN(k) (((ONLY_MASK >> (k)) & 1) != 0 && lo <= (k) && (k) < hi)
#else
#define IN(k) (lo <= (k) && (k) < hi)
#endif
#define SEAM(k) do { if ((k) + 1 < hi) xcd_barrier(bar); } while (0)
#endif
#define PHASE_LOCALS int tidp = threadIdx.x; asm volatile("" : "+v"(tidp)); const int lanep = tidp & 63; GAS unsigned char* wsg_ = (GAS unsigned char*)args.ws; asm volatile("" : "+s"(wsg_)); unsigned char* wsp = (unsigned char*)wsg_; int Gp = gridDim.x; asm volatile("" : "+s"(Gp)); const int NGW = Gp * NWAVES, NGT = Gp * NWAVES * 64; (void)NGT; (void)NGW
    const int gw = vcu * NWAVES + wave;

    const float* x = (const float*)(const GAS float*)args.in[0]; const float* meta_tok = (const float*)(const GAS float*)args.in[1]; const float* norm_mix = (const float*)(const GAS float*)args.in[2]; const float* w_in = (const float*)(const GAS float*)args.in[3]; const float* b_gate = (const float*)(const GAS float*)args.in[4];
    const float* lam_q1 = (const float*)(const GAS float*)args.in[5]; const float* lam_k1 = (const float*)(const GAS float*)args.in[6]; const float* lam_q2 = (const float*)(const GAS float*)args.in[7]; const float* lam_k2 = (const float*)(const GAS float*)args.in[8]; const float* subln = (const float*)(const GAS float*)args.in[9];
    const float* pool_w = (const float*)(const GAS float*)args.in[10]; const float* pool_scale = (const float*)(const GAS float*)args.in[11]; const float* w_ba = (const float*)(const GAS float*)args.in[12]; const float* w_bp = (const float*)(const GAS float*)args.in[13]; const float* w_out = (const float*)(const GAS float*)args.in[14];
    const float* norm_ffn = (const float*)(const GAS float*)args.in[15]; const float* d_wg = (const float*)(const GAS float*)args.in[16]; const float* d_wu = (const float*)(const GAS float*)args.in[17]; const float* d_wd = (const float*)(const GAS float*)args.in[18]; const float* router = (const float*)(const GAS float*)args.in[19];
    const float* m_wg = (const float*)(const GAS float*)args.in[20]; const float* m_wu = (const float*)(const GAS float*)args.in[21]; const float* m_wd = (const float*)(const GAS float*)args.in[22]; const float* norm_final = (const float*)(const GAS float*)args.in[23];
#define ROPE ((float*)(wsp + WS_ROPE))
#define TOKE ((int*)(wsp + WS_TOKE))
#define TOKS ((int*)(wsp + WS_TOKS))
#define TOKW ((float*)(wsp + WS_TOKW))
#define ROWL ((int*)(wsp + WS_ROWL))
#define ROWW ((float*)(wsp + WS_ROWW))
#define WIN ((bf16_t*)(wsp + WS_WIN))
#define WBA ((bf16_t*)(wsp + WS_WBA))
#define WC ((bf16_t*)(wsp + WS_WC))
#define WOUT ((bf16_t*)(wsp + WS_WOUT))
#define DWGU ((bf16_t*)(wsp + WS_DWGU))
#define DWD ((bf16_t*)(wsp + WS_DWD))
#define MWGU ((bf16_t*)(wsp + WS_MWGU))
#define MWD ((bf16_t*)(wsp + WS_MWD))
#define HRES ((float*)(wsp + WS_HRES))
#define HRES16 ((bf16_t*)(wsp + WS_HRES))
#define H ((bf16_t*)(wsp + WS_H))
#define MB ((bf16_t*)(wsp + WS_H))
#define QB ((bf16_t*)(wsp + WS_Q))
#define KB ((bf16_t*)(wsp + WS_K))
#define VB ((bf16_t*)(wsp + WS_V))
#define UB ((bf16_t*)(wsp + WS_U))
#define GB ((bf16_t*)(wsp + WS_G))
#define YB ((bf16_t*)(wsp + WS_Y))
#define HID ((bf16_t*)(wsp + WS_HID))
#define CNT ((unsigned*)(wsp + WS_CTL) + CW_CNT)
#define H8P ((unsigned char*)(GAS unsigned char*)args.out)
#define WIN8G ((unsigned char*)(GAS unsigned char*)args.out + (size_t)T * DM)

    if (IN(0)) { PHASE_LOCALS;
#pragma unroll 1
      for (int rep0 = 0; rep0 < MK_REP_P0; ++rep0) {
        LAS float* scr = (LAS float*)(lds + wave * 16384);
        constexpr int I_FF = (DM / 64) * (DFF / 32);
        constexpr int I_MOE = NE * 3 * I_FF, I_DENSE = 3 * I_FF;
        constexpr int I_WIN = (DM / 64) * (INC / 32), I_WBA = (AW / 64) * (DM / 32), I_WOUT = (DM / 64) * (DM / 32), I_LAYER = I_WIN + I_WBA + I_WOUT;
        constexpr int NITEMS = I_MOE + I_DENSE + 2 * I_LAYER;
        for (int it = gw; it < NITEMS; it += NGW) {
            int r = it;
            if (r < I_MOE) { const int e = r / (3 * I_FF), q = r % (3 * I_FF), which = q / I_FF, item = q % I_FF;
                if (which == 0) transpose_item_f8<1>(m_wg + (size_t)e * DM * DFF, DM, DFF, (unsigned char*)MWGU + (size_t)e * NHID2 * DM, scr, item, lanep, F8_SW);
                else if (which == 1) transpose_item_f8<2>(m_wu + (size_t)e * DM * DFF, DM, DFF, (unsigned char*)MWGU + (size_t)e * NHID2 * DM, scr, item, lanep, F8_SW);
                else transpose_item_f8<0>(m_wd + (size_t)e * DFF * DM, DFF, DM, (unsigned char*)MWD + (size_t)e * DM * DFF, scr, item, lanep, F8_SW);
                continue; }
            r -= I_MOE;
            if (r < I_DENSE) { const int which = r / I_FF, item = r % I_FF;
                if (MK_F8_DENSE) {
                if (which == 0) transpose_item_f8<1>(d_wg, DM, DFF, (unsigned char*)DWGU, scr, item, lanep, F8_SW);
                else if (which == 1) transpose_item_f8<2>(d_wu, DM, DFF, (unsigned char*)DWGU, scr, item, lanep, F8_SW);
                else transpose_item_f8<0>(d_wd, DFF, DM, (unsigned char*)DWD, scr, item, lanep, F8_SW);
                } else {
                if (which == 0) transpose_item<1>(d_wg, DM, DFF, DWGU, scr, item, lanep);
                else if (which == 1) transpose_item<2>(d_wu, DM, DFF, DWGU, scr, item, lanep);
                else transpose_item<0>(d_wd, DFF, DM, DWD, scr, item, lanep); }
                continue; }
            r -= I_DENSE;
            const int l = r / I_LAYER; r = r % I_LAYER;
            if (r < I_WIN) { transpose_item<3>(w_in + (size_t)l * DM * INC, DM, INC, WIN + (size_t)l * INC * DM, scr, r, lanep, WIN8G + (size_t)l * 4096 * DM); continue; }
            r -= I_WIN;
            if (r < I_WBA) { transpose_item<0>(w_ba + (size_t)l * AW * DM, AW, DM, WBA + (size_t)l * DM * AW, scr, r, lanep); continue; }
            r -= I_WBA;
            transpose_item<0>(w_out + (size_t)l * DM * DM, DM, DM, WOUT + (size_t)l * DM * DM, scr, r, lanep);
        }
        for (int it = gw; it < 2 * 32 * 128; it += NGW) {
            const int l = it >> 12, nb = (it >> 7) & 31, kcb = it & 127, n = nb * 64 + lanep, kc0 = kcb * 8, g = kc0 >> 8, c0 = kc0 & 255;
            const float* pw = pool_w + ((size_t)(l * 4 + g) * 256 + c0) * 256; const float* ps = pool_scale + l * 1024 + g * 256; const float* wb = w_bp + ((size_t)l * 1024 + g * 256) * DM + n;
            float a[8];
#pragma unroll
            for (int q = 0; q < 8; ++q) a[q] = 0.f;
            for (int e = 0; e < 256; ++e) { const float wv = wb[(size_t)e * DM] * ps[e];
#pragma unroll
                for (int q = 0; q < 8; ++q) a[q] += pw[q * 256 + e] * wv; }
            u32x4 o; o.x = cvt_pk_bf16(a[0], a[1]); o.y = cvt_pk_bf16(a[2], a[3]); o.z = cvt_pk_bf16(a[4], a[5]); o.w = cvt_pk_bf16(a[6], a[7]);
            *(u32x4*)(WC + ((size_t)l * DM + n) * 1024 + kc0) = o;
        }
        for (int idx = (vcu * NWAVES * 64) + tidp; idx < LTOK * 32; idx += NGT) { const int pos = idx >> 5, i = idx & 31;
            const float inv = __builtin_amdgcn_exp2f((float)(-i) * 0.41524101186092029f); const float ang = (float)pos * inv;
            double rev = (double)ang * 0.15915494309189535; rev -= floor(rev);
            ROPE[pos * 64 + i] = __builtin_amdgcn_cosf((float)rev); ROPE[pos * 64 + 32 + i] = __builtin_amdgcn_sinf((float)rev); }
#define EMB_ROW(r) ((r) < TX ? x + (size_t)(r) * DM : meta_tok + (size_t)(((r) - TX) & (NMETA - 1)) * DM)
        for (int r0 = gw; r0 < T; r0 += 2 * NGW) { const int rr = r0 + (lanep >> 5) * NGW; const bool valid = rr < T; const int r = valid ? rr : r0;
            f32x4 v[16]; float rstd; norm_row2<false, false>(EMB_ROW(r), nullptr, norm_mix, H + (size_t)r * DM, lanep, valid, v, rstd);
            if (valid && r < TX) { unsigned* o4 = (unsigned*)(H8P + (size_t)r * DM) + (lanep & 31);
#pragma unroll
                for (int j = 0; j < 16; ++j) o4[32 * j] = cvt4_fp8(v[j].x * F8_SA, v[j].y * F8_SA, v[j].z * F8_SA, v[j].w * F8_SA); } }
        SEAM(0);
      }
    }

#pragma unroll 1
    for (int layer = 0; layer < 2; ++layer) {
        const int pb = 1 + 8 * layer;
        if (IN(pb + 0)) { PHASE_LOCALS;
            { SchedInA S; S.o.init(NPAN - 1, 16, Gp, bx); S.A = (const char*)H; S.B = (const char*)(WIN + (size_t)layer * INC * DM);
              EpiIn E{QB, KB, VB, UB, GB, b_gate + layer * 4096, ROPE};
              pg8::gemm_phase<EpiIn, SchedInA, false>(lds, DM / 64, DM * 2, DM * 2, S, E); }
            { SchedIn8 S; S.o.init(NPAN - 1, 16, Gp, bx); S.A = (const char*)H8P; S.B = (const char*)(WIN8G + (size_t)layer * 4096 * DM);
              EpiGate8 E{GB, b_gate + layer * 4096};
              pg8::gemm_phase<EpiGate8, SchedIn8, false, true>(lds, DM / 128, DM, DM, S, E); }
            SEAM(pb + 0);
        }
        if (IN(pb + 1)) { PHASE_LOCALS;
            const bool split = layer == 0 && (Gp & 1) == 0 && Gp >= 256;
            const int gw_m = split ? (vcu >= Gp / 2 ? (vcu - Gp / 2) * NWAVES + wave : (layer == 0 ? T : TX)) : gw, ngw_m = split ? NGW / 2 : NGW;
#pragma unroll 1
            for (int repm = 0; repm < MK_REP_M; ++repm)
            for (int r = gw_m; r < (layer == 0 ? T : TX); r += ngw_m) { const int b = row_batch(r), pos = row_pos(r), g = lanep >> 4, half = 1 << g;
                const int wlo = max(pos - half, 0), whi = min(pos + half, LTOK);
                float s[16];
#pragma unroll
                for (int q = 0; q < 16; ++q) s[q] = 0.f;
                u32x4 wa[16], wc_[16];
#pragma unroll
                for (int jj = 0; jj < 16; ++jj) { const int j = pos - 8 + jj; const int jc = min(max(j, 0), LTOK - 1);
                    const u32x4* up = (const u32x4*)(UB + (size_t)row_of(b, jc) * 1024 + lanep * 16); wa[jj] = up[0]; wc_[jj] = up[1]; }
#pragma unroll
                for (int jj = 0; jj < 16; ++jj) { const int j = pos - 8 + jj; const unsigned msk = (j >= wlo && j < whi) ? 0xffffffffu : 0u;
                    const u32x4 a = wa[jj] & msk, c = wc_[jj] & msk;
                        s[0] += bf_lo(a.x); s[1] += bf_hi(a.x); s[2] += bf_lo(a.y); s[3] += bf_hi(a.y); s[4] += bf_lo(a.z); s[5] += bf_hi(a.z); s[6] += bf_lo(a.w); s[7] += bf_hi(a.w);
                        s[8] += bf_lo(c.x); s[9] += bf_hi(c.x); s[10] += bf_lo(c.y); s[11] += bf_hi(c.y); s[12] += bf_lo(c.z); s[13] += bf_hi(c.z); s[14] += bf_lo(c.w); s[15] += bf_hi(c.w); }
                const float rc = 1.0f / (float)(whi - wlo);
                const u32x4* up = (const u32x4*)(UB + (size_t)r * 1024 + lanep * 16); const u32x4 a = up[0], c = up[1];
                const float uv[16] = {bf_lo(a.x), bf_hi(a.x), bf_lo(a.y), bf_hi(a.y), bf_lo(a.z), bf_hi(a.z), bf_lo(a.w), bf_hi(a.w), bf_lo(c.x), bf_hi(c.x), bf_lo(c.y), bf_hi(c.y), bf_lo(c.z), bf_hi(c.z), bf_lo(c.w), bf_hi(c.w)};
                u32x4 o0, o1;
                o0.x = cvt_pk_bf16(s[0] * rc - uv[0], s[1] * rc - uv[1]); o0.y = cvt_pk_bf16(s[2] * rc - uv[2], s[3] * rc - uv[3]); o0.z = cvt_pk_bf16(s[4] * rc - uv[4], s[5] * rc - uv[5]); o0.w = cvt_pk_bf16(s[6] * rc - uv[6], s[7] * rc - uv[7]);
                o1.x = cvt_pk_bf16(s[8] * rc - uv[8], s[9] * rc - uv[9]); o1.y = cvt_pk_bf16(s[10] * rc - uv[10], s[11] * rc - uv[11]); o1.z = cvt_pk_bf16(s[12] * rc - uv[12], s[13] * rc - uv[13]); o1.w = cvt_pk_bf16(s[14] * rc - uv[14], s[15] * rc - uv[15]);
                u32x4* mp = (u32x4*)(MB + (size_t)r * 1024 + lanep * 16); mp[0] = o0; mp[1] = o1; }
            const float linit = layer == 0 ? 0.2f : (0.8f - 0.6f * 0.74081822068171788f);
            const float d1 = wave_sum(lam_q1[layer * 64 + lanep] * lam_k1[layer * 64 + lanep], lanep), d2 = wave_sum(lam_q2[layer * 64 + lanep] * lam_k2[layer * 64 + lanep], lanep);
            att::AttnArgs P{QB, KB, VB, QB, subln + layer * 128, expf(d1) - expf(d2) + linit, 1.0f - linit};
            __syncthreads();
#pragma unroll 1
            for (int rep = 0; rep < MK_REP_ATT; ++rep) {
            P.A = (rep + 1 < MK_REP_ATT) ? (bf16_t*)(wsp + WS_H + ZSTEP) : QB;
            const int nm = split ? (vcu < 128 ? 1 : 0) : 0, xlim = (layer == 0 && !split) ? 1152 : 1024;
            for (int it = 0; ; ++it) { int id; if (it < nm) id = 1024 + vcu; else { id = vcu + (it - nm) * Gp; if (id >= xlim) break; }
                const int bh = id < 1024 ? (id >> 3) : (id - 1024); int qb = id < 1024 ? (id & 7) : 8; asm volatile("" : "+s"(qb));
                att::attn_unit(P, bh >> 3, bh & 7, qb, lds);
            } }
            SEAM(pb + 1);
        }
        if (IN(pb + 2)) { PHASE_LOCALS;
            SchedY S; S.o.init(layer == 0 ? NPAN : NPAN - 1, DM / 256, Gp, bx); S.A0 = (const char*)QB; S.A1 = (const char*)MB; S.B0 = (const char*)(WBA + (size_t)layer * DM * AW); S.B1 = (const char*)(WC + (size_t)layer * DM * 1024);
            EpiY E{YB, GB};
#pragma unroll 1
            for (int rep = 0; rep < MK_REP_P3; ++rep) {
            pg8::gemm_phase<EpiY, SchedY, false>(lds, 1024 / 64, 1024 * 2, 1024 * 2, S, E);
            SEAM(pb + 2); }
        }
        if (IN(pb + 3)) { PHASE_LOCALS;
            SchedPlain S; S.o.init(layer == 0 ? NPAN : NPAN - 1, DM / 256, Gp, bx); S.A = (const char*)YB; S.B = (const char*)(WOUT + (size_t)layer * DM * DM); S.astep = (size_t)256 * DM * 2; S.bstep = (size_t)256 * DM * 2;
            EpiDelta E{GB, 1.f};
            pg8::gemm_phase<EpiDelta, SchedPlain, false>(lds, DM / 64, DM * 2, DM * 2, S, E);
            SEAM(pb + 3);
        }
        if (IN(pb + 4)) { PHASE_LOCALS;
            if (layer == 1) {
                for (int i = vcu * NWAVES * 64 + tidp; i < MOE_MAXROWS; i += NGT) { ROWL[i] = -1; ROWW[i] = 0.f; } }
            const int R2 = layer == 0 ? T : TX;
            for (int r0 = gw; r0 < R2; r0 += 2 * NGW) { const int rr = r0 + (lanep >> 5) * NGW; const bool valid = rr < R2; const int r = valid ? rr : r0; const int l32 = lanep & 31;
                f32x4 v[16]; float rstd;
#if MK_HRES16
                if (layer == 0) {
                    const f32x4* xr = (const f32x4*)EMB_ROW(r) + l32;
#pragma unroll
                    for (int j = 0; j < 16; ++j) v[j] = xr[32 * j]; }
                else { u32x2 s_[16];
#pragma unroll
                    for (int j = 0; j < 16; ++j) s_[j] = ((const u32x2*)(HRES16 + (size_t)r * DM))[l32 + 32 * j];
#pragma unroll
                    for (int j = 0; j < 16; ++j) { const u32x2 q = s_[j]; v[j].x = bf_lo(q.x); v[j].y = bf_hi(q.x); v[j].z = bf_lo(q.y); v[j].w = bf_hi(q.y); } }
                norm_row2<true, false, false, true, true>(nullptr, HRES16 + (size_t)r * DM, norm_ffn + layer * DM, nullptr, lanep, valid, v, rstd, GB + (size_t)r * DM);
#else
                const float* hsrc = layer == 0 ? EMB_ROW(r) : HRES + (size_t)r * DM;
                norm_row2<true, false>(hsrc, HRES + (size_t)r * DM, norm_ffn + layer * DM, (layer == 0 && !MK_F8_DENSE) ? H + (size_t)r * DM : nullptr, lanep, valid, v, rstd, GB + (size_t)r * DM);
#endif
                if ((layer == 1 || MK_F8_DENSE) && valid) {
                    unsigned* o4 = (unsigned*)((unsigned char*)H + (size_t)r * DM) + l32;
#pragma unroll
                    for (int j = 0; j < 16; ++j) o4[32 * j] = cvt4_fp8(v[j].x * F8_SA, v[j].y * F8_SA, v[j].z * F8_SA, v[j].w * F8_SA); }
                if (layer == 1) {
                    float lg[8];
#pragma unroll
                    for (int e = 0; e < 8; ++e) lg[e] = 0.f;
#pragma unroll
                    for (int j = 0; j < 16; ++j) { const f32x4* rp = (const f32x4*)(router + (size_t)(4 * (l32 + 32 * j)) * 8);
#pragma unroll
                        for (int q = 0; q < 4; ++q) { const f32x4 ra = rp[2 * q], rb = rp[2 * q + 1]; const float hv = v[j][q];
                            lg[0] += hv * ra.x; lg[1] += hv * ra.y; lg[2] += hv * ra.z; lg[3] += hv * ra.w; lg[4] += hv * rb.x; lg[5] += hv * rb.y; lg[6] += hv * rb.z; lg[7] += hv * rb.w; } }
#pragma unroll
                    for (int e = 0; e < 8; ++e) lg[e] = half_sum(lg[e], lanep);
                    if (l32 == 0 && valid) { int e1 = 0; float v1 = lg[0];
#pragma unroll
                        for (int e = 1; e < 8; ++e) if (lg[e] > v1) { v1 = lg[e]; e1 = e; }
                        int e2 = -1; float v2 = -INFINITY;
#pragma unroll
                        for (int e = 0; e < 8; ++e) if (e != e1 && lg[e] > v2) { v2 = lg[e]; e2 = e; }
                        if (e2 < 0) e2 = (e1 + 1) & 7;
                        const float w1 = 1.0f / (1.0f + expf(v2 - v1)), w2 = 1.0f - w1;
                        const int s1 = (int)atomicAdd(CNT + e1, 1u), s2 = (int)atomicAdd(CNT + e2, 1u);
                        TOKE[r] = e1; TOKE[T + r] = e2; TOKS[r] = s1; TOKS[T + r] = s2; TOKW[r] = w1; TOKW[T + r] = w2; }
                }
            }
            SEAM(pb + 4);
        }
        if (layer == 0) {
            if (IN(6)) { PHASE_LOCALS;
                SchedPlain S; S.o.init(NPAN, NHID2 / 256, Gp, bx); S.A = (const char*)H; S.B = (const char*)DWGU; S.astep = (size_t)256 * DM * 2; S.bstep = (size_t)256 * DM * 2;
#if MK_F8_DENSE
                S.astep = (size_t)256 * DM; S.bstep = (size_t)256 * DM;
                EpiSwi8 E{(unsigned char*)HID};
                pg8::gemm_phase<EpiSwi8, SchedPlain, false, true>(lds, DM / 128, DM, DM, S, E);
                SEAM(6);
#else
                EpiSwi E{HID};
#pragma unroll 1
                for (int rep = 0; rep < MK_REP_P5; ++rep) {
                pg8::gemm_phase<EpiSwi, SchedPlain, false>(lds, DM / 64, DM * 2, DM * 2, S, E);
                SEAM(6); }
#endif
            }
            if (IN(7)) { PHASE_LOCALS;
                SchedPlain S; S.o.init(NPAN, DM / 256, Gp, bx); S.A = (const char*)HID; S.B = (const char*)DWD; S.astep = (size_t)256 * DFF * 2; S.bstep = (size_t)256 * DFF * 2;
#if MK_F8_DENSE
                S.astep = (size_t)256 * DFF; S.bstep = (size_t)256 * DFF;
                EpiDelta E{H, 1.0f / (F8_SH * F8_SW)};
                pg8::gemm_phase<EpiDelta, SchedPlain, false, true>(lds, DFF / 128, DFF, DFF, S, E);
                SEAM(7);
#else
#pragma unroll 1
                for (int rep = 0; rep < MK_REP_P6; ++rep) {
                EpiRes E{HRES, (rep + 1 < MK_REP_P6) ? 0.f : 1.f};
                pg8::gemm_phase<EpiRes, SchedPlain, false>(lds, DFF / 64, DFF * 2, DFF * 2, S, E);
                SEAM(7); }
#endif
            }
            if (IN(8)) { PHASE_LOCALS;
#pragma unroll 1
                for (int rep = 0; rep < MK_REP_N1; ++rep) {
                for (int r0 = gw; r0 < T; r0 += 2 * NGW) { const int rr = r0 + (lanep >> 5) * NGW; const bool valid = rr < T; const int r = valid ? rr : r0;
                    f32x4 v[16]; float rstd;
#if MK_HRES16
                    norm_row2<true, false, true, true>(HRES16 + (size_t)r * DM, HRES16 + (size_t)r * DM, norm_mix + DM, H + (size_t)r * DM, lanep, valid, v, rstd, H + (size_t)r * DM);
#else
                    norm_row2<MK_F8_DENSE != 0, false>(HRES + (size_t)r * DM, HRES + (size_t)r * DM, norm_mix + DM, H + (size_t)r * DM, lanep, valid, v, rstd, H + (size_t)r * DM);
#endif
                    if (valid && r < TX) { unsigned* o4 = (unsigned*)(H8P + (size_t)r * DM) + (lanep & 31);
#pragma unroll
                        for (int j = 0; j < 16; ++j) o4[32 * j] = cvt4_fp8(v[j].x * F8_SA, v[j].y * F8_SA, v[j].z * F8_SA, v[j].w * F8_SA); } }
                SEAM(8); }
            }
        } else {
            MoeMap mm; int rb[9];
            { unsigned char* wsp = (unsigned char*)(GAS unsigned char*)args.ws; int p = 0;
#pragma unroll
              for (int e = 0; e < 8; ++e) { const int c = (int)__hip_atomic_load(CNT + e, __ATOMIC_RELAXED, __HIP_MEMORY_SCOPE_AGENT); mm.pb[e] = p; rb[e] = p * 256; p = min(p + ((c + 255) >> 8), MOE_MAXPAN); }
              mm.pb[8] = p; rb[8] = p * 256; }
            if (IN(14)) { PHASE_LOCALS;
                for (int i = gw * 4 + (lanep >> 4); i < 2 * TX; i += NGW * 4) {
                    const int k = i >= TX ? 1 : 0, tok = i - k * TX; const int e = TOKE[k * T + tok], s = TOKS[k * T + tok];
                    int base = 0;
#pragma unroll
                    for (int j = 0; j < 8; ++j) base = (j == e) ? rb[j] : base;
                    if (e >= 0 && e < 8 && s >= 0 && base + s < MOE_MAXROWS) { const int pos = base + s; const int l16 = lanep & 15;
                        if (l16 == 0) { ROWL[pos] = tok | (k << 30); ROWW[pos] = TOKW[k * T + tok]; }
                        const u32x4* src = (const u32x4*)((const unsigned char*)H + (size_t)tok * DM) + l16; u32x4* dst = (u32x4*)(wsp + WS_H8S + (size_t)pos * DM) + l16;
                        u32x4 t[8];
#pragma unroll
                        for (int j = 0; j < 8; ++j) t[j] = src[16 * j];
#pragma unroll
                        for (int j = 0; j < 8; ++j) dst[16 * j] = t[j]; } }
                SEAM(14);
            }
            if (IN(15)) { PHASE_LOCALS;
                SchedMoeUp S; S.o.init(mm.pb[8], NHID2 / 256, Gp, bx); S.A = (const char*)(wsp + WS_H8S); S.B = (const char*)MWGU; S.mm = mm;
                EpiSwi8 E{(unsigned char*)HID};
                pg8::gemm_phase<EpiSwi8, SchedMoeUp, false, true>(lds, DM / 128, DM, DM, S, E);
                SEAM(15);
            }
            if (IN(16)) { PHASE_LOCALS;
                SchedMoeDown S; S.o.init(mm.pb[8], DM / 256, Gp, bx, 1); S.A = (const char*)HID; S.B = (const char*)MWD; S.mm = mm;
                EpiMoeDown E{(bf16_t*)(wsp + WS_OUT2A), (bf16_t*)(wsp + WS_OUT2B), ROWL, ROWW, 1.0f / (F8_SH * F8_SW)};
                pg8::gemm_phase<EpiMoeDown, SchedMoeDown, false, true>(lds, DFF / 128, DFF, DFF, S, E);
                SEAM(16);
            }
            if (IN(17)) { PHASE_LOCALS;
                for (int r0 = gw; r0 < TX; r0 += 2 * NGW) { const int rr = r0 + (lanep >> 5) * NGW; const bool valid = rr < TX; const int r = valid ? rr : r0;
                    f32x4 v[16]; float rstd; norm_row2<true, true, MK_HRES16 != 0, false>(MK_HRES16 ? (const void*)(HRES16 + (size_t)r * DM) : (const void*)(HRES + (size_t)r * DM), nullptr, norm_final, nullptr, lanep, valid, v, rstd, (const bf16_t*)(wsp + WS_OUT2A) + (size_t)r * DM, (const bf16_t*)(wsp + WS_OUT2B) + (size_t)r * DM);
                    if (valid) { f32x4* op = (f32x4*)((float*)(GAS float*)args.out + (size_t)r * DM) + (lanep & 31);
#pragma unroll
                        for (int j = 0; j < 16; ++j) op[32 * j] = v[j]; } }
            }
        }
    }
    if (MK_PROBE_BUF != 0 && IN(20)) { PHASE_LOCALS;
        for (int r = gw; r < TX; r += NGW) {
            float* op = (float*)(GAS float*)args.out + (size_t)r * DM; const int rs = MK_PROBE_META ? TX + (r & 255) : r;
            for (int c = lanep; c < DM; c += 64) { bf16_t v;
                if (MK_PROBE_BUF == 1) v = c < 1024 ? QB[(size_t)rs * 1024 + c] : KB[(size_t)rs * 1024 + c - 1024];
                else if (MK_PROBE_BUF == 2) v = c < 1024 ? VB[(size_t)rs * 1024 + c] : UB[(size_t)rs * 1024 + c - 1024];
                else if (MK_PROBE_BUF == 3) v = GB[(size_t)rs * 4096 + c];
                else if (MK_PROBE_BUF == 4) v = GB[(size_t)rs * 4096 + 2048 + c];
                else if (MK_PROBE_BUF == 5) v = c < 1024 ? QB[(size_t)rs * 1024 + c] : MB[(size_t)rs * 1024 + c - 1024];
                else if (MK_PROBE_BUF == 7) v = c < 1024 ? QB[(size_t)rs * 1024 + c] : (bf16_t)0;
                else if (MK_PROBE_BUF == 8) v = c < 1024 ? MB[(size_t)rs * 1024 + c] : (bf16_t)0;
                else v = YB[(size_t)rs * 2048 + c];
                float fv = __uint_as_float((unsigned)v << 16); if (!(fabsf(fv) < 1e30f)) fv = 12345.0f;
                op[c] = fv; } }
    }
#undef IN
#undef SEAM
#undef PHASE_LOCALS
}

extern "C" void kernel_launch(void* const* d_in, const int* in_sizes, int n_in, void* d_out, int out_size, void* d_ws, size_t ws_size, hipStream_t stream) {
    static int grid = 0;
    if (grid == 0) {
        if (n_in != 24 || out_size != TX * DM || ws_size < WS_END) { fprintf(stderr, "kernel_launch: unexpected shapes (n_in %d, out %d, ws %zu < %zu)\n", n_in, out_size, ws_size, (size_t)WS_END); grid = -1; return; }
        int dev = 0, cus = 0;
        if (hipGetDevice(&dev) != hipSuccess || hipDeviceGetAttribute(&cus, hipDeviceAttributeMultiprocessorCount, dev) != hipSuccess) { grid = -1; return; }
        if (hipFuncSetAttribute((const void*)fwd_kernel, hipFuncAttributeMaxDynamicSharedMemorySize, LDS_BYTES) != hipSuccess) { fprintf(stderr, "kernel_launch: hipFuncSetAttribute failed\n"); grid = -1; return; }
        int per_cu = 0;
        if (hipOccupancyMaxActiveBlocksPerMultiprocessor(&per_cu, (const void*)fwd_kernel, NWAVES * 64, LDS_BYTES) != hipSuccess || per_cu < 1) fprintf(stderr, "kernel_launch: occupancy query reports %d\n", per_cu);
        (void)hipGetLastError();
        grid = cus;
    }
    if (grid < 0) return;
    (void)hipMemsetAsync((char*)d_ws + WS_CTL, 0, CTL_ZERO_BYTES, stream);
    Args a{};
    for (int i = 0; i < 24; ++i) a.in[i] = (const float*)d_in[i];
    a.out = (float*)d_out; a.ws = (unsigned char*)d_ws;
#if MK_ONE_LAUNCH
    a.ph_lo = 0; a.ph_hi = NPHASE;
    hipLaunchKernelGGL(fwd_kernel, dim3(grid), dim3(NWAVES * 64), LDS_BYTES, stream, a);
#else
    for (int p = 0; p <= MK_LAST_PHASE; ++p) { a.ph_lo = p; a.ph_hi = p + 1; hipLaunchKernelGGL(fwd_kernel, dim3(grid), dim3(NWAVES * 64), LDS_BYTES, stream, a); }
    if (MK_PROBE_BUF != 0) { a.ph_lo = 20; a.ph_hi = 21; hipLaunchKernelGGL(fwd_kernel, dim3(grid), dim3(NWAVES * 64), LDS_BYTES, stream, a); }
    else if (MK_LAST_PHASE < 17) { a.ph_lo = 17; a.ph_hi = 18; hipLaunchKernelGGL(fwd_kernel, dim3(grid), dim3(NWAVES * 64), LDS_BYTES, stream, a); }
#endif
}
```

```cpp
#include <hip/hip_runtime.h>
#include <cstdio>
#include <cstdint>

#ifndef MK_ONE_LAUNCH
#define MK_ONE_LAUNCH 1
#endif
#ifndef MK_REP_P0
#define MK_REP_P0 1
#endif
#ifndef MK_REP_P5
#define MK_REP_P5 1
#endif
#ifndef MK_REP_ATT
#define MK_REP_ATT 1
#endif
#ifndef MK_REP_M
#define MK_REP_M 1
#endif
#ifndef MK_REP_P1
#define MK_REP_P1 1
#endif
#ifndef MK_REP_P3
#define MK_REP_P3 1
#endif
#ifndef MK_REP_N1
#define MK_REP_N1 1
#endif
#ifndef MK_REP_P4
#define MK_REP_P4 1
#endif
#ifndef MK_REP_P6
#define MK_REP_P6 1
#endif
#ifndef MK_REP_MUP
#define MK_REP_MUP 1
#endif
#ifndef MK_F8_DENSE
#define MK_F8_DENSE 1
#endif
#ifndef MK_REP_MOE
#define MK_REP_MOE 1
#endif
#ifndef MK_HRES16
#define MK_HRES16 1
#endif
#ifndef MK_REP_EPI
#define MK_REP_EPI 1
#endif
#ifndef MK_PROBE_META
#define MK_PROBE_META 0
#endif
#ifndef MK_PROBE_BUF
#define MK_PROBE_BUF 0
#endif
#ifndef MK_LAST_PHASE
#define MK_LAST_PHASE 17
#endif

#define LAS __attribute__((address_space(3)))
#define GAS __attribute__((address_space(1)))
typedef unsigned short bf16_t;
typedef short bf16x8 __attribute__((ext_vector_type(8)));
typedef short s16x4 __attribute__((ext_vector_type(4)));
typedef float f32x2 __attribute__((ext_vector_type(2)));
typedef float f32x4 __attribute__((ext_vector_type(4)));
typedef float f32x16 __attribute__((ext_vector_type(16)));
typedef unsigned u32x2 __attribute__((ext_vector_type(2)));
typedef unsigned u32x4 __attribute__((ext_vector_type(4)));

constexpr int NB = 16, SEQ = 2048, NMETA = 16, LTOK = SEQ + NMETA, DM = 2048;
constexpr int T = NB * LTOK;
constexpr int TX = NB * SEQ;
constexpr int NPAN = T / 256;
constexpr int AW = 1024, NH = 8, DFF = 5632, NE = 8, INC = 8192;
constexpr int NHID2 = 2 * DFF;
constexpr float EPS = 1e-5f;
constexpr float LOG2E = 1.4426950408889634f;
constexpr float QSCALE = 0.125f * LOG2E;
constexpr int MOE_MAXPAN = 264, MOE_MAXROWS = MOE_MAXPAN * 256;
constexpr int NWAVES = 8;

__device__ __forceinline__ int row_pos(int r) { return r < TX ? NMETA + (r & (SEQ - 1)) : ((r - TX) & (NMETA - 1)); }
__device__ __forceinline__ int row_batch(int r) { return r < TX ? (r >> 11) : ((r - TX) >> 4); }
__device__ __forceinline__ int row_of(int b, int pos) { return pos < NMETA ? TX + b * NMETA + pos : b * SEQ + pos - NMETA; }

constexpr size_t MiB = 1u << 20;
constexpr size_t WS_CTL = 0, CTL_ZERO_BYTES = 1 * MiB;
constexpr size_t WS_ROPE = 1 * MiB;
constexpr size_t WS_TOKE = 2 * MiB, WS_TOKS = 2 * MiB + 320 * 1024, WS_TOKW = 2 * MiB + 640 * 1024;
constexpr size_t WS_ROWL = 3 * MiB, WS_ROWW = 3 * MiB + 320 * 1024;
constexpr size_t WS_WIN = 5 * MiB;
constexpr size_t WS_WBA = 69 * MiB;
constexpr size_t WS_WC = 77 * MiB;
constexpr size_t WS_WOUT = 85 * MiB;
constexpr size_t WS_DWGU = 101 * MiB;
constexpr size_t WS_DWD = 145 * MiB;
constexpr size_t WS_MWGU = 167 * MiB;
constexpr size_t WS_MWD = 519 * MiB;
constexpr size_t WS_HRES = 695 * MiB;
constexpr size_t WS_H = 953 * MiB;
constexpr size_t WS_Z = 1082 * MiB;
constexpr size_t ZSTEP = (size_t)T * 1024 * 2;
constexpr size_t WS_Q = WS_Z, WS_K = WS_Z + ZSTEP, WS_V = WS_Z + 2 * ZSTEP, WS_U = WS_Z + 3 * ZSTEP, WS_G = WS_Z + 4 * ZSTEP;
constexpr size_t WS_Y = WS_K;
constexpr size_t WS_HID = WS_Z;
constexpr size_t WS_OUT2A = WS_WIN, WS_OUT2B = WS_H;
static_assert(WS_OUT2A + (size_t)T * 2048 * 2 <= WS_MWGU, "OUT2A over dead weights");
constexpr size_t WS_H8S = WS_Z + 368 * MiB;
constexpr size_t WS_END = WS_Z + 8 * ZSTEP;
static_assert(WS_MWD + (size_t)8 * 2048 * 5632 * 2 <= WS_HRES && WS_HRES + (size_t)T * 2048 * 4 <= WS_H && WS_H + (size_t)T * 2048 * 2 <= WS_Z, "ws map");
static_assert((size_t)MOE_MAXROWS * DFF <= 368 * MiB && WS_H8S + (size_t)MOE_MAXROWS * DM <= WS_END && (size_t)T * DFF * 2 <= 8 * ZSTEP, "hidden / gathered rows fit Z"); static_assert((size_t)MOE_MAXROWS * 4 <= 320 * 1024, "row tables");
constexpr int CW_BAR = 4096;
constexpr int CW_CNT = 8192;

typedef __bf16 bf16x2_t __attribute__((ext_vector_type(2)));
__device__ __forceinline__ unsigned cvt_pk_bf16(float lo, float hi) { const f32x2 v = {lo, hi}; const bf16x2_t b = __builtin_convertvector(v, bf16x2_t); return __builtin_bit_cast(unsigned, b); }
__device__ __forceinline__ float bf_lo(unsigned u) { return __uint_as_float(u << 16); }
__device__ __forceinline__ float bf_hi(unsigned u) { return __uint_as_float(u & 0xffff0000u); }
__device__ __forceinline__ float shfl_xor_l(float v, int o, int lane) { return __int_as_float(__builtin_amdgcn_ds_bpermute((lane ^ o) << 2, __float_as_int(v))); }
__device__ __forceinline__ float wave_sum(float v, int lane) {
#pragma unroll
    for (int o = 1; o < 64; o <<= 1) v += shfl_xor_l(v, o, lane);
    return v;
}
__device__ __forceinline__ float fast_sigmoid(float x) { return __builtin_amdgcn_rcpf(1.0f + __builtin_amdgcn_exp2f(-x * LOG2E)); }
constexpr float F8_SA = 16.0f, F8_SW = 256.0f, F8_SH = 8.0f;
__device__ __forceinline__ float f8_clamp(float x) { return __builtin_fminf(__builtin_fmaxf(x, -448.0f), 448.0f); }
__device__ __forceinline__ unsigned cvt4_fp8(float a, float b, float c, float d) {
    int r = __builtin_amdgcn_cvt_pk_fp8_f32(f8_clamp(a), f8_clamp(b), 0, false); r = __builtin_amdgcn_cvt_pk_fp8_f32(f8_clamp(c), f8_clamp(d), r, true); return (unsigned)r; }
#define NT_STORE16(p, v) __builtin_nontemporal_store((v), (u32x4*)(p))
#define LDS_WAIT() asm volatile("s_waitcnt lgkmcnt(0)" ::: "memory")
#define VM_WAIT() asm volatile("s_waitcnt vmcnt(0)" ::: "memory")

namespace pg8 {
constexpr int BM = 256, BK = 64, HALF = 128, HTB = HALF * BK * 2, STAGE_BYTES = 8 * HTB, NXCD = 8, WGM = 8;
__host__ __device__ __forceinline__ int lds_byte(int r, int c) { const int st = (r >> 4) * 2 + (c >> 5), rr = r & 15, cc = c & 31, ob = rr * 64 + cc * 2; return st * 1024 + (ob ^ (((ob >> 9) & 1) << 5)); }
__host__ __device__ __forceinline__ void stage_rc(int b, int& R, int& C) { const int st = b / 1024, sb = b % 1024, swz = sb ^ (((sb >> 9) & 1) << 5); R = (st >> 1) * 16 + swz / 64; C = (st & 1) * 32 + (swz % 64) / 2; }
__host__ __device__ __forceinline__ int perm32(int rho) { const int n = rho >> 4, i = rho & 15; return 8 * (i >> 2) + 4 * n + (i & 3); }

struct Unit { const char* a; const char* b; int pm, pn, aux; };
template <class E, class = void> struct epi_chain { static constexpr bool value = false; };
template <class E> struct epi_chain<E, decltype((void)E::CHAIN)> { static constexpr bool value = E::CHAIN; };

struct TileOrder {
    int nM, nN, nwg, G, c, pnfast;
    __device__ __forceinline__ void init(int nM_, int nN_, int G_, int c_, int pnfast_ = 0) { nM = nM_; nN = nN_; nwg = nM * nN; G = G_; c = c_; pnfast = pnfast_; }
    __device__ __forceinline__ bool tile(int i, int& pm, int& pn) const { return tileL((long)i * G + c, pm, pn); }
    __device__ __forceinline__ bool tileL(const long L, int& pm, int& pn) const {
        if (L >= nwg) return false;
        int wgid = (int)L; { const int q = nwg / NXCD, r = nwg % NXCD, xcd = wgid % NXCD, off = wgid / NXCD; wgid = (xcd < r ? xcd * (q + 1) : r * (q + 1) + (xcd - r) * q) + off; }
        const int nig = WGM * nN, gid = wgid / nig, fm = gid * WGM, gsz = (nM - fm) < WGM ? (nM - fm) : WGM;
        if (pnfast) { pn = (wgid % nig) % nN; pm = fm + (wgid % nig) / nN; }
        else { pm = fm + ((wgid % nig) % gsz); pn = (wgid % nig) / gsz; }
        return true;
    }
};

typedef int i32x8 __attribute__((ext_vector_type(8)));
template <class Epi, class Sched, bool GATHER, bool F8 = false>
__device__ __forceinline__ void gemm_phase(LAS unsigned char* lds, const int nt, const int ldaB, const int ldbB, const Sched& S, const Epi& E) {
    int tid_ = threadIdx.x; asm volatile("" : "+v"(tid_));
    const int tid = tid_, wid = __builtin_amdgcn_readfirstlane(tid >> 6), lane = tid & 63, wr = wid >> 2, wc = wid & 3, fr = lane & 15, fq = lane >> 4;
    unsigned voffA[2], voffB[2]; int RA[2], CA[2];
#pragma unroll
    for (int i = 0; i < 2; ++i) { int R, C; stage_rc(tid * 16 + i * 8192, R, C); const int Rb = Epi::PERM ? ((R & ~31) + perm32(R & 31)) : R;
        voffA[i] = (unsigned)(R * ldaB + C * 2); voffB[i] = (unsigned)(Rb * ldbB + C * 2); RA[i] = R; CA[i] = C * 2; }
    const size_t kstep = (size_t)(BK * 2);
    const size_t hstepA = (size_t)HALF * ldaB, hstepB = (size_t)HALF * ldbB;
    const unsigned ldsw = (unsigned)wid * 1024u;
    const int aoff = lds_byte(wr * 64 + fr, fq * 8), boff = lds_byte(wc * 32 + fr, fq * 8);
    unsigned cO[2][2], nO[2][2], sO[2][2];
#define PG8_SA(b, h) (((b) * 2 + (h)) * HTB)
#define PG8_SB(b, h) ((4 + (b) * 2 + (h)) * HTB)
#define PG8_STAGE_B(bufoff, gbase) do { _Pragma("unroll") for (int _i = 0; _i < 2; ++_i) \
        __builtin_amdgcn_global_load_lds((const unsigned*)((const char*)(gbase) + voffB[_i]), (LAS unsigned*)(lds + (bufoff) + ldsw + _i * 8192), 16, 0, 0); } while (0)
#define PG8_STAGE_A(bufoff, gbase, h, O) do { _Pragma("unroll") for (int _i = 0; _i < 2; ++_i) { \
        const char* _p = GATHER ? ((const char*)(gbase) + (O)[h][_i]) : ((const char*)(gbase) + (size_t)(h) * hstepA + voffA[_i]); \
        __builtin_amdgcn_global_load_lds((const unsigned*)_p, (LAS unsigned*)(lds + (bufoff) + ldsw + _i * 8192), 16, 0, 0); } } while (0)
#define PG8_LD16(off) (*(const LAS u32x4*)(lds + (off)))
#define PG8_CAT(lo, hi) __builtin_bit_cast(i32x8, __builtin_shufflevector(lo, hi, 0, 1, 2, 3, 4, 5, 6, 7))
#define PG8_LDA(dst, b, h) do { _Pragma("unroll") for (int m = 0; m < 4; ++m) { if constexpr (F8) dst##8[m] = PG8_CAT(PG8_LD16(PG8_SA(b, h) + aoff + m * 2048), PG8_LD16(PG8_SA(b, h) + aoff + m * 2048 + 1024)); \
        else { _Pragma("unroll") for (int k = 0; k < 2; ++k) dst[m][k] = *(const LAS bf16x8*)(lds + PG8_SA(b, h) + aoff + m * 2048 + k * 1024); } } } while (0)
#define PG8_LDB(dst, b, h) do { _Pragma("unroll") for (int n = 0; n < 2; ++n) { if constexpr (F8) dst##8[n] = PG8_CAT(PG8_LD16(PG8_SB(b, h) + boff + n * 2048), PG8_LD16(PG8_SB(b, h) + boff + n * 2048 + 1024)); \
        else { _Pragma("unroll") for (int k = 0; k < 2; ++k) dst[n][k] = *(const LAS bf16x8*)(lds + PG8_SB(b, h) + boff + n * 2048 + k * 1024); } } } while (0)
#define PG8_MMA(ai, bj, At, Bt) do { __builtin_amdgcn_s_setprio(1); _Pragma("unroll") for (int m = 0; m < 4; ++m) _Pragma("unroll") for (int n = 0; n < 2; ++n) { \
        if constexpr (F8) asm volatile("v_mfma_scale_f32_16x16x128_f8f6f4 %0, %1, %2, %0, %3, %3 op_sel_hi:[0,0,0]" : "+v"(acc[ai][bj][m][n]) : "v"(Bt##8[n]), "v"(At##8[m]), "v"(f8one));   \
        else { _Pragma("unroll") for (int k = 0; k < 2; ++k) acc[ai][bj][m][n] = __builtin_amdgcn_mfma_f32_16x16x32_bf16(Bt[n][k], At[m][k], acc[ai][bj][m][n], 0, 0, 0); } } \
        __builtin_amdgcn_s_setprio(0); } while (0)
#define PG8_WAIT_V(n) asm volatile("s_waitcnt vmcnt(" #n ")" ::: "memory")
#define PG8_WAIT_L(n) asm volatile("s_waitcnt lgkmcnt(" #n ")" ::: "memory")
#define PG8_BAR __builtin_amdgcn_s_barrier()
#define PG8_SCHED __builtin_amdgcn_sched_barrier(0)
#define PG8_ROWS(dst, u) do { const int* _rw = S.rows(u); _Pragma("unroll") for (int _h = 0; _h < 2; ++_h) _Pragma("unroll") for (int _i = 0; _i < 2; ++_i) { \
        int _t = _rw[_h * HALF + RA[_i]]; _t = _t < 0 ? 0 : (_t >= T ? T - 1 : _t); dst[_h][_i] = (unsigned)_t * (unsigned)ldaB + (unsigned)CA[_i]; } } while (0)
    Unit cur, nxt; int ui = 0;
    if (!S.next(0, cur)) return;
    f32x4 acc[2][2][4][2];
#pragma unroll
    for (int a = 0; a < 2; ++a)
#pragma unroll
        for (int b = 0; b < 2; ++b)
#pragma unroll
            for (int m = 0; m < 4; ++m)
#pragma unroll
                for (int n = 0; n < 2; ++n) acc[a][b][m][n] = (f32x4){0.f, 0.f, 0.f, 0.f};
    int f8one = 0x7F7F7F7F; asm volatile("" : "+v"(f8one));
    bf16x8 At[4][2], B0[2][2], B1[2][2]; i32x8 At8[4], B08[2], B18[2];
    const char* cA = cur.a; const char* cB = cur.b;
    if constexpr (GATHER) { PG8_ROWS(cO, cur); }
    PG8_STAGE_B(PG8_SB(0, 0), cB); PG8_STAGE_B(PG8_SB(0, 1), cB + hstepB); PG8_STAGE_A(PG8_SA(0, 0), cA, 0, cO); PG8_STAGE_A(PG8_SA(0, 1), cA, 1, cO);
    if (wr == 1) PG8_BAR;
    PG8_WAIT_V(2); PG8_BAR;
    PG8_STAGE_B(PG8_SB(1, 0), cB + kstep); PG8_STAGE_A(PG8_SA(1, 0), cA + kstep, 0, cO); PG8_STAGE_B(PG8_SB(1, 1), cB + hstepB + kstep);
    PG8_WAIT_V(6); PG8_BAR;
    for (;;) {
        const bool has_next = S.next(ui + 1, nxt);
        const char* nA = has_next ? nxt.a : cA; const char* nB = has_next ? nxt.b : cB;
        if constexpr (GATHER) { if (has_next) { PG8_ROWS(nO, nxt); } else {
#pragma unroll
            for (int h = 0; h < 2; ++h)
#pragma unroll
                for (int i = 0; i < 2; ++i) nO[h][i] = cO[h][i]; } }
        for (int t = 0; t < nt; t += 2) {
            const bool last = (t == nt - 2);
            const char* a1 = cA + (size_t)(t + 1) * kstep;
            const char* a2 = last ? nA : cA + (size_t)(t + 2) * kstep; const char* b2 = last ? nB : cB + (size_t)(t + 2) * kstep;
            const char* a3 = a2 + kstep; const char* b3 = b2 + kstep;
            if constexpr (GATHER) {
#pragma unroll
                for (int h = 0; h < 2; ++h)
#pragma unroll
                    for (int i = 0; i < 2; ++i) sO[h][i] = last ? nO[h][i] : cO[h][i]; }
            PG8_LDB(B0, 0, 0); PG8_LDB(B1, 0, 1); PG8_SCHED; PG8_LDA(At, 0, 0); PG8_STAGE_A(PG8_SA(1, 1), a1, 1, cO);
            PG8_WAIT_V(8); PG8_WAIT_L(0); PG8_BAR; PG8_MMA(0, 0, At, B0); PG8_MMA(0, 1, At, B1); PG8_BAR; PG8_SCHED;
            PG8_LDA(At, 0, 1); PG8_STAGE_B(PG8_SB(0, 0), b2); PG8_STAGE_B(PG8_SB(0, 1), b2 + hstepB); PG8_STAGE_A(PG8_SA(0, 0), a2, 0, sO);
            PG8_WAIT_V(8); PG8_WAIT_L(0); PG8_BAR; PG8_MMA(1, 0, At, B0); PG8_MMA(1, 1, At, B1); PG8_BAR; PG8_SCHED;
            PG8_LDB(B0, 1, 0); PG8_LDB(B1, 1, 1); PG8_SCHED; PG8_LDA(At, 1, 0); PG8_STAGE_A(PG8_SA(0, 1), a2, 1, sO);
            PG8_WAIT_V(8); PG8_WAIT_L(0); PG8_BAR; PG8_MMA(0, 0, At, B0); PG8_MMA(0, 1, At, B1); PG8_BAR; PG8_SCHED;
            PG8_LDA(At, 1, 1); PG8_STAGE_B(PG8_SB(1, 0), b3); PG8_STAGE_B(PG8_SB(1, 1), b3 + hstepB); PG8_STAGE_A(PG8_SA(1, 0), a3, 0, sO);
            PG8_WAIT_V(8); PG8_WAIT_L(0); PG8_BAR; PG8_MMA(1, 0, At, B0); PG8_MMA(1, 1, At, B1); PG8_BAR; PG8_SCHED;
        }
        if (wr == 0) PG8_BAR;
        if constexpr (F8) asm volatile("s_nop 15\n\ts_nop 15" ::: "memory");
        bool keep = false;
        if constexpr (epi_chain<Epi>::value) { if (cur.aux == 0) { E.mid(acc, cur, wr, wc, fr, fq); keep = true; } else E(acc, cur, wr, wc, fr, fq); }
        else E(acc, cur, wr, wc, fr, fq);
        if (!has_next) break;
        if (!keep) {
#pragma unroll
        for (int a = 0; a < 2; ++a)
#pragma unroll
            for (int b = 0; b < 2; ++b)
#pragma unroll
                for (int m = 0; m < 4; ++m)
#pragma unroll
                    for (int n = 0; n < 2; ++n) acc[a][b][m][n] = (f32x4){0.f, 0.f, 0.f, 0.f}; }
        cur = nxt; cA = nA; cB = nB; ++ui;
        if constexpr (GATHER) {
#pragma unroll
            for (int h = 0; h < 2; ++h)
#pragma unroll
                for (int i = 0; i < 2; ++i) cO[h][i] = nO[h][i]; }
        if (wr == 1) PG8_BAR;
    }
    PG8_WAIT_V(0);
    PG8_BAR;
#undef PG8_SA
#undef PG8_SB
#undef PG8_STAGE_A
#undef PG8_STAGE_B
#undef PG8_LDA
#undef PG8_LDB
#undef PG8_MMA
#undef PG8_CAT
#undef PG8_LD16
#undef PG8_WAIT_V
#undef PG8_WAIT_L
#undef PG8_BAR
#undef PG8_SCHED
#undef PG8_ROWS
}
}

using pg8::Unit;
typedef f32x4 Acc[2][2][4][2];

struct EpiIn {
    static constexpr bool PERM = true;
    bf16_t *Q, *Kb, *V, *U, *G; const float* bgate; const float* rope;
    __device__ __forceinline__ void operator()(const Acc& acc, const Unit& u, int wr, int wc, int fr, int fq) const {
        const int row0 = u.pm * 256 + wr * 64 + fr;
        if (u.pn < 8) {
            bf16_t* base = u.pn < 4 ? Q : Kb; const float sc = u.pn < 4 ? QSCALE : 1.0f; const int ct = (u.pn & 3) * 256 + wc * 64 + 8 * fq;
            f32x4 cs[2][2][4];
#define ROPE_LD(bf, st) do { _Pragma("unroll") for (int g = 0; g < 2; ++g) { const int gi = (st) * 2 + g, row = row0 + (gi >> 2) * 128 + (gi & 3) * 16; const float* tb = rope + row_pos(row) * 64 + 8 * fq; \
                cs[bf][g][0] = *(const f32x4*)tb; cs[bf][g][1] = *(const f32x4*)(tb + 4); cs[bf][g][2] = *(const f32x4*)(tb + 32); cs[bf][g][3] = *(const f32x4*)(tb + 36); } } while (0)
#define ROPE_DO(bf, st) do { _Pragma("unroll") for (int g = 0; g < 2; ++g) { const int gi = (st) * 2 + g, ai = gi >> 2, m = gi & 3, row = row0 + ai * 128 + m * 16; \
                const f32x4 c0 = cs[bf][g][0], c1 = cs[bf][g][1], s0 = cs[bf][g][2], s1 = cs[bf][g][3]; \
                const f32x4 t1a = acc[ai][0][m][0], t1b = acc[ai][0][m][1], t2a = acc[ai][1][m][0], t2b = acc[ai][1][m][1]; \
                const f32x4 o1a = (t1a * c0 - t2a * s0) * sc, o1b = (t1b * c1 - t2b * s1) * sc, o2a = (t2a * c0 + t1a * s0) * sc, o2b = (t2b * c1 + t1b * s1) * sc; \
                u32x4 w1, w2; w1.x = cvt_pk_bf16(o1a[0], o1a[1]); w1.y = cvt_pk_bf16(o1a[2], o1a[3]); w1.z = cvt_pk_bf16(o1b[0], o1b[1]); w1.w = cvt_pk_bf16(o1b[2], o1b[3]); \
                w2.x = cvt_pk_bf16(o2a[0], o2a[1]); w2.y = cvt_pk_bf16(o2a[2], o2a[3]); w2.z = cvt_pk_bf16(o2b[0], o2b[1]); w2.w = cvt_pk_bf16(o2b[2], o2b[3]); \
                bf16_t* rp = base + (size_t)row * 1024 + ct; NT_STORE16(rp, w1); NT_STORE16(rp + 32, w2); } } while (0)
            ROPE_LD(0, 0); ROPE_LD(1, 1); __builtin_amdgcn_sched_barrier(0);
            ROPE_DO(0, 0); __builtin_amdgcn_sched_barrier(0); ROPE_LD(0, 2); __builtin_amdgcn_sched_barrier(0);
            ROPE_DO(1, 1); __builtin_amdgcn_sched_barrier(0); ROPE_LD(1, 3); __builtin_amdgcn_sched_barrier(0);
            ROPE_DO(0, 2); __builtin_amdgcn_sched_barrier(0); ROPE_DO(1, 3);
#undef ROPE_LD
#undef ROPE_DO
        } else if (u.pn < 16) {
            bf16_t* base = u.pn < 12 ? V : U; const int ct = (u.pn & 3) * 256 + wc * 32 + 8 * fq;
#pragma unroll
            for (int ai = 0; ai < 2; ++ai)
#pragma unroll
                for (int m = 0; m < 4; ++m) { bf16_t* rp = base + (size_t)(row0 + ai * 128 + m * 16) * 1024 + ct;
#pragma unroll
                    for (int bj = 0; bj < 2; ++bj) { const f32x4 v0 = acc[ai][bj][m][0], v1 = acc[ai][bj][m][1];
                        u32x4 w; w.x = cvt_pk_bf16(v0[0], v0[1]); w.y = cvt_pk_bf16(v0[2], v0[3]); w.z = cvt_pk_bf16(v1[0], v1[1]); w.w = cvt_pk_bf16(v1[2], v1[3]);
                        NT_STORE16(rp + bj * 128, w); } }
        } else {
            const int ct = (u.pn - 16) * 128 + wc * 32 + 8 * fq;
            float nba[8], nbp[8];
#pragma unroll
            for (int n = 0; n < 2; ++n) { const f32x4 a_ = *(const f32x4*)(bgate + ct + 4 * n), p_ = *(const f32x4*)(bgate + 2048 + ct + 4 * n);
#pragma unroll
                for (int j = 0; j < 4; ++j) { nba[n * 4 + j] = a_[j] * -LOG2E; nbp[n * 4 + j] = p_[j] * -LOG2E; } }
#pragma unroll
            for (int ai = 0; ai < 2; ++ai)
#pragma unroll
                for (int m = 0; m < 4; ++m) { bf16_t* rp = G + (size_t)(row0 + ai * 128 + m * 16) * 4096 + ct;
                    float ea[8], ep[8], sp[8];
#pragma unroll
                    for (int j = 0; j < 8; ++j) { ea[j] = __builtin_fmaf(acc[ai][0][m][j >> 2][j & 3], -LOG2E, nba[j]); ep[j] = __builtin_fmaf(acc[ai][1][m][j >> 2][j & 3], -LOG2E, nbp[j]); }
                    __builtin_amdgcn_sched_barrier(0);
#pragma unroll
                    for (int j = 0; j < 8; ++j) { ea[j] = __builtin_amdgcn_exp2f(ea[j]); ep[j] = __builtin_amdgcn_exp2f(ep[j]); }
                    __builtin_amdgcn_sched_barrier(0);
#pragma unroll
                    for (int j = 0; j < 8; ++j) { ea[j] += 1.0f; ep[j] += 1.0f; }
                    __builtin_amdgcn_sched_barrier(0);
#pragma unroll
                    for (int j = 0; j < 8; ++j) { ea[j] = __builtin_amdgcn_rcpf(ea[j]); sp[j] = __builtin_amdgcn_rcpf(ep[j]); }
                    __builtin_amdgcn_sched_barrier(0);
#pragma unroll
                    for (int j = 0; j < 8; ++j) ea[j] *= ep[j];
                    u32x4 w0, w1; w0.x = cvt_pk_bf16(ea[0], ea[1]); w0.y = cvt_pk_bf16(ea[2], ea[3]); w0.z = cvt_pk_bf16(ea[4], ea[5]); w0.w = cvt_pk_bf16(ea[6], ea[7]);
                    w1.x = cvt_pk_bf16(sp[0], sp[1]); w1.y = cvt_pk_bf16(sp[2], sp[3]); w1.z = cvt_pk_bf16(sp[4], sp[5]); w1.w = cvt_pk_bf16(sp[6], sp[7]);
                    NT_STORE16(rp, w0); NT_STORE16(rp + 2048, w1); }
        }
    }
};
struct SchedIn {
    pg8::TileOrder o; const char* A; const char* B;
    __device__ __forceinline__ bool next(int i, Unit& u) const { int pm, pn; if (!o.tile(i, pm, pn)) return false;
        u.pm = pm; u.pn = pn; u.aux = 0; u.a = A + (size_t)pm * 256 * 2048 * 2; u.b = B + (size_t)pn * 256 * 2048 * 2; return true; }
    __device__ __forceinline__ const int* rows(const Unit&) const { return nullptr; }
};

struct SchedInA {
    pg8::TileOrder o; const char* A; const char* B;
    __device__ __forceinline__ bool next(int i, Unit& u) const { int pm, pn;
        if (!o.tile(i, pm, pn)) { const long j = (long)i * o.G + o.c - o.nwg; if (j >= 32) return false; pm = NPAN - 1; pn = (int)j; }
        u.pm = pm; u.pn = pn; u.aux = 0; u.a = A + (size_t)pm * 256 * 2048 * 2; u.b = B + (size_t)pn * 256 * 2048 * 2; return true; }
    __device__ __forceinline__ const int* rows(const Unit&) const { return nullptr; }
};
struct SchedIn8 {
    pg8::TileOrder o; const char* A; const char* B;
    __device__ __forceinline__ bool next(int i, Unit& u) const { int pm, pn; long L;
        if (o.G == 256 && o.nwg == 2048) { if (o.c >= 32) { L = (long)i * 224 + (o.c - 32); if (L >= 2048 - 192) return false; } else { if (i >= 6) return false; L = 2048 - 192 + i * 32 + o.c; } }
        else L = (long)i * o.G + o.c;
        if (!o.tileL(L, pm, pn)) return false;
        u.pm = pm; u.pn = pn; u.aux = 0; u.a = A + (size_t)pm * 256 * 2048; u.b = B + (size_t)pn * 256 * 2048; return true; }
    __device__ __forceinline__ const int* rows(const Unit&) const { return nullptr; }
};
struct EpiGate8 {
    static constexpr bool PERM = true;
    bf16_t* G; const float* bgate;
    __device__ __forceinline__ void operator()(const Acc& acc, const Unit& u, int wr, int wc, int fr, int fq) const {
        const int row0 = u.pm * 256 + wr * 64 + fr, ct = u.pn * 128 + wc * 32 + 8 * fq; constexpr float NS = -LOG2E / (F8_SA * F8_SW);
        float nba[8], nbp[8];
#pragma unroll
        for (int n = 0; n < 2; ++n) { const f32x4 a_ = *(const f32x4*)(bgate + ct + 4 * n), p_ = *(const f32x4*)(bgate + 2048 + ct + 4 * n);
#pragma unroll
            for (int j = 0; j < 4; ++j) { nba[n * 4 + j] = a_[j] * -LOG2E; nbp[n * 4 + j] = p_[j] * -LOG2E; } }
#pragma unroll
        for (int ai = 0; ai < 2; ++ai)
#pragma unroll
            for (int m = 0; m < 4; ++m) { bf16_t* rp = G + (size_t)(row0 + ai * 128 + m * 16) * 4096 + ct;
                float ea[8], ep[8], sp[8];
#pragma unroll
                for (int j = 0; j < 8; ++j) { ea[j] = __builtin_fmaf(acc[ai][0][m][j >> 2][j & 3], NS, nba[j]); ep[j] = __builtin_fmaf(acc[ai][1][m][j >> 2][j & 3], NS, nbp[j]); }
                __builtin_amdgcn_sched_barrier(0);
#pragma unroll
                for (int j = 0; j < 8; ++j) { ea[j] = __builtin_amdgcn_exp2f(ea[j]); ep[j] = __builtin_amdgcn_exp2f(ep[j]); }
                __builtin_amdgcn_sched_barrier(0);
#pragma unroll
                for (int j = 0; j < 8; ++j) { ea[j] += 1.0f; ep[j] += 1.0f; }
                __builtin_amdgcn_sched_barrier(0);
#pragma unroll
                for (int j = 0; j < 8; ++j) { ea[j] = __builtin_amdgcn_rcpf(ea[j]); sp[j] = __builtin_amdgcn_rcpf(ep[j]); }
                __builtin_amdgcn_sched_barrier(0);
#pragma unroll
                for (int j = 0; j < 8; ++j) ea[j] *= ep[j];
                u32x4 w0, w1; w0.x = cvt_pk_bf16(ea[0], ea[1]); w0.y = cvt_pk_bf16(ea[2], ea[3]); w0.z = cvt_pk_bf16(ea[4], ea[5]); w0.w = cvt_pk_bf16(ea[6], ea[7]);
                w1.x = cvt_pk_bf16(sp[0], sp[1]); w1.y = cvt_pk_bf16(sp[2], sp[3]); w1.z = cvt_pk_bf16(sp[4], sp[5]); w1.w = cvt_pk_bf16(sp[6], sp[7]);
                NT_STORE16(rp, w0); NT_STORE16(rp + 2048, w1); }
    }
};

struct EpiY {
    static constexpr bool PERM = true, CHAIN = true;
    bf16_t* Y; const bf16_t* G;
    __device__ __forceinline__ void mid(Acc& acc, const Unit& u, int wr, int wc, int fr, int fq) const {
        const int row0 = u.pm * 256 + wr * 64 + fr, ct = u.pn * 256 + wc * 32 + 8 * fq;
        u32x4 g[2][4][2];
#pragma unroll
        for (int ai = 0; ai < 2; ++ai)
#pragma unroll
            for (int m = 0; m < 4; ++m)
#pragma unroll
                for (int bj = 0; bj < 2; ++bj) g[ai][m][bj] = *(const u32x4*)(G + (size_t)(row0 + ai * 128 + m * 16) * 4096 + ct + bj * 128);
        __builtin_amdgcn_sched_barrier(0);
#pragma unroll
        for (int ai = 0; ai < 2; ++ai)
#pragma unroll
            for (int m = 0; m < 4; ++m)
#pragma unroll
                for (int bj = 0; bj < 2; ++bj) { const u32x4 gg = g[ai][m][bj];
                    f32x4& v0 = acc[ai][bj][m][0]; f32x4& v1 = acc[ai][bj][m][1];
                    v0[0] *= bf_lo(gg.x); v0[1] *= bf_hi(gg.x); v0[2] *= bf_lo(gg.y); v0[3] *= bf_hi(gg.y); v1[0] *= bf_lo(gg.z); v1[1] *= bf_hi(gg.z); v1[2] *= bf_lo(gg.w); v1[3] *= bf_hi(gg.w); }
    }
    __device__ __forceinline__ void operator()(const Acc& acc, const Unit& u, int wr, int wc, int fr, int fq) const {
        const int row0 = u.pm * 256 + wr * 64 + fr, ct = u.pn * 256 + wc * 32 + 8 * fq;
        u32x4 g[2][4][2];
#pragma unroll
        for (int ai = 0; ai < 2; ++ai)
#pragma unroll
            for (int m = 0; m < 4; ++m)
#pragma unroll
                for (int bj = 0; bj < 2; ++bj) g[ai][m][bj] = *(const u32x4*)(G + (size_t)(row0 + ai * 128 + m * 16) * 4096 + 2048 + ct + bj * 128);
        __builtin_amdgcn_sched_barrier(0);
#pragma unroll
        for (int ai = 0; ai < 2; ++ai)
#pragma unroll
            for (int m = 0; m < 4; ++m) { const size_t row = (size_t)(row0 + ai * 128 + m * 16);
#pragma unroll
                for (int bj = 0; bj < 2; ++bj) { const u32x4 gg = g[ai][m][bj];
                    f32x4 v0 = acc[ai][bj][m][0], v1 = acc[ai][bj][m][1];
                    v0[0] *= bf_lo(gg.x); v0[1] *= bf_hi(gg.x); v0[2] *= bf_lo(gg.y); v0[3] *= bf_hi(gg.y); v1[0] *= bf_lo(gg.z); v1[1] *= bf_hi(gg.z); v1[2] *= bf_lo(gg.w); v1[3] *= bf_hi(gg.w);
                    u32x4 w; w.x = cvt_pk_bf16(v0[0], v0[1]); w.y = cvt_pk_bf16(v0[2], v0[3]); w.z = cvt_pk_bf16(v1[0], v1[1]); w.w = cvt_pk_bf16(v1[2], v1[3]);
                    *(u32x4*)(Y + row * 2048 + ct + bj * 128) = w; } }
    }
};
struct SchedY {
    pg8::TileOrder o; const char* A0; const char* A1; const char* B0; const char* B1;
    __device__ __forceinline__ bool next(int i, Unit& u) const { int pm, pn; if (!o.tile(i >> 1, pm, pn)) return false;
        u.pm = pm; u.pn = pn; u.aux = i & 1; u.a = ((i & 1) ? A1 : A0) + (size_t)pm * 256 * 1024 * 2; u.b = ((i & 1) ? B1 : B0) + (size_t)pn * 256 * 1024 * 2; return true; }
    __device__ __forceinline__ const int* rows(const Unit&) const { return nullptr; }
};

struct EpiRes {
    static constexpr bool PERM = false;
    float* HR; float sc;
    __device__ __forceinline__ void operator()(const Acc& acc, const Unit& u, int wr, int wc, int fr, int fq) const {
        const int row0 = u.pm * 256 + wr * 64 + fr, col0 = u.pn * 256 + wc * 32 + 4 * fq;
#pragma unroll
        for (int ai = 0; ai < 2; ++ai)
#pragma unroll
            for (int m = 0; m < 4; ++m) { float* rp = HR + (size_t)(row0 + ai * 128 + m * 16) * 2048 + col0;
#pragma unroll
                for (int bj = 0; bj < 2; ++bj)
#pragma unroll
                    for (int n = 0; n < 2; ++n) { f32x4* p = (f32x4*)(rp + bj * 128 + n * 16); *p = *p + acc[ai][bj][m][n] * sc; } }
    }
};
struct EpiDelta {
    static constexpr bool PERM = true;
    bf16_t* D; float sc;
    __device__ __forceinline__ void operator()(const Acc& acc, const Unit& u, int wr, int wc, int fr, int fq) const {
        const int row0 = u.pm * 256 + wr * 64 + fr, col0 = u.pn * 256 + wc * 32 + 8 * fq;
#pragma unroll
        for (int ai = 0; ai < 2; ++ai)
#pragma unroll
            for (int m = 0; m < 4; ++m) { bf16_t* rp = D + (size_t)(row0 + ai * 128 + m * 16) * 2048 + col0;
#pragma unroll
                for (int bj = 0; bj < 2; ++bj) { const f32x4 v0 = acc[ai][bj][m][0] * sc, v1 = acc[ai][bj][m][1] * sc;
                    u32x4 o; o.x = cvt_pk_bf16(v0[0], v0[1]); o.y = cvt_pk_bf16(v0[2], v0[3]); o.z = cvt_pk_bf16(v1[0], v1[1]); o.w = cvt_pk_bf16(v1[2], v1[3]);
                    NT_STORE16(rp + bj * 128, o); } }
    }
};
struct SchedPlain {
    pg8::TileOrder o; const char* A; const char* B; size_t astep, bstep;
    __device__ __forceinline__ bool next(int i, Unit& u) const { int pm, pn; if (!o.tile(i, pm, pn)) return false;
        u.pm = pm; u.pn = pn; u.aux = 0; u.a = A + (size_t)pm * astep; u.b = B + (size_t)pn * bstep; return true; }
    __device__ __forceinline__ const int* rows(const Unit&) const { return nullptr; }
};

struct EpiSwi {
    static constexpr bool PERM = true;
    bf16_t* HID;
    __device__ __forceinline__ void operator()(const Acc& acc, const Unit& u, int wr, int wc, int fr, int fq) const {
        const int row0 = u.pm * 256 + wr * 64 + fr, ct = u.pn * 128 + wc * 32 + 8 * fq;
#pragma unroll
        for (int ai = 0; ai < 2; ++ai)
#pragma unroll
            for (int m = 0; m < 4; ++m) { f32x4 h0, h1; const f32x4 g0 = acc[ai][0][m][0], g1 = acc[ai][0][m][1], u0 = acc[ai][1][m][0], u1 = acc[ai][1][m][1];
#pragma unroll
                for (int j = 0; j < 4; ++j) { h0[j] = g0[j] * fast_sigmoid(g0[j]) * u0[j]; h1[j] = g1[j] * fast_sigmoid(g1[j]) * u1[j]; }
                u32x4 w; w.x = cvt_pk_bf16(h0[0], h0[1]); w.y = cvt_pk_bf16(h0[2], h0[3]); w.z = cvt_pk_bf16(h1[0], h1[1]); w.w = cvt_pk_bf16(h1[2], h1[3]);
                *(u32x4*)(HID + (size_t)(row0 + ai * 128 + m * 16) * DFF + ct) = w; }
    }
};
struct EpiSwi8 {
    static constexpr bool PERM = true;
    unsigned char* HID8;
    __device__ __forceinline__ void operator()(const Acc& acc, const Unit& u, int wr, int wc, int fr, int fq) const {
        const int row0 = u.pm * 256 + wr * 64 + fr, ct = u.pn * 128 + wc * 32 + 8 * fq;
        constexpr float dq = 1.0f / (F8_SA * F8_SW), C = 1.0f / (dq * dq * F8_SH);
#pragma unroll
        for (int ai = 0; ai < 2; ++ai)
#pragma unroll
            for (int m = 0; m < 4; ++m) { float t[8], p[8];
#pragma unroll
                for (int j = 0; j < 8; ++j) t[j] = acc[ai][0][m][j >> 2][j & 3] * (-LOG2E * dq);
                __builtin_amdgcn_sched_barrier(0);
#pragma unroll
                for (int j = 0; j < 8; ++j) t[j] = __builtin_amdgcn_exp2f(t[j]);
#pragma unroll
                for (int j = 0; j < 8; ++j) p[j] = acc[ai][0][m][j >> 2][j & 3] * acc[ai][1][m][j >> 2][j & 3];
                __builtin_amdgcn_sched_barrier(0);
#pragma unroll
                for (int j = 0; j < 8; ++j) t[j] = __builtin_fmaf(t[j], C, C);
                __builtin_amdgcn_sched_barrier(0);
#pragma unroll
                for (int j = 0; j < 8; ++j) t[j] = __builtin_amdgcn_rcpf(t[j]);
                __builtin_amdgcn_sched_barrier(0);
#pragma unroll
                for (int j = 0; j < 8; ++j) p[j] *= t[j];
                u32x2 w; w.x = cvt4_fp8(p[0], p[1], p[2], p[3]); w.y = cvt4_fp8(p[4], p[5], p[6], p[7]);
                *(u32x2*)(HID8 + (size_t)(row0 + ai * 128 + m * 16) * DFF + ct) = w; }
    }
};
struct MoeMap { int pb[9]; };
__device__ __forceinline__ int moe_expert(const MoeMap& mm, int pm) { int e = 0;
#pragma unroll
    for (int j = 1; j < 8; ++j) e += (pm >= mm.pb[j]) ? 1 : 0;
    return e; }
struct SchedMoeUp {
    pg8::TileOrder o; const char* A; const char* B; MoeMap mm;
    __device__ __forceinline__ bool next(int i, Unit& u) const { int pm, pn; if (!o.tile(i, pm, pn)) return false;
        u.pm = pm; u.pn = pn; u.aux = 0; u.a = A + (size_t)pm * 256 * DM; u.b = B + (size_t)moe_expert(mm, pm) * ((size_t)NHID2 * DM) + (size_t)pn * 256 * DM; return true; }
    __device__ __forceinline__ const int* rows(const Unit&) const { return nullptr; }
};
struct SchedMoeDown {
    pg8::TileOrder o; const char* A; const char* B; MoeMap mm;
    __device__ __forceinline__ bool next(int i, Unit& u) const { int pm, pn; if (!o.tile(i, pm, pn)) return false;
        u.pm = pm; u.pn = pn; u.aux = 0; u.a = A + (size_t)pm * 256 * DFF; u.b = B + (size_t)moe_expert(mm, pm) * ((size_t)DM * DFF) + (size_t)pn * 256 * DFF; return true; }
    __device__ __forceinline__ const int* rows(const Unit&) const { return nullptr; }
};
struct EpiMoeDown {
    static constexpr bool PERM = true;
    bf16_t* O2A; bf16_t* O2B; const int* rowl; const float* roww; float sc;
    __device__ __forceinline__ void operator()(const Acc& acc, const Unit& u, int wr, int wc, int fr, int fq) const {
        const int row0 = u.pm * 256 + wr * 64 + fr, col0 = u.pn * 256 + wc * 32 + 8 * fq;
        int tvs[8]; float wvs[8];
#pragma unroll
        for (int i = 0; i < 8; ++i) { const int sr = row0 + (i >> 2) * 128 + (i & 3) * 16; tvs[i] = rowl[sr]; wvs[i] = roww[sr]; }
        __builtin_amdgcn_sched_barrier(0);
#pragma unroll
        for (int ai = 0; ai < 2; ++ai)
#pragma unroll
            for (int m = 0; m < 4; ++m) { const int tv = tvs[ai * 4 + m]; const int tok = tv & 0x3fffffff; const float w = wvs[ai * 4 + m] * sc;
                if (tv >= 0 && tok < T) { bf16_t* rp = ((tv >> 30) ? O2B : O2A) + (size_t)tok * 2048 + col0;
#pragma unroll
                    for (int bj = 0; bj < 2; ++bj) { const f32x4 v0 = acc[ai][bj][m][0] * w, v1 = acc[ai][bj][m][1] * w;
                        u32x4 o; o.x = cvt_pk_bf16(v0[0], v0[1]); o.y = cvt_pk_bf16(v0[2], v0[3]); o.z = cvt_pk_bf16(v1[0], v1[1]); o.w = cvt_pk_bf16(v1[2], v1[3]);
                        NT_STORE16(rp + bj * 128, o); } } }
    }
};

namespace att {
constexpr int SHM_V = 16384, SHM_K = 8192;
constexpr int OFF_V = 0, OFF_K = 32768, OFF_WS = 49152, OFF_ST = 51200, LDS_BYTES = OFF_ST + 65536;
constexpr int NT = 33;
constexpr float THR2 = 11.5f;
#define SBAR() __builtin_amdgcn_sched_barrier(0)
__device__ __forceinline__ int kswz(int row, int ch) { return row * 128 + ((ch ^ ((row >> 1) & 7)) << 4); }
__device__ __forceinline__ int crow(int r, int hi) { return (r & 3) + 8 * (r >> 2) + 4 * hi; }
__device__ __forceinline__ void partialSM(f32x16& p0, f32x16& p1, float& m_reg, float& alpha) {
    float pmax = p0[0];
#pragma unroll
    for (int r = 1; r < 16; ++r) pmax = fmaxf(pmax, p0[r]);
#pragma unroll
    for (int r = 0; r < 16; ++r) pmax = fmaxf(pmax, p1[r]);
    { auto rr = __builtin_amdgcn_permlane32_swap(__float_as_uint(pmax), __float_as_uint(pmax), false, false); pmax = fmaxf(__uint_as_float(rr[0]), __uint_as_float(rr[1])); }
    float mn;
    if (__builtin_expect(__all(pmax - m_reg <= THR2), 1)) { mn = m_reg; alpha = 1.f; }
    else { mn = fmaxf(m_reg, pmax); alpha = __builtin_amdgcn_exp2f(m_reg - mn); m_reg = mn; }
#pragma unroll
    for (int r = 0; r < 16; ++r) { p0[r] -= mn; p1[r] -= mn; }
#pragma unroll
    for (int r = 0; r < 16; ++r) p0[r] = __builtin_amdgcn_exp2f(p0[r]);
}
__device__ __forceinline__ void finishSM(f32x16& p0, f32x16& p1, float alpha, float& l_reg, bf16x8& pa0, bf16x8& pa1, bf16x8& pa2, bf16x8& pa3) {
#pragma unroll
    for (int r = 0; r < 16; ++r) p1[r] = __builtin_amdgcn_exp2f(p1[r]);
    float ps = 0;
#pragma unroll
    for (int r = 0; r < 16; ++r) ps += p0[r];
#pragma unroll
    for (int r = 0; r < 16; ++r) ps += p1[r];
    { auto rr = __builtin_amdgcn_permlane32_swap(__float_as_uint(ps), __float_as_uint(ps), false, false); ps = __uint_as_float(rr[0]) + __uint_as_float(rr[1]); }
    l_reg = l_reg * alpha + ps;
#define PK4(P, BASE, OUT) do { unsigned a0 = cvt_pk_bf16(P[BASE + 0], P[BASE + 1]), a1 = cvt_pk_bf16(P[BASE + 2], P[BASE + 3]);   \
    unsigned b0 = cvt_pk_bf16(P[BASE + 4], P[BASE + 5]), b1 = cvt_pk_bf16(P[BASE + 6], P[BASE + 7]);                              \
    auto r0 = __builtin_amdgcn_permlane32_swap(a0, b0, false, false); auto r1 = __builtin_amdgcn_permlane32_swap(a1, b1, false, false); \
    u32x4 w = {r0[0], r1[0], r0[1], r1[1]}; OUT = __builtin_bit_cast(bf16x8, w); } while (0)
    PK4(p0, 0, pa0); PK4(p0, 8, pa1); PK4(p1, 0, pa2); PK4(p1, 8, pa3);
#undef PK4
}
__device__ __forceinline__ void exp_first(f32x16& p0, f32x16& p1, float m_reg) {
#pragma unroll
    for (int r = 0; r < 16; ++r) { p0[r] -= m_reg; p1[r] -= m_reg; }
#pragma unroll
    for (int r = 0; r < 16; ++r) p0[r] = __builtin_amdgcn_exp2f(p0[r]);
}
__device__ __forceinline__ float exp_second_sum(f32x16& p0, f32x16& p1) {
#pragma unroll
    for (int r = 0; r < 16; ++r) p1[r] = __builtin_amdgcn_exp2f(p1[r]);
    float ps = 0;
#pragma unroll
    for (int r = 0; r < 16; ++r) ps += p0[r];
#pragma unroll
    for (int r = 0; r < 16; ++r) ps += p1[r];
    { auto rr = __builtin_amdgcn_permlane32_swap(__float_as_uint(ps), __float_as_uint(ps), false, false); ps = __uint_as_float(rr[0]) + __uint_as_float(rr[1]); }
    return ps;
}
__device__ __forceinline__ void pack_p(const f32x16& p0, const f32x16& p1, bf16x8& pa0, bf16x8& pa1, bf16x8& pa2, bf16x8& pa3) {
#define PK4(P, BASE, OUT) do { unsigned a0 = cvt_pk_bf16(P[BASE + 0], P[BASE + 1]), a1 = cvt_pk_bf16(P[BASE + 2], P[BASE + 3]);   \
    unsigned b0 = cvt_pk_bf16(P[BASE + 4], P[BASE + 5]), b1 = cvt_pk_bf16(P[BASE + 6], P[BASE + 7]);                              \
    auto r0 = __builtin_amdgcn_permlane32_swap(a0, b0, false, false); auto r1 = __builtin_amdgcn_permlane32_swap(a1, b1, false, false); \
    u32x4 w = {r0[0], r1[0], r0[1], r1[1]}; OUT = __builtin_bit_cast(bf16x8, w); } while (0)
    PK4(p0, 0, pa0); PK4(p0, 8, pa1); PK4(p1, 0, pa2); PK4(p1, 8, pa3);
#undef PK4
}
__device__ __forceinline__ void qkt(f32x16& p0, f32x16& p1, const LAS unsigned char* Ks, const bf16x8* qr, int r32, int hi) {
    p0 = f32x16{}; p1 = f32x16{};
#pragma unroll
    for (int d0 = 0; d0 < 4; ++d0) {
        const bf16x8 b0 = *(const LAS bf16x8*)(Ks + kswz(r32, d0 * 2 + hi));
        const bf16x8 b1 = *(const LAS bf16x8*)(Ks + kswz(32 + r32, d0 * 2 + hi));
        p0 = __builtin_amdgcn_mfma_f32_32x32x16_bf16(b0, qr[d0], p0, 0, 0, 0);
        p1 = __builtin_amdgcn_mfma_f32_32x32x16_bf16(b1, qr[d0], p1, 0, 0, 0); }
}
__device__ __forceinline__ int v_st(int k, int c) { const int kk = (k & ~0xC) | ((k & 4) << 1) | ((k & 8) >> 1); return ((kk >> 3) * 4 + (c >> 5)) * 512 + ((kk & 7) * 32 + (c & 31)) * 2; }
__device__ __forceinline__ int v_rd_base(int lane) { return ((lane & 3) << 3) | (((lane >> 2) & 3) << 6) | (((lane >> 4) & 1) << 5) | (((lane >> 5) & 1) << 8); }
constexpr int v_rd_off(int d0, int ks, int half) { return d0 * 512 + ks * 4096 + half * 2048; }
template <int OFF> __device__ __forceinline__ s16x4 tr_read(int vb) { s16x4 r; asm volatile("ds_read_b64_tr_b16 %0, %1 offset:%2" : "=&v"(r) : "v"(vb), "i"(OFF) : "memory"); return r; }
template <int D0> __device__ __forceinline__ void pv_one(f32x16& od, int vb, bf16x8 pa0, bf16x8 pa1, bf16x8 pa2, bf16x8 pa3) {
    const s16x4 l0 = tr_read<v_rd_off(D0, 0, 0)>(vb), h0 = tr_read<v_rd_off(D0, 0, 1)>(vb), l1 = tr_read<v_rd_off(D0, 1, 0)>(vb), h1 = tr_read<v_rd_off(D0, 1, 1)>(vb);
    const s16x4 l2 = tr_read<v_rd_off(D0, 2, 0)>(vb), h2 = tr_read<v_rd_off(D0, 2, 1)>(vb), l3 = tr_read<v_rd_off(D0, 3, 0)>(vb), h3 = tr_read<v_rd_off(D0, 3, 1)>(vb);
    asm volatile("s_waitcnt lgkmcnt(0)" ::: "memory"); SBAR();
#define PK(L, H) (bf16x8){L[0], L[1], L[2], L[3], H[0], H[1], H[2], H[3]}
    od = __builtin_amdgcn_mfma_f32_32x32x16_bf16(pa0, PK(l0, h0), od, 0, 0, 0);
    od = __builtin_amdgcn_mfma_f32_32x32x16_bf16(pa1, PK(l1, h1), od, 0, 0, 0);
    od = __builtin_amdgcn_mfma_f32_32x32x16_bf16(pa2, PK(l2, h2), od, 0, 0, 0);
    od = __builtin_amdgcn_mfma_f32_32x32x16_bf16(pa3, PK(l3, h3), od, 0, 0, 0);
#undef PK
}
__device__ __forceinline__ void pv_d0(f32x16* o, int vb, bf16x8 pa0, bf16x8 pa1, bf16x8 pa2, bf16x8 pa3) {
    pv_one<0>(o[0], vb, pa0, pa1, pa2, pa3); pv_one<1>(o[1], vb, pa0, pa1, pa2, pa3); pv_one<2>(o[2], vb, pa0, pa1, pa2, pa3); pv_one<3>(o[3], vb, pa0, pa1, pa2, pa3);
}

__device__ __forceinline__ void attn_pass_exact(const bf16_t* __restrict__ Qb, const bf16_t* __restrict__ Kb, const bf16_t* __restrict__ Vb, int b, int h, int mp, int qrow,
                                          f32x16 (&o)[4], float& l_out, LAS unsigned char* lds) {
    int tid_ = threadIdx.x; asm volatile("" : "+v"(tid_));
    const int tid = tid_, wid = tid >> 6, lane = tid & 63, r32 = lane & 31, hi = lane >> 5;
    LAS unsigned char* V_lds = lds + OFF_V; LAS unsigned char* K_lds = lds + OFF_K;
    LAS float* ws = (LAS float*)(lds + OFF_WS) + wid * 64; LAS float* al_l = ws + 32;
    float m_reg = -1e30f, l_reg = 0.f;
#pragma unroll
    for (int d = 0; d < 4; ++d) o[d] = f32x16{};
    bf16x8 qr[4];
    { const bf16_t* Qw = Qb + (size_t)qrow * 1024 + h * 128 + mp * 64 + hi * 8;
#pragma unroll
      for (int d0 = 0; d0 < 4; ++d0) qr[d0] = *(const bf16x8*)(Qw + d0 * 16); }
    const int sr = tid >> 4, sc = (tid & 15) * 8, vst0 = v_st(sr, sc), vst1 = v_st(32 + sr, sc);
    const int kk = tid >> 3, kch = tid & 7, kst = kswz(kk, kch);
    const int vb0 = (int)(uintptr_t)V_lds + v_rd_base(lane);
    const bf16_t* Kcol = Kb + h * 128 + mp * 64 + kch * 8; const bf16_t* Vcol = Vb + h * 128 + sc;
    const int mrow = TX + b * NMETA, xrow = b * SEQ - 64;
    struct { bf16x8 vs0, vs1, ks; } st_[2];
#define KROW(t, k) ((t) == 0 ? mrow + ((k) & 15) : xrow + (t) * 64 + (k))
#define SLOAD(i, t) do { st_[i].vs0 = *(const bf16x8*)(Vcol + (size_t)KROW(t, sr) * 1024); st_[i].vs1 = *(const bf16x8*)(Vcol + (size_t)KROW(t, 32 + sr) * 1024); \
        st_[i].ks = *(const bf16x8*)(Kcol + (size_t)KROW(t, kk) * 1024); } while (0)
#define SWRITE(bf, i) do { *(LAS bf16x8*)(V_lds + (bf) * SHM_V + vst0) = st_[i].vs0; *(LAS bf16x8*)(V_lds + (bf) * SHM_V + vst1) = st_[i].vs1; \
        *(LAS bf16x8*)(K_lds + (bf) * SHM_K + kst) = st_[i].ks; } while (0)
#define RESC(a) do { if (__any((a) < 1.f)) { if (hi == 0) al_l[r32] = (a); LDS_WAIT(); \
        _Pragma("unroll") for (int d = 0; d < 4; ++d) _Pragma("unroll") for (int r = 0; r < 16; ++r) o[d][r] *= al_l[crow(r, hi)]; } } while (0)
    f32x16 pA0, pA1, pB0, pB1; float alA, alB; bf16x8 pa0, pa1, pa2, pa3;
    constexpr int SE = 0, SO = 1;
    SLOAD(SE, 0); SWRITE(0, SE); __syncthreads();
    qkt(pA0, pA1, K_lds, qr, r32, hi);
#pragma unroll
    for (int r = 8; r < 16; ++r) pA0[r] = -INFINITY;
#pragma unroll
    for (int r = 0; r < 16; ++r) pA1[r] = -INFINITY;
    partialSM(pA0, pA1, m_reg, alA);
    SLOAD(SO, 1); SLOAD(SE, 2);
    SWRITE(1, SO); __syncthreads();
#define HALF_STEP(PN0, PN1, ALN, PP0, PP1, ALP, KBUF, VBUF, LD, LDSLOT, LDT, WR, WRBUF, WRSLOT) do { \
        SBAR(); qkt(PN0, PN1, K_lds + (KBUF) * SHM_K, qr, r32, hi); \
        finishSM(PP0, PP1, ALP, l_reg, pa0, pa1, pa2, pa3); SBAR(); \
        if (LD) { SLOAD(LDSLOT, LDT); } SBAR(); \
        pv_d0(o, vb0 + (VBUF) * SHM_V, pa0, pa1, pa2, pa3); partialSM(PN0, PN1, m_reg, ALN); \
        __syncthreads(); if (WR) { SWRITE(WRBUF, WRSLOT); } \
        RESC(ALN); __syncthreads(); } while (0)
    for (int j = 1; j + 3 < NT; j += 2) {
        HALF_STEP(pB0, pB1, alB, pA0, pA1, alA, 1, 0, true, SO, j + 2, true, 0, SE);
        HALF_STEP(pA0, pA1, alA, pB0, pB1, alB, 0, 1, true, SE, j + 3, true, 1, SO);
    }
    {
        HALF_STEP(pB0, pB1, alB, pA0, pA1, alA, 1, 0, false, SO, 0, true, 0, SE);
        HALF_STEP(pA0, pA1, alA, pB0, pB1, alB, 0, 1, false, SE, 0, false, 1, SO);
    }
    finishSM(pA0, pA1, alA, l_reg, pa0, pa1, pa2, pa3); SBAR();
    pv_d0(o, vb0, pa0, pa1, pa2, pa3);
    l_out = l_reg;
    __syncthreads();
#undef KROW
#undef SLOAD
#undef SWRITE
#undef RESC
#undef HALF_STEP
}

__device__ __forceinline__ bool attn_pass_fast(const bf16_t* __restrict__ Qb, const bf16_t* __restrict__ Kb, const bf16_t* __restrict__ Vb, int b, int h, int mp, int qrow,
                                          f32x16 (&o)[4], float& l_out, LAS unsigned char* lds) {
    int tid_ = threadIdx.x; asm volatile("" : "+v"(tid_));
    const int tid = tid_, wid = tid >> 6, lane = tid & 63, r32 = lane & 31, hi = lane >> 5;
    LAS unsigned char* V_lds = lds + OFF_V; LAS unsigned char* K_lds = lds + OFF_K;
    LAS float* ws = (LAS float*)(lds + OFF_WS) + wid * 64; LAS float* al_l = ws + 32;
    float m_reg = -1e30f, l_reg = 0.f;
#pragma unroll
    for (int d = 0; d < 4; ++d) o[d] = f32x16{};
    bf16x8 qr[4];
    { const bf16_t* Qw = Qb + (size_t)qrow * 1024 + h * 128 + mp * 64 + hi * 8;
#pragma unroll
      for (int d0 = 0; d0 < 4; ++d0) qr[d0] = *(const bf16x8*)(Qw + d0 * 16); }
    const int sr = tid >> 4, sc = (tid & 15) * 8, vst0 = v_st(sr, sc), vst1 = v_st(32 + sr, sc);
    const int kk = tid >> 3, kch = tid & 7, kst = kswz(kk, kch);
    const int vb0 = (int)(uintptr_t)V_lds + v_rd_base(lane);
    const bf16_t* Kcol = Kb + h * 128 + mp * 64 + kch * 8; const bf16_t* Vcol = Vb + h * 128 + sc;
    const int mrow = TX + b * NMETA, xrow = b * SEQ - 64;
    struct { bf16x8 vs0, vs1, ks; } st_[2];
#define KROW(t, k) ((t) == 0 ? mrow + ((k) & 15) : xrow + (t) * 64 + (k))
#define SLOAD(i, t) do { st_[i].vs0 = *(const bf16x8*)(Vcol + (size_t)KROW(t, sr) * 1024); st_[i].vs1 = *(const bf16x8*)(Vcol + (size_t)KROW(t, 32 + sr) * 1024); \
        st_[i].ks = *(const bf16x8*)(Kcol + (size_t)KROW(t, kk) * 1024); } while (0)
#define SWRITE(bf, i) do { *(LAS bf16x8*)(V_lds + (bf) * SHM_V + vst0) = st_[i].vs0; *(LAS bf16x8*)(V_lds + (bf) * SHM_V + vst1) = st_[i].vs1; \
        *(LAS bf16x8*)(K_lds + (bf) * SHM_K + kst) = st_[i].ks; } while (0)
#define RESC(a) do { if (__any((a) < 1.f)) { if (hi == 0) al_l[r32] = (a); LDS_WAIT(); \
        _Pragma("unroll") for (int d = 0; d < 4; ++d) _Pragma("unroll") for (int r = 0; r < 16; ++r) o[d][r] *= al_l[crow(r, hi)]; } } while (0)
    f32x16 pA0, pA1, pB0, pB1; float alA; bf16x8 pa0, pa1, pa2, pa3;
    constexpr int SE = 0, SO = 1;
    SLOAD(SE, 0); SLOAD(SO, 1); SWRITE(0, SE); SLOAD(SE, 2); __syncthreads();
    qkt(pA0, pA1, K_lds, qr, r32, hi);
#pragma unroll
    for (int r = 8; r < 16; ++r) pA0[r] = -INFINITY;
#pragma unroll
    for (int r = 0; r < 16; ++r) pA1[r] = -INFINITY;
    partialSM(pA0, pA1, m_reg, alA);
    SWRITE(1, SO); __syncthreads();
#define HALF_STEP(PN0, PN1, PP0, PP1, KBUF, VBUF, LD, LDSLOT, LDT, WR, WRBUF, WRSLOT, TILE0) do { \
        SBAR(); qkt(PN0, PN1, K_lds + (KBUF) * SHM_K, qr, r32, hi); \
        float ps_ = exp_second_sum(PP0, PP1); \
        l_reg += ps_; pack_p(PP0, PP1, pa0, pa1, pa2, pa3); SBAR(); \
        if (LD) { SLOAD(LDSLOT, LDT); } SBAR(); \
        pv_d0(o, vb0 + (VBUF) * SHM_V, pa0, pa1, pa2, pa3); exp_first(PN0, PN1, m_reg); \
        __syncthreads(); if (WR) { SWRITE(WRBUF, WRSLOT); } \
        __syncthreads(); } while (0)
    for (int j = 1; j + 3 < NT; j += 2) {
        HALF_STEP(pB0, pB1, pA0, pA1, 1, 0, true, SO, j + 2, true, 0, SE, false);
        HALF_STEP(pA0, pA1, pB0, pB1, 0, 1, true, SE, j + 3, true, 1, SO, false);
    }
    {
        HALF_STEP(pB0, pB1, pA0, pA1, 1, 0, false, SO, 0, true, 0, SE, false);
        HALF_STEP(pA0, pA1, pB0, pB1, 0, 1, false, SE, 0, false, 1, SO, false);
    }
    { float ps_ = exp_second_sum(pA0, pA1);
      l_reg += ps_; pack_p(pA0, pA1, pa0, pa1, pa2, pa3); SBAR(); }
    pv_d0(o, vb0, pa0, pa1, pa2, pa3);
    l_out = l_reg;
    if (lane == 0) al_l[0] = __any(!(l_reg <= 1.1529215e18f)) ? 1.0f : 0.0f;
    LDS_WAIT();
    __syncthreads();
    float bad_ = 0.f;
#pragma unroll
    for (int w = 0; w < 8; ++w) bad_ += ((const LAS float*)(lds + OFF_WS))[w * 64 + 32];
    const bool redo = bad_ != 0.f;
#undef KROW
#undef SLOAD
#undef SWRITE
#undef RESC
#undef HALF_STEP
    return redo;
}

struct AttnArgs { const bf16_t* Q; const bf16_t* K; const bf16_t* V; bf16_t* A; const float* subln; float lam, oml; };

__device__ __forceinline__ void attn_unit(const AttnArgs& P, int b, int h, int qb  , LAS unsigned char* lds) {
    int tid_ = threadIdx.x; asm volatile("" : "+v"(tid_));
    const int tid = tid_, wid = tid >> 6, lane = tid & 63, r32 = lane & 31, hi = lane >> 5;
    const bool meta = qb == 8;
    const int qrow = meta ? TX + b * NMETA + (r32 & 15) : b * SEQ + qb * 256 + wid * 32 + r32;
    LAS float* ws = (LAS float*)(lds + OFF_WS) + wid * 64;
    unsigned stb = (unsigned)(uintptr_t)(lds + OFF_ST) + (unsigned)tid * 4u; asm volatile("" : "+v"(stb));
    f32x16 o[4]; float l_reg;
    if (attn_pass_fast(P.Q, P.K, P.V, b, h, 0, qrow, o, l_reg, lds)) attn_pass_exact(P.Q, P.K, P.V, b, h, 0, qrow, o, l_reg, lds);
    if (hi == 0) ws[r32] = l_reg; LDS_WAIT();
    {
#pragma unroll
        for (int r = 0; r < 16; ++r) { const float rl = __builtin_amdgcn_rcpf(ws[crow(r, hi)]);
            *(LAS unsigned*)(stb + (r * 2 + 0) * 2048) = cvt_pk_bf16(o[0][r] * rl, o[1][r] * rl); *(LAS unsigned*)(stb + (r * 2 + 1) * 2048) = cvt_pk_bf16(o[2][r] * rl, o[3][r] * rl); }
    }
    LDS_WAIT();
    if (attn_pass_fast(P.Q, P.K, P.V, b, h, 1, qrow, o, l_reg, lds)) attn_pass_exact(P.Q, P.K, P.V, b, h, 1, qrow, o, l_reg, lds);
    if (hi == 0) ws[r32] = l_reg; LDS_WAIT();
    float ss[16];
#pragma unroll
    for (int r = 0; r < 16; ++r) { const float rl = __builtin_amdgcn_rcpf(ws[crow(r, hi)]) * P.lam;
        const unsigned s0 = *(LAS unsigned*)(stb + (r * 2 + 0) * 2048), s1 = *(LAS unsigned*)(stb + (r * 2 + 1) * 2048);
        o[0][r] = bf_lo(s0) - o[0][r] * rl; o[1][r] = bf_hi(s0) - o[1][r] * rl; o[2][r] = bf_lo(s1) - o[2][r] * rl; o[3][r] = bf_hi(s1) - o[3][r] * rl;
        ss[r] = (o[0][r] * o[0][r] + o[1][r] * o[1][r]) + (o[2][r] * o[2][r] + o[3][r] * o[3][r]); }
#pragma unroll
    for (int r = 0; r < 16; ++r) {
#pragma unroll
        for (int s = 1; s < 32; s <<= 1) ss[r] += shfl_xor_l(ss[r], s, lane);
        ss[r] = __builtin_amdgcn_rsqf(ss[r] * (1.0f / 128.0f) + EPS) * P.oml; }
    float gsub[4];
#pragma unroll
    for (int d = 0; d < 4; ++d) gsub[d] = P.subln[d * 32 + r32];
    const bool wst = !meta || wid == 0;
#pragma unroll
    for (int r = 0; r < 16; ++r) { const int rr = crow(r, hi);
        if (wst && (!meta || rr < 16)) { const int orow = meta ? TX + b * NMETA + rr : b * SEQ + qb * 256 + wid * 32 + rr;
            bf16_t* op = P.A + (size_t)orow * 1024 + h * 128 + r32;
#pragma unroll
            for (int d = 0; d < 4; ++d) op[d * 32] = (bf16_t)(cvt_pk_bf16(o[d][r] * ss[r] * gsub[d], 0.f) & 0xffffu); } }
    LDS_WAIT(); __syncthreads();
}
#undef SBAR
}

#define XB_TMO      128
#define XB_XCNT(j)  (256  + 64 * (j))
#define XB_XSUB(j)  (1280 + 64 * (j))
#define XB_XGEN(j)  (2304 + 64 * (j))
#define XB_TOP      3328
#define XB_TOPGEN   3392
#define XCD_BAR_WORDS 3456
#define XB_SPIN_CAP (1u << 22)
__device__ __forceinline__ unsigned xb_ld(unsigned* p)              { return __hip_atomic_load(p, __ATOMIC_RELAXED, __HIP_MEMORY_SCOPE_AGENT); }
__device__ __forceinline__ unsigned xb_add(unsigned* p, unsigned v) { return __hip_atomic_fetch_add(p, v, __ATOMIC_RELAXED, __HIP_MEMORY_SCOPE_AGENT); }
__device__ __forceinline__ unsigned xb_xcc_id() { return (unsigned)__builtin_amdgcn_s_getreg((3 << 11) | 20) & 0xFu; }
#define XB_SPIN(cond, bar) do { unsigned _sp = 0; while (cond) { __builtin_amdgcn_s_sleep(1); \
    if ((++_sp & 255u) == 0u) { if (xb_ld(&(bar)[XB_TMO])) break; if (_sp > XB_SPIN_CAP) { atomicAdd(&(bar)[XB_TMO], 1u); break; } } } } while (0)
struct XcdBarrier { unsigned* bar; unsigned x; volatile LAS unsigned* st; };
__device__ __forceinline__ XcdBarrier xcd_barrier_post(unsigned* bar, volatile LAS unsigned* st) {
    XcdBarrier b; b.bar = bar; b.x = xb_xcc_id(); b.st = st;
    if (threadIdx.x == 0) (void)xb_add(&bar[XB_XCNT(b.x)], 1u);
    return b;
}
__device__ __forceinline__ void xcd_barrier_complete(unsigned* bar, unsigned x, unsigned& nloc, unsigned& nx) {
    const unsigned G = gridDim.x * gridDim.y * gridDim.z;
    unsigned sum, cnt, mine, sp = 0u;
    for (;;) {
        sum = 0u; cnt = 0u; mine = 0u;
#pragma unroll
        for (unsigned j = 0; j < 16; ++j) { const unsigned c = xb_ld(&bar[XB_XCNT(j)]); sum += c; cnt += (c > 0u) ? 1u : 0u; mine = (j == x) ? c : mine; }
        if (sum == G) break;
        __builtin_amdgcn_s_sleep(1);
        if ((++sp & 255u) == 0u) { if (xb_ld(&bar[XB_TMO])) break; if (sp > XB_SPIN_CAP) { atomicAdd(&bar[XB_TMO], 1u); break; } }
    }
    nloc = mine > 0u ? mine : 1u; nx = cnt > 0u ? cnt : 1u;
}
__device__ __forceinline__ void xcd_barrier(const XcdBarrier& b) {
    asm volatile("s_waitcnt vmcnt(0)" ::: "memory");
    __syncthreads();
    if (threadIdx.x == 0) {
        unsigned* bar = b.bar;
        __builtin_amdgcn_s_waitcnt(0);
        unsigned nloc = b.st[0], nx = b.st[1];
        if (nloc == 0u) { xcd_barrier_complete(bar, b.x, nloc, nx); b.st[0] = nloc; b.st[1] = nx; }
        const unsigned old = xb_add(&bar[XB_XSUB(b.x)], 1u);
        const unsigned gen = old / nloc;
        if (old + 1u == (gen + 1u) * nloc) {
            __builtin_amdgcn_fence(__ATOMIC_RELEASE, "agent");
            asm volatile("s_waitcnt vmcnt(0)" ::: "memory");
            const unsigned og = xb_add(&bar[XB_TOP], 1u);
            const unsigned tg = og / nx;
            if (og + 1u == (tg + 1u) * nx) xb_add(&bar[XB_TOPGEN], 1u);
            else XB_SPIN(xb_ld(&bar[XB_TOPGEN]) == tg, bar);
            __builtin_amdgcn_fence(__ATOMIC_ACQUIRE, "agent");
            xb_add(&bar[XB_XGEN(b.x)], 1u);
            asm volatile("s_waitcnt vmcnt(0)" ::: "memory");
        } else {
            XB_SPIN(xb_ld(&bar[XB_XGEN(b.x)]) == gen, bar);
            __builtin_amdgcn_fence(__ATOMIC_ACQUIRE, "agent");
            asm volatile("s_waitcnt vmcnt(0)" ::: "memory");
        }
    }
    __syncthreads();
}

constexpr int RING_BYTES = 131072, LDSCTL_OFF = RING_BYTES, LDS_BYTES = 147456;
static_assert(att::LDS_BYTES <= RING_BYTES, "attention scratch inside the ring region");
constexpr int NPHASE = 18;

struct Args { const float* in[24]; float* out; unsigned char* ws; int ph_lo, ph_hi; };

template <int MODE> __device__ __forceinline__ int rowmap(int n) {
    if (MODE == 1) return (n >> 7) * 256 + (n & 127);
    if (MODE == 2) return (n >> 7) * 256 + 128 + (n & 127);
    if (MODE == 3) { if (n < 2048) { const int tile = n >> 8, hh = (n >> 6) & 3, bj = (n >> 5) & 1, i = n & 31; return tile * 256 + bj * 128 + hh * 32 + i; }
                     if (n >= 4096) { const int pool = n >= 6144 ? 1 : 0, c = n - 4096 - pool * 2048; return 4096 + (c >> 7) * 256 + pool * 128 + (c & 127); }
                     return n; }
    return n;
}
template <int MODE> __device__ __forceinline__ void transpose_item(const float* __restrict__ W, int K, int N, bf16_t* __restrict__ WT, LAS float* scr, int item, int lane, unsigned char* __restrict__ W8 = nullptr) {
    const int nblk = N / 32, kb = item / nblk, nb = item % nblk, k0 = 64 * kb, n0 = 32 * nb;
#pragma unroll 8
    for (int i = 0; i < 32; ++i) { const int kk = 2 * i + (lane >> 5); scr[kk * 33 + (lane & 31)] = W[(size_t)(k0 + kk) * N + n0 + (lane & 31)]; }
    LDS_WAIT(); asm volatile("" ::: "memory");
    const int c = lane & 7;
#pragma unroll
    for (int j = 0; j < 4; ++j) { const int n = (lane >> 3) + 8 * j; const LAS float* s = scr + (8 * c) * 33 + n;
        u32x4 o; o.x = cvt_pk_bf16(s[0 * 33], s[1 * 33]); o.y = cvt_pk_bf16(s[2 * 33], s[3 * 33]); o.z = cvt_pk_bf16(s[4 * 33], s[5 * 33]); o.w = cvt_pk_bf16(s[6 * 33], s[7 * 33]);
        *(u32x4*)(WT + (size_t)rowmap<MODE>(n0 + n) * K + k0 + 8 * c) = o;
        if (MODE == 3 && n0 >= 4096) {
            u32x2 o8; o8.x = cvt4_fp8(s[0 * 33] * F8_SW, s[1 * 33] * F8_SW, s[2 * 33] * F8_SW, s[3 * 33] * F8_SW); o8.y = cvt4_fp8(s[4 * 33] * F8_SW, s[5 * 33] * F8_SW, s[6 * 33] * F8_SW, s[7 * 33] * F8_SW);
            *(u32x2*)(W8 + (size_t)(rowmap<MODE>(n0 + n) - 4096) * K + k0 + 8 * c) = o8; } }
    LDS_WAIT(); asm volatile("" ::: "memory");
}

template <int MODE> __device__ __forceinline__ void transpose_item_f8(const float* __restrict__ W, int K, int N, unsigned char* __restrict__ WT, LAS float* scr, int item, int lane, float scale) {
    const int nblk = N / 32, kb = item / nblk, nb = item % nblk, k0 = 64 * kb, n0 = 32 * nb;
#pragma unroll 8
    for (int i = 0; i < 32; ++i) { const int kk = 2 * i + (lane >> 5); scr[kk * 33 + (lane & 31)] = W[(size_t)(k0 + kk) * N + n0 + (lane & 31)] * scale; }
    LDS_WAIT(); asm volatile("" ::: "memory");
    const int c = lane & 7;
#pragma unroll
    for (int j = 0; j < 4; ++j) { const int n = (lane >> 3) + 8 * j; const LAS float* s = scr + (8 * c) * 33 + n;
        u32x2 o; o.x = cvt4_fp8(s[0 * 33], s[1 * 33], s[2 * 33], s[3 * 33]); o.y = cvt4_fp8(s[4 * 33], s[5 * 33], s[6 * 33], s[7 * 33]);
        *(u32x2*)(WT + (size_t)rowmap<MODE>(n0 + n) * K + k0 + 8 * c) = o; }
    LDS_WAIT(); asm volatile("" ::: "memory");
}

__device__ __forceinline__ float half_sum(float v, int lane) {
#pragma unroll
    for (int o = 1; o < 32; o <<= 1) v += shfl_xor_l(v, o, lane);
    return v;
}
template <bool HAS0, bool HAS1, bool SRC16 = false, bool OUT16 = false, bool PRELOADED = false>
__device__ __forceinline__ void norm_row2(const void* src, void* hres_out, const float* __restrict__ gain, bf16_t* hout, int lane, bool valid, f32x4 (&v)[16], float& rstd,
                                          const bf16_t* add0 = nullptr, const bf16_t* add1 = nullptr) {
    const int l32 = lane & 31; const f32x4* xr = (const f32x4*)src + l32; float s = 0.f; u32x2 a_[16], b_[16], s_[16];
#pragma unroll
    for (int j = 0; j < 16; ++j) { if (SRC16) s_[j] = ((const u32x2*)src)[l32 + 32 * j]; else if (!PRELOADED) v[j] = xr[32 * j]; if (HAS0) a_[j] = ((const u32x2*)add0)[l32 + 32 * j]; if (HAS1) b_[j] = ((const u32x2*)add1)[l32 + 32 * j]; }
#pragma unroll
    for (int j = 0; j < 16; ++j) {
        if (SRC16) { const u32x2 q = s_[j]; v[j].x = bf_lo(q.x); v[j].y = bf_hi(q.x); v[j].z = bf_lo(q.y); v[j].w = bf_hi(q.y); }
        if (HAS0) { const u32x2 a = a_[j]; v[j].x += bf_lo(a.x); v[j].y += bf_hi(a.x); v[j].z += bf_lo(a.y); v[j].w += bf_hi(a.y); }
        if (HAS1) { const u32x2 b = b_[j]; v[j].x += bf_lo(b.x); v[j].y += bf_hi(b.x); v[j].z += bf_lo(b.y); v[j].w += bf_hi(b.y); }
        s += (v[j].x * v[j].x + v[j].y * v[j].y) + (v[j].z * v[j].z + v[j].w * v[j].w); }
    if (hres_out && valid) {
        if (OUT16) { u32x2* hr = (u32x2*)hres_out + l32;
#pragma unroll
            for (int j = 0; j < 16; ++j) { u32x2 w; w.x = cvt_pk_bf16(v[j].x, v[j].y); w.y = cvt_pk_bf16(v[j].z, v[j].w); hr[32 * j] = w; } }
        else { f32x4* hr = (f32x4*)hres_out + l32;
#pragma unroll
            for (int j = 0; j < 16; ++j) hr[32 * j] = v[j]; } }
    rstd = __builtin_amdgcn_rsqf(half_sum(s, lane) * (1.0f / DM) + EPS);
    const f32x4* gr = (const f32x4*)gain + l32;
#pragma unroll
    for (int j = 0; j < 16; ++j) { const f32x4 g = gr[32 * j]; v[j] = v[j] * rstd * g; }
    if (hout && valid) { u32x2* o8 = (u32x2*)hout + l32;
#pragma unroll
        for (int j = 0; j < 16; ++j) { u32x2 w; w.x = cvt_pk_bf16(v[j].x, v[j].y); w.y = cvt_pk_bf16(v[j].z, v[j].w); o8[32 * j] = w; } }
}

__global__ void __launch_bounds__(NWAVES * 64, 2) fwd_kernel(Args args) {
    extern __shared__ __attribute__((aligned(16))) unsigned char lds_raw[];
    LAS unsigned char* lds = (LAS unsigned char*)lds_raw;
    const int tid = threadIdx.x, lane = tid & 63, wave = __builtin_amdgcn_readfirstlane(tid >> 6);
    const int G = gridDim.x; const int bx = blockIdx.x; const int vcu = (G % 8 == 0) ? (bx % 8) * (G / 8) + bx / 8 : bx;
    unsigned* ctl = (unsigned*)(GAS unsigned*)(args.ws + WS_CTL);
    volatile LAS unsigned* MISC = (volatile LAS unsigned*)(lds + LDSCTL_OFF);
    for (int u = tid; u < (LDS_BYTES - LDSCTL_OFF) / 4; u += NWAVES * 64) ((LAS unsigned*)(lds + LDSCTL_OFF))[u] = 0u;
    __syncthreads();
    const int lo = args.ph_lo, hi = args.ph_hi; (void)lo;
    XcdBarrier bar; bar.bar = ctl + CW_BAR; bar.x = 0; bar.st = nullptr;
    if (hi - lo > 1) bar = xcd_barrier_post(ctl + CW_BAR, MISC + 8);
#if MK_ONE_LAUNCH && MK_PROBE_BUF == 0 && MK_LAST_PHASE == 17
#define IN(k) ((k) < NPHASE)
#define SEAM(k) do { if ((k) + 1 < NPHASE) xcd_barrier(bar); } while (0)
#else
#ifdef ONLY_MASK
#define IN(k) (((ONLY_MASK >> (k)) & 1) != 0 && lo <= (k) && (k) < hi)
#else
#define IN(k) (lo <= (k) && (k) < hi)
#endif
#define SEAM(k) do { if ((k) + 1 < hi) xcd_barrier(bar); } while (0)
#endif
#define PHASE_LOCALS int tidp = threadIdx.x; asm volatile("" : "+v"(tidp)); const int lanep = tidp & 63; GAS unsigned char* wsg_ = (GAS unsigned char*)args.ws; asm volatile("" : "+s"(wsg_)); unsigned char* wsp = (unsigned char*)wsg_; int Gp = gridDim.x; asm volatile("" : "+s"(Gp)); const int NGW = Gp * NWAVES, NGT = Gp * NWAVES * 64; (void)NGT; (void)NGW
    const int gw = vcu * NWAVES + wave;

    const float* x = (const float*)(const GAS float*)args.in[0]; const float* meta_tok = (const float*)(const GAS float*)args.in[1]; const float* norm_mix = (const float*)(const GAS float*)args.in[2]; const float* w_in = (const float*)(const GAS float*)args.in[3]; const float* b_gate = (const float*)(const GAS float*)args.in[4];
    const float* lam_q1 = (const float*)(const GAS float*)args.in[5]; const float* lam_k1 = (const float*)(const GAS float*)args.in[6]; const float* lam_q2 = (const float*)(const GAS float*)args.in[7]; const float* lam_k2 = (const float*)(const GAS float*)args.in[8]; const float* subln = (const float*)(const GAS float*)args.in[9];
    const float* pool_w = (const float*)(const GAS float*)args.in[10]; const float* pool_scale = (const float*)(const GAS float*)args.in[11]; const float* w_ba = (const float*)(const GAS float*)args.in[12]; const float* w_bp = (const float*)(const GAS float*)args.in[13]; const float* w_out = (const float*)(const GAS float*)args.in[14];
    const float* norm_ffn = (const float*)(const GAS float*)args.in[15]; const float* d_wg = (const float*)(const GAS float*)args.in[16]; const float* d_wu = (const float*)(const GAS float*)args.in[17]; const float* d_wd = (const float*)(const GAS float*)args.in[18]; const float* router = (const float*)(const GAS float*)args.in[19];
    const float* m_wg = (const float*)(const GAS float*)args.in[20]; const float* m_wu = (const float*)(const GAS float*)args.in[21]; const float* m_wd = (const float*)(const GAS float*)args.in[22]; const float* norm_final = (const float*)(const GAS float*)args.in[23];
#define ROPE ((float*)(wsp + WS_ROPE))
#define TOKE ((int*)(wsp + WS_TOKE))
#define TOKS ((int*)(wsp + WS_TOKS))
#define TOKW ((float*)(wsp + WS_TOKW))
#define ROWL ((int*)(wsp + WS_ROWL))
#define ROWW ((float*)(wsp + WS_ROWW))
#define WIN ((bf16_t*)(wsp + WS_WIN))
#define WBA ((bf16_t*)(wsp + WS_WBA))
#define WC ((bf16_t*)(wsp + WS_WC))
#define WOUT ((bf16_t*)(wsp + WS_WOUT))
#define DWGU ((bf16_t*)(wsp + WS_DWGU))
#define DWD ((bf16_t*)(wsp + WS_DWD))
#define MWGU ((bf16_t*)(wsp + WS_MWGU))
#define MWD ((bf16_t*)(wsp + WS_MWD))
#define HRES ((float*)(wsp + WS_HRES))
#define HRES16 ((bf16_t*)(wsp + WS_HRES))
#define H ((bf16_t*)(wsp + WS_H))
#define MB ((bf16_t*)(wsp + WS_H))
#define QB ((bf16_t*)(wsp + WS_Q))
#define KB ((bf16_t*)(wsp + WS_K))
#define VB ((bf16_t*)(wsp + WS_V))
#define UB ((bf16_t*)(wsp + WS_U))
#define GB ((bf16_t*)(wsp + WS_G))
#define YB ((bf16_t*)(wsp + WS_Y))
#define HID ((bf16_t*)(wsp + WS_HID))
#define CNT ((unsigned*)(wsp + WS_CTL) + CW_CNT)
#define H8P ((unsigned char*)(GAS unsigned char*)args.out)
#define WIN8G ((unsigned char*)(GAS unsigned char*)args.out + (size_t)T * DM)

    if (IN(0)) { PHASE_LOCALS;
#pragma unroll 1
      for (int rep0 = 0; rep0 < MK_REP_P0; ++rep0) {
        LAS float* scr = (LAS float*)(lds + wave * 16384);
        constexpr int I_FF = (DM / 64) * (DFF / 32);
        constexpr int I_MOE = NE * 3 * I_FF, I_DENSE = 3 * I_FF;
        constexpr int I_WIN = (DM / 64) * (INC / 32), I_WBA = (AW / 64) * (DM / 32), I_WOUT = (DM / 64) * (DM / 32), I_LAYER = I_WIN + I_WBA + I_WOUT;
        constexpr int NITEMS = I_MOE + I_DENSE + 2 * I_LAYER;
        for (int it = gw; it < NITEMS; it += NGW) {
            int r = it;
            if (r < I_MOE) { const int e = r / (3 * I_FF), q = r % (3 * I_FF), which = q / I_FF, item = q % I_FF;
                if (which == 0) transpose_item_f8<1>(m_wg + (size_t)e * DM * DFF, DM, DFF, (unsigned char*)MWGU + (size_t)e * NHID2 * DM, scr, item, lanep, F8_SW);
                else if (which == 1) transpose_item_f8<2>(m_wu + (size_t)e * DM * DFF, DM, DFF, (unsigned char*)MWGU + (size_t)e * NHID2 * DM, scr, item, lanep, F8_SW);
                else transpose_item_f8<0>(m_wd + (size_t)e * DFF * DM, DFF, DM, (unsigned char*)MWD + (size_t)e * DM * DFF, scr, item, lanep, F8_SW);
                continue; }
            r -= I_MOE;
            if (r < I_DENSE) { const int which = r / I_FF, item = r % I_FF;
                if (MK_F8_DENSE) {
                if (which == 0) transpose_item_f8<1>(d_wg, DM, DFF, (unsigned char*)DWGU, scr, item, lanep, F8_SW);
                else if (which == 1) transpose_item_f8<2>(d_wu, DM, DFF, (unsigned char*)DWGU, scr, item, lanep, F8_SW);
                else transpose_item_f8<0>(d_wd, DFF, DM, (unsigned char*)DWD, scr, item, lanep, F8_SW);
                } else {
                if (which == 0) transpose_item<1>(d_wg, DM, DFF, DWGU, scr, item, lanep);
                else if (which == 1) transpose_item<2>(d_wu, DM, DFF, DWGU, scr, item, lanep);
                else transpose_item<0>(d_wd, DFF, DM, DWD, scr, item, lanep); }
                continue; }
            r -= I_DENSE;
            const int l = r / I_LAYER; r = r % I_LAYER;
            if (r < I_WIN) { transpose_item<3>(w_in + (size_t)l * DM * INC, DM, INC, WIN + (size_t)l * INC * DM, scr, r, lanep, WIN8G + (size_t)l * 4096 * DM); continue; }
            r -= I_WIN;
            if (r < I_WBA) { transpose_item<0>(w_ba + (size_t)l * AW * DM, AW, DM, WBA + (size_t)l * DM * AW, scr, r, lanep); continue; }
            r -= I_WBA;
            transpose_item<0>(w_out + (size_t)l * DM * DM, DM, DM, WOUT + (size_t)l * DM * DM, scr, r, lanep);
        }
        for (int it = gw; it < 2 * 32 * 128; it += NGW) {
            const int l = it >> 12, nb = (it >> 7) & 31, kcb = it & 127, n = nb * 64 + lanep, kc0 = kcb * 8, g = kc0 >> 8, c0 = kc0 & 255;
            const float* pw = pool_w + ((size_t)(l * 4 + g) * 256 + c0) * 256; const float* ps = pool_scale + l * 1024 + g * 256; const float* wb = w_bp + ((size_t)l * 1024 + g * 256) * DM + n;
            float a[8];
#pragma unroll
            for (int q = 0; q < 8; ++q) a[q] = 0.f;
            for (int e = 0; e < 256; ++e) { const float wv = wb[(size_t)e * DM] * ps[e];
#pragma unroll
                for (int q = 0; q < 8; ++q) a[q] += pw[q * 256 + e] * wv; }
            u32x4 o; o.x = cvt_pk_bf16(a[0], a[1]); o.y = cvt_pk_bf16(a[2], a[3]); o.z = cvt_pk_bf16(a[4], a[5]); o.w = cvt_pk_bf16(a[6], a[7]);
            *(u32x4*)(WC + ((size_t)l * DM + n) * 1024 + kc0) = o;
        }
        for (int idx = (vcu * NWAVES * 64) + tidp; idx < LTOK * 32; idx += NGT) { const int pos = idx >> 5, i = idx & 31;
            const float inv = __builtin_amdgcn_exp2f((float)(-i) * 0.41524101186092029f); const float ang = (float)pos * inv;
            double rev = (double)ang * 0.15915494309189535; rev -= floor(rev);
            ROPE[pos * 64 + i] = __builtin_amdgcn_cosf((float)rev); ROPE[pos * 64 + 32 + i] = __builtin_amdgcn_sinf((float)rev); }
#define EMB_ROW(r) ((r) < TX ? x + (size_t)(r) * DM : meta_tok + (size_t)(((r) - TX) & (NMETA - 1)) * DM)
        for (int r0 = gw; r0 < T; r0 += 2 * NGW) { const int rr = r0 + (lanep >> 5) * NGW; const bool valid = rr < T; const int r = valid ? rr : r0;
            f32x4 v[16]; float rstd; norm_row2<false, false>(EMB_ROW(r), nullptr, norm_mix, H + (size_t)r * DM, lanep, valid, v, rstd);
            if (valid && r < TX) { unsigned* o4 = (unsigned*)(H8P + (size_t)r * DM) + (lanep & 31);
#pragma unroll
                for (int j = 0; j < 16; ++j) o4[32 * j] = cvt4_fp8(v[j].x * F8_SA, v[j].y * F8_SA, v[j].z * F8_SA, v[j].w * F8_SA); } }
        SEAM(0);
      }
    }

#pragma unroll 1
    for (int layer = 0; layer < 2; ++layer) {
        const int pb = 1 + 8 * layer;
        if (IN(pb + 0)) { PHASE_LOCALS;
            { SchedInA S; S.o.init(NPAN - 1, 16, Gp, bx); S.A = (const char*)H; S.B = (const char*)(WIN + (size_t)layer * INC * DM);
              EpiIn E{QB, KB, VB, UB, GB, b_gate + layer * 4096, ROPE};
              pg8::gemm_phase<EpiIn, SchedInA, false>(lds, DM / 64, DM * 2, DM * 2, S, E); }
            { SchedIn8 S; S.o.init(NPAN - 1, 16, Gp, bx); S.A = (const char*)H8P; S.B = (const char*)(WIN8G + (size_t)layer * 4096 * DM);
              EpiGate8 E{GB, b_gate + layer * 4096};
              pg8::gemm_phase<EpiGate8, SchedIn8, false, true>(lds, DM / 128, DM, DM, S, E); }
            SEAM(pb + 0);
        }
        if (IN(pb + 1)) { PHASE_LOCALS;
            const bool split = layer == 0 && (Gp & 1) == 0 && Gp >= 256;
            const int gw_m = split ? (vcu >= Gp / 2 ? (vcu - Gp / 2) * NWAVES + wave : (layer == 0 ? T : TX)) : gw, ngw_m = split ? NGW / 2 : NGW;
#pragma unroll 1
            for (int repm = 0; repm < MK_REP_M; ++repm)
            for (int r = gw_m; r < (layer == 0 ? T : TX); r += ngw_m) { const int b = row_batch(r), pos = row_pos(r), g = lanep >> 4, half = 1 << g;
                const int wlo = max(pos - half, 0), whi = min(pos + half, LTOK);
                float s[16];
#pragma unroll
                for (int q = 0; q < 16; ++q) s[q] = 0.f;
                u32x4 wa[16], wc_[16];
#pragma unroll
                for (int jj = 0; jj < 16; ++jj) { const int j = pos - 8 + jj; const int jc = min(max(j, 0), LTOK - 1);
                    const u32x4* up = (const u32x4*)(UB + (size_t)row_of(b, jc) * 1024 + lanep * 16); wa[jj] = up[0]; wc_[jj] = up[1]; }
#pragma unroll
                for (int jj = 0; jj < 16; ++jj) { const int j = pos - 8 + jj; const unsigned msk = (j >= wlo && j < whi) ? 0xffffffffu : 0u;
                    const u32x4 a = wa[jj] & msk, c = wc_[jj] & msk;
                        s[0] += bf_lo(a.x); s[1] += bf_hi(a.x); s[2] += bf_lo(a.y); s[3] += bf_hi(a.y); s[4] += bf_lo(a.z); s[5] += bf_hi(a.z); s[6] += bf_lo(a.w); s[7] += bf_hi(a.w);
                        s[8] += bf_lo(c.x); s[9] += bf_hi(c.x); s[10] += bf_lo(c.y); s[11] += bf_hi(c.y); s[12] += bf_lo(c.z); s[13] += bf_hi(c.z); s[14] += bf_lo(c.w); s[15] += bf_hi(c.w); }
                const float rc = 1.0f / (float)(whi - wlo);
                const u32x4* up = (const u32x4*)(UB + (size_t)r * 1024 + lanep * 16); const u32x4 a = up[0], c = up[1];
                const float uv[16] = {bf_lo(a.x), bf_hi(a.x), bf_lo(a.y), bf_hi(a.y), bf_lo(a.z), bf_hi(a.z), bf_lo(a.w), bf_hi(a.w), bf_lo(c.x), bf_hi(c.x), bf_lo(c.y), bf_hi(c.y), bf_lo(c.z), bf_hi(c.z), bf_lo(c.w), bf_hi(c.w)};
                u32x4 o0, o1;
                o0.x = cvt_pk_bf16(s[0] * rc - uv[0], s[1] * rc - uv[1]); o0.y = cvt_pk_bf16(s[2] * rc - uv[2], s[3] * rc - uv[3]); o0.z = cvt_pk_bf16(s[4] * rc - uv[4], s[5] * rc - uv[5]); o0.w = cvt_pk_bf16(s[6] * rc - uv[6], s[7] * rc - uv[7]);
                o1.x = cvt_pk_bf16(s[8] * rc - uv[8], s[9] * rc - uv[9]); o1.y = cvt_pk_bf16(s[10] * rc - uv[10], s[11] * rc - uv[11]); o1.z = cvt_pk_bf16(s[12] * rc - uv[12], s[13] * rc - uv[13]); o1.w = cvt_pk_bf16(s[14] * rc - uv[14], s[15] * rc - uv[15]);
                u32x4* mp = (u32x4*)(MB + (size_t)r * 1024 + lanep * 16); mp[0] = o0; mp[1] = o1; }
            const float linit = layer == 0 ? 0.2f : (0.8f - 0.6f * 0.74081822068171788f);
            const float d1 = wave_sum(lam_q1[layer * 64 + lanep] * lam_k1[layer * 64 + lanep], lanep), d2 = wave_sum(lam_q2[layer * 64 + lanep] * lam_k2[layer * 64 + lanep], lanep);
            att::AttnArgs P{QB, KB, VB, QB, subln + layer * 128, expf(d1) - expf(d2) + linit, 1.0f - linit};
            __syncthreads();
#pragma unroll 1
            for (int rep = 0; rep < MK_REP_ATT; ++rep) {
            P.A = (rep + 1 < MK_REP_ATT) ? (bf16_t*)(wsp + WS_H + ZSTEP) : QB;
            const int nm = split ? (vcu < 128 ? 1 : 0) : 0, xlim = (layer == 0 && !split) ? 1152 : 1024;
            for (int it = 0; ; ++it) { int id; if (it < nm) id = 1024 + vcu; else { id = vcu + (it - nm) * Gp; if (id >= xlim) break; }
                const int bh = id < 1024 ? (id >> 3) : (id - 1024); int qb = id < 1024 ? (id & 7) : 8; asm volatile("" : "+s"(qb));
                att::attn_unit(P, bh >> 3, bh & 7, qb, lds);
            } }
            SEAM(pb + 1);
        }
        if (IN(pb + 2)) { PHASE_LOCALS;
            SchedY S; S.o.init(layer == 0 ? NPAN : NPAN - 1, DM / 256, Gp, bx); S.A0 = (const char*)QB; S.A1 = (const char*)MB; S.B0 = (const char*)(WBA + (size_t)layer * DM * AW); S.B1 = (const char*)(WC + (size_t)layer * DM * 1024);
            EpiY E{YB, GB};
#pragma unroll 1
            for (int rep = 0; rep < MK_REP_P3; ++rep) {
            pg8::gemm_phase<EpiY, SchedY, false>(lds, 1024 / 64, 1024 * 2, 1024 * 2, S, E);
            SEAM(pb + 2); }
        }
        if (IN(pb + 3)) { PHASE_LOCALS;
            SchedPlain S; S.o.init(layer == 0 ? NPAN : NPAN - 1, DM / 256, Gp, bx); S.A = (const char*)YB; S.B = (const char*)(WOUT + (size_t)layer * DM * DM); S.astep = (size_t)256 * DM * 2; S.bstep = (size_t)256 * DM * 2;
            EpiDelta E{GB, 1.f};
            pg8::gemm_phase<EpiDelta, SchedPlain, false>(lds, DM / 64, DM * 2, DM * 2, S, E);
            SEAM(pb + 3);
        }
        if (IN(pb + 4)) { PHASE_LOCALS;
            if (layer == 1) {
                for (int i = vcu * NWAVES * 64 + tidp; i < MOE_MAXROWS; i += NGT) { ROWL[i] = -1; ROWW[i] = 0.f; } }
            const int R2 = layer == 0 ? T : TX;
            LAS int* lcnt = (LAS int*)lds; LAS int* lrec = (LAS int*)lds + 16;
            int nit = 0;
            const int nitmax = (R2 + 2 * NGW - 1) / (2 * NGW);
            if (layer == 1) { if (tidp < 16) lcnt[tidp] = 0; for (int i = tidp; i < nitmax * 16; i += NWAVES * 64) lrec[4 * i] = -1; __syncthreads(); }
            for (int r0 = gw; r0 < R2; r0 += 2 * NGW, ++nit) { const int rr = r0 + (lanep >> 5) * NGW; const bool valid = rr < R2; const int r = valid ? rr : r0; const int l32 = lanep & 31;
                f32x4 v[16]; float rstd;
#if MK_HRES16
                if (layer == 0) {
                    const f32x4* xr = (const f32x4*)EMB_ROW(r) + l32;
#pragma unroll
                    for (int j = 0; j < 16; ++j) v[j] = xr[32 * j]; }
                else { u32x2 s_[16];
#pragma unroll
                    for (int j = 0; j < 16; ++j) s_[j] = ((const u32x2*)(HRES16 + (size_t)r * DM))[l32 + 32 * j];
#pragma unroll
                    for (int j = 0; j < 16; ++j) { const u32x2 q = s_[j]; v[j].x = bf_lo(q.x); v[j].y = bf_hi(q.x); v[j].z = bf_lo(q.y); v[j].w = bf_hi(q.y); } }
                norm_row2<true, false, false, true, true>(nullptr, HRES16 + (size_t)r * DM, norm_ffn + layer * DM, nullptr, lanep, valid, v, rstd, GB + (size_t)r * DM);
#else
                const float* hsrc = layer == 0 ? EMB_ROW(r) : HRES + (size_t)r * DM;
                norm_row2<true, false>(hsrc, HRES + (size_t)r * DM, norm_ffn + layer * DM, (layer == 0 && !MK_F8_DENSE) ? H + (size_t)r * DM : nullptr, lanep, valid, v, rstd, GB + (size_t)r * DM);
#endif
                if ((layer == 1 || MK_F8_DENSE) && valid) {
                    unsigned* o4 = (unsigned*)((unsigned char*)H + (size_t)r * DM) + l32;
#pragma unroll
                    for (int j = 0; j < 16; ++j) o4[32 * j] = cvt4_fp8(v[j].x * F8_SA, v[j].y * F8_SA, v[j].z * F8_SA, v[j].w * F8_SA); }
                if (layer == 1) {
                    float lg[8];
#pragma unroll
                    for (int e = 0; e < 8; ++e) lg[e] = 0.f;
#pragma unroll
                    for (int j = 0; j < 16; ++j) { const f32x4* rp = (const f32x4*)(router + (size_t)(4 * (l32 + 32 * j)) * 8);
#pragma unroll
                        for (int q = 0; q < 4; ++q) { const f32x4 ra = rp[2 * q], rb = rp[2 * q + 1]; const float hv = v[j][q];
                            lg[0] += hv * ra.x; lg[1] += hv * ra.y; lg[2] += hv * ra.z; lg[3] += hv * ra.w; lg[4] += hv * rb.x; lg[5] += hv * rb.y; lg[6] += hv * rb.z; lg[7] += hv * rb.w; } }
#pragma unroll
                    for (int e = 0; e < 8; ++e) lg[e] = half_sum(lg[e], lanep);
                    if (l32 == 0 && !valid) lrec[4 * (nit * 16 + wave * 2 + (lanep >> 5))] = -1;
                    if (l32 == 0 && valid) { int e1 = 0; float v1 = lg[0];
#pragma unroll
                        for (int e = 1; e < 8; ++e) if (lg[e] > v1) { v1 = lg[e]; e1 = e; }
                        int e2 = -1; float v2 = -INFINITY;
#pragma unroll
                        for (int e = 0; e < 8; ++e) if (e != e1 && lg[e] > v2) { v2 = lg[e]; e2 = e; }
                        if (e2 < 0) e2 = (e1 + 1) & 7;
                        const float w1 = 1.0f / (1.0f + expf(v2 - v1)), w2 = 1.0f - w1;
                        const int s1 = __hip_atomic_fetch_add(lcnt + e1, 1, __ATOMIC_RELAXED, __HIP_MEMORY_SCOPE_WORKGROUP), s2 = __hip_atomic_fetch_add(lcnt + e2, 1, __ATOMIC_RELAXED, __HIP_MEMORY_SCOPE_WORKGROUP);
                        LAS int* rc = lrec + 4 * (nit * 16 + wave * 2 + (lanep >> 5)); rc[0] = r; rc[1] = e1 | (e2 << 8); rc[2] = s1; rc[3] = s2;
                        TOKE[r] = e1; TOKE[T + r] = e2; TOKW[r] = w1; TOKW[T + r] = w2; }
                }
            }
            if (layer == 1) {
                __syncthreads();
                if (tidp < 8) lcnt[8 + tidp] = (int)atomicAdd(CNT + tidp, (unsigned)lcnt[tidp]);
                __syncthreads();
                for (int i = tidp; i < nitmax * 16; i += NWAVES * 64) { const int r = lrec[4 * i];
                    if (r >= 0) { const int ee = lrec[4 * i + 1]; TOKS[r] = lcnt[8 + (ee & 255)] + lrec[4 * i + 2]; TOKS[T + r] = lcnt[8 + (ee >> 8)] + lrec[4 * i + 3]; } }
                __syncthreads();
            }
            SEAM(pb + 4);
        }
        if (layer == 0) {
            if (IN(6)) { PHASE_LOCALS;
                SchedPlain S; S.o.init(NPAN, NHID2 / 256, Gp, bx); S.A = (const char*)H; S.B = (const char*)DWGU; S.astep = (size_t)256 * DM * 2; S.bstep = (size_t)256 * DM * 2;
#if MK_F8_DENSE
                S.astep = (size_t)256 * DM; S.bstep = (size_t)256 * DM;
                EpiSwi8 E{(unsigned char*)HID};
                pg8::gemm_phase<EpiSwi8, SchedPlain, false, true>(lds, DM / 128, DM, DM, S, E);
                SEAM(6);
#else
                EpiSwi E{HID};
#pragma unroll 1
                for (int rep = 0; rep < MK_REP_P5; ++rep) {
                pg8::gemm_phase<EpiSwi, SchedPlain, false>(lds, DM / 64, DM * 2, DM * 2, S, E);
                SEAM(6); }
#endif
            }
            if (IN(7)) { PHASE_LOCALS;
                SchedPlain S; S.o.init(NPAN, DM / 256, Gp, bx); S.A = (const char*)HID; S.B = (const char*)DWD; S.astep = (size_t)256 * DFF * 2; S.bstep = (size_t)256 * DFF * 2;
#if MK_F8_DENSE
                S.astep = (size_t)256 * DFF; S.bstep = (size_t)256 * DFF;
                EpiDelta E{H, 1.0f / (F8_SH * F8_SW)};
                pg8::gemm_phase<EpiDelta, SchedPlain, false, true>(lds, DFF / 128, DFF, DFF, S, E);
                SEAM(7);
#else
#pragma unroll 1
                for (int rep = 0; rep < MK_REP_P6; ++rep) {
                EpiRes E{HRES, (rep + 1 < MK_REP_P6) ? 0.f : 1.f};
                pg8::gemm_phase<EpiRes, SchedPlain, false>(lds, DFF / 64, DFF * 2, DFF * 2, S, E);
                SEAM(7); }
#endif
            }
            if (IN(8)) { PHASE_LOCALS;
#pragma unroll 1
                for (int rep = 0; rep < MK_REP_N1; ++rep) {
                for (int r0 = gw; r0 < T; r0 += 2 * NGW) { const int rr = r0 + (lanep >> 5) * NGW; const bool valid = rr < T; const int r = valid ? rr : r0;
                    f32x4 v[16]; float rstd;
#if MK_HRES16
                    norm_row2<true, false, true, true>(HRES16 + (size_t)r * DM, HRES16 + (size_t)r * DM, norm_mix + DM, H + (size_t)r * DM, lanep, valid, v, rstd, H + (size_t)r * DM);
#else
                    norm_row2<MK_F8_DENSE != 0, false>(HRES + (size_t)r * DM, HRES + (size_t)r * DM, norm_mix + DM, H + (size_t)r * DM, lanep, valid, v, rstd, H + (size_t)r * DM);
#endif
                    if (valid && r < TX) { unsigned* o4 = (unsigned*)(H8P + (size_t)r * DM) + (lanep & 31);
#pragma unroll
                        for (int j = 0; j < 16; ++j) o4[32 * j] = cvt4_fp8(v[j].x * F8_SA, v[j].y * F8_SA, v[j].z * F8_SA, v[j].w * F8_SA); } }
                SEAM(8); }
            }
        } else {
            MoeMap mm; int rb[9];
            { unsigned char* wsp = (unsigned char*)(GAS unsigned char*)args.ws; int p = 0;
#pragma unroll
              for (int e = 0; e < 8; ++e) { const int c = (int)__hip_atomic_load(CNT + e, __ATOMIC_RELAXED, __HIP_MEMORY_SCOPE_AGENT); mm.pb[e] = p; rb[e] = p * 256; p = min(p + ((c + 255) >> 8), MOE_MAXPAN); }
              mm.pb[8] = p; rb[8] = p * 256; }
            if (IN(14)) { PHASE_LOCALS;
                for (int i = gw * 4 + (lanep >> 4); i < 2 * TX; i += NGW * 4) {
                    const int k = i >= TX ? 1 : 0, tok = i - k * TX; const int e = TOKE[k * T + tok], s = TOKS[k * T + tok];
                    int base = 0;
#pragma unroll
                    for (int j = 0; j < 8; ++j) base = (j == e) ? rb[j] : base;
                    if (e >= 0 && e < 8 && s >= 0 && base + s < MOE_MAXROWS) { const int pos = base + s; const int l16 = lanep & 15;
                        if (l16 == 0) { ROWL[pos] = tok | (k << 30); ROWW[pos] = TOKW[k * T + tok]; }
                        const u32x4* src = (const u32x4*)((const unsigned char*)H + (size_t)tok * DM) + l16; u32x4* dst = (u32x4*)(wsp + WS_H8S + (size_t)pos * DM) + l16;
                        u32x4 t[8];
#pragma unroll
                        for (int j = 0; j < 8; ++j) t[j] = src[16 * j];
#pragma unroll
                        for (int j = 0; j < 8; ++j) dst[16 * j] = t[j]; } }
                SEAM(14);
            }
            if (IN(15)) { PHASE_LOCALS;
                SchedMoeUp S; S.o.init(mm.pb[8], NHID2 / 256, Gp, bx); S.A = (const char*)(wsp + WS_H8S); S.B = (const char*)MWGU; S.mm = mm;
                EpiSwi8 E{(unsigned char*)HID};
                pg8::gemm_phase<EpiSwi8, SchedMoeUp, false, true>(lds, DM / 128, DM, DM, S, E);
                SEAM(15);
            }
            if (IN(16)) { PHASE_LOCALS;
                SchedMoeDown S; S.o.init(mm.pb[8], DM / 256, Gp, bx, 1); S.A = (const char*)HID; S.B = (const char*)MWD; S.mm = mm;
                EpiMoeDown E{(bf16_t*)(wsp + WS_OUT2A), (bf16_t*)(wsp + WS_OUT2B), ROWL, ROWW, 1.0f / (F8_SH * F8_SW)};
                pg8::gemm_phase<EpiMoeDown, SchedMoeDown, false, true>(lds, DFF / 128, DFF, DFF, S, E);
                SEAM(16);
            }
            if (IN(17)) { PHASE_LOCALS;
                for (int r0 = gw; r0 < TX; r0 += 2 * NGW) { const int rr = r0 + (lanep >> 5) * NGW; const bool valid = rr < TX; const int r = valid ? rr : r0;
                    f32x4 v[16]; float rstd; norm_row2<true, true, MK_HRES16 != 0, false>(MK_HRES16 ? (const void*)(HRES16 + (size_t)r * DM) : (const void*)(HRES + (size_t)r * DM), nullptr, norm_final, nullptr, lanep, valid, v, rstd, (const bf16_t*)(wsp + WS_OUT2A) + (size_t)r * DM, (const bf16_t*)(wsp + WS_OUT2B) + (size_t)r * DM);
                    if (valid) { f32x4* op = (f32x4*)((float*)(GAS float*)args.out + (size_t)r * DM) + (lanep & 31);
#pragma unroll
                        for (int j = 0; j < 16; ++j) op[32 * j] = v[j]; } }
            }
        }
    }
    if (MK_PROBE_BUF != 0 && IN(20)) { PHASE_LOCALS;
        for (int r = gw; r < TX; r += NGW) {
            float* op = (float*)(GAS float*)args.out + (size_t)r * DM; const int rs = MK_PROBE_META ? TX + (r & 255) : r;
            for (int c = lanep; c < DM; c += 64) { bf16_t v;
                if (MK_PROBE_BUF == 1) v = c < 1024 ? QB[(size_t)rs * 1024 + c] : KB[(size_t)rs * 1024 + c - 1024];
                else if (MK_PROBE_BUF == 2) v = c < 1024 ? VB[(size_t)rs * 1024 + c] : UB[(size_t)rs * 1024 + c - 1024];
                else if (MK_PROBE_BUF == 3) v = GB[(size_t)rs * 4096 + c];
                else if (MK_PROBE_BUF == 4) v = GB[(size_t)rs * 4096 + 2048 + c];
                else if (MK_PROBE_BUF == 5) v = c < 1024 ? QB[(size_t)rs * 1024 + c] : MB[(size_t)rs * 1024 + c - 1024];
                else if (MK_PROBE_BUF == 7) v = c < 1024 ? QB[(size_t)rs * 1024 + c] : (bf16_t)0;
                else if (MK_PROBE_BUF == 8) v = c < 1024 ? MB[(size_t)rs * 1024 + c] : (bf16_t)0;
                else v = YB[(size_t)rs * 2048 + c];
                float fv = __uint_as_float((unsigned)v << 16); if (!(fabsf(fv) < 1e30f)) fv = 12345.0f;
                op[c] = fv; } }
    }
#undef IN
#undef SEAM
#undef PHASE_LOCALS
}

extern "C" void kernel_launch(void* const* d_in, const int* in_sizes, int n_in, void* d_out, int out_size, void* d_ws, size_t ws_size, hipStream_t stream) {
    static int grid = 0;
    if (grid == 0) {
        if (n_in != 24 || out_size != TX * DM || ws_size < WS_END) { fprintf(stderr, "kernel_launch: unexpected shapes (n_in %d, out %d, ws %zu < %zu)\n", n_in, out_size, ws_size, (size_t)WS_END); grid = -1; return; }
        int dev = 0, cus = 0;
        if (hipGetDevice(&dev) != hipSuccess || hipDeviceGetAttribute(&cus, hipDeviceAttributeMultiprocessorCount, dev) != hipSuccess) { grid = -1; return; }
        if (hipFuncSetAttribute((const void*)fwd_kernel, hipFuncAttributeMaxDynamicSharedMemorySize, LDS_BYTES) != hipSuccess) { fprintf(stderr, "kernel_launch: hipFuncSetAttribute failed\n"); grid = -1; return; }
        int per_cu = 0;
        if (hipOccupancyMaxActiveBlocksPerMultiprocessor(&per_cu, (const void*)fwd_kernel, NWAVES * 64, LDS_BYTES) != hipSuccess || per_cu < 1) fprintf(stderr, "kernel_launch: occupancy query reports %d\n", per_cu);
        (void)hipGetLastError();
        grid = cus;
    }
    if (grid < 0) return;
    (void)hipMemsetAsync((char*)d_ws + WS_CTL, 0, CTL_ZERO_BYTES, stream);
    Args a{};
    for (int i = 0; i < 24; ++i) a.in[i] = (const float*)d_in[i];
    a.out = (float*)d_out; a.ws = (unsigned char*)d_ws;
#if MK_ONE_LAUNCH
    a.ph_lo = 0; a.ph_hi = NPHASE;
    hipLaunchKernelGGL(fwd_kernel, dim3(grid), dim3(NWAVES * 64), LDS_BYTES, stream, a);
#else
    for (int p = 0; p <= MK_LAST_PHASE; ++p) { a.ph_lo = p; a.ph_hi = p + 1; hipLaunchKernelGGL(fwd_kernel, dim3(grid), dim3(NWAVES * 64), LDS_BYTES, stream, a); }
    if (MK_PROBE_BUF != 0) { a.ph_lo = 20; a.ph_hi = 21; hipLaunchKernelGGL(fwd_kernel, dim3(grid), dim3(NWAVES * 64), LDS_BYTES, stream, a); }
    else if (MK_LAST_PHASE < 17) { a.ph_lo = 17; a.ph_hi = 18; hipLaunchKernelGGL(fwd_kernel, dim3(grid), dim3(NWAVES * 64), LDS_BYTES, stream, a); }
#endif
}
```

```cpp
#include <hip/hip_runtime.h>
#include <cstdio>
#include <cstdint>

#ifndef MK_ONE_LAUNCH
#define MK_ONE_LAUNCH 1
#endif
#ifndef MK_REP_P0
#define MK_REP_P0 1
#endif
#ifndef MK_REP_P5
#define MK_REP_P5 1
#endif
#ifndef MK_REP_ATT
#define MK_REP_ATT 1
#endif
#ifndef MK_REP_M
#define MK_REP_M 1
#endif
#ifndef MK_REP_P1
#define MK_REP_P1 1
#endif
#ifndef MK_REP_P3
#define MK_REP_P3 1
#endif
#ifndef MK_REP_N1
#define MK_REP_N1 1
#endif
#ifndef MK_REP_P4
#define MK_REP_P4 1
#endif
#ifndef MK_REP_P6
#define MK_REP_P6 1
#endif
#ifndef MK_REP_MUP
#define MK_REP_MUP 1
#endif
#ifndef MK_F8_DENSE
#define MK_F8_DENSE 1
#endif
#ifndef MK_REP_MOE
#define MK_REP_MOE 1
#endif
#ifndef MK_HRES16
#define MK_HRES16 1
#endif
#ifndef MK_REP_EPI
#define MK_REP_EPI 1
#endif
#ifndef MK_PROBE_META
#define MK_PROBE_META 0
#endif
#ifndef MK_PROBE_BUF
#define MK_PROBE_BUF 0
#endif
#ifndef MK_LAST_PHASE
#define MK_LAST_PHASE 17
#endif

#define LAS __attribute__((address_space(3)))
#define GAS __attribute__((address_space(1)))
typedef unsigned short bf16_t;
typedef short bf16x8 __attribute__((ext_vector_type(8)));
typedef short s16x4 __attribute__((ext_vector_type(4)));
typedef float f32x2 __attribute__((ext_vector_type(2)));
typedef float f32x4 __attribute__((ext_vector_type(4)));
typedef float f32x16 __attribute__((ext_vector_type(16)));
typedef unsigned u32x2 __attribute__((ext_vector_type(2)));
typedef unsigned u32x4 __attribute__((ext_vector_type(4)));

constexpr int NB = 16, SEQ = 2048, NMETA = 16, LTOK = SEQ + NMETA, DM = 2048;
constexpr int T = NB * LTOK;
constexpr int TX = NB * SEQ;
constexpr int NPAN = T / 256;
constexpr int AW = 1024, NH = 8, DFF = 5632, NE = 8, INC = 8192;
constexpr int NHID2 = 2 * DFF;
constexpr float EPS = 1e-5f;
constexpr float LOG2E = 1.4426950408889634f;
constexpr float QSCALE = 0.125f * LOG2E;
constexpr int MOE_MAXPAN = 264, MOE_MAXROWS = MOE_MAXPAN * 256;
constexpr int NWAVES = 8;

__device__ __forceinline__ int row_pos(int r) { return r < TX ? NMETA + (r & (SEQ - 1)) : ((r - TX) & (NMETA - 1)); }
__device__ __forceinline__ int row_batch(int r) { return r < TX ? (r >> 11) : ((r - TX) >> 4); }
__device__ __forceinline__ int row_of(int b, int pos) { return pos < NMETA ? TX + b * NMETA + pos : b * SEQ + pos - NMETA; }

constexpr size_t MiB = 1u << 20;
constexpr size_t WS_CTL = 0, CTL_ZERO_BYTES = 1 * MiB;
constexpr size_t WS_ROPE = 1 * MiB;
constexpr size_t WS_TOKE = 2 * MiB, WS_TOKS = 2 * MiB + 320 * 1024, WS_TOKW = 2 * MiB + 640 * 1024;
constexpr size_t WS_ROWL = 3 * MiB, WS_ROWW = 3 * MiB + 320 * 1024;
constexpr size_t WS_WIN = 5 * MiB;
constexpr size_t WS_WBA = 69 * MiB;
constexpr size_t WS_WC = 77 * MiB;
constexpr size_t WS_WOUT = 85 * MiB;
constexpr size_t WS_DWGU = 101 * MiB;
constexpr size_t WS_DWD = 145 * MiB;
constexpr size_t WS_MWGU = 167 * MiB;
constexpr size_t WS_MWD = 519 * MiB;
constexpr size_t WS_HRES = 695 * MiB;
constexpr size_t WS_H = 953 * MiB;
constexpr size_t WS_Z = 1082 * MiB;
constexpr size_t ZSTEP = (size_t)T * 1024 * 2;
constexpr size_t WS_Q = WS_Z, WS_K = WS_Z + ZSTEP, WS_V = WS_Z + 2 * ZSTEP, WS_U = WS_Z + 3 * ZSTEP, WS_G = WS_Z + 4 * ZSTEP;
constexpr size_t WS_Y = WS_K;
constexpr size_t WS_HID = WS_Z;
constexpr size_t WS_OUT2A = WS_WIN, WS_OUT2B = WS_H;
static_assert(WS_OUT2A + (size_t)T * 2048 * 2 <= WS_MWGU, "OUT2A over dead weights");
constexpr size_t WS_H8S = WS_Z + 368 * MiB;
constexpr size_t WS_END = WS_Z + 8 * ZSTEP;
static_assert(WS_MWD + (size_t)8 * 2048 * 5632 * 2 <= WS_HRES && WS_HRES + (size_t)T * 2048 * 4 <= WS_H && WS_H + (size_t)T * 2048 * 2 <= WS_Z, "ws map");
static_assert((size_t)MOE_MAXROWS * DFF <= 368 * MiB && WS_H8S + (size_t)MOE_MAXROWS * DM <= WS_END && (size_t)T * DFF * 2 <= 8 * ZSTEP, "hidden / gathered rows fit Z"); static_assert((size_t)MOE_MAXROWS * 4 <= 320 * 1024, "row tables");
constexpr int CW_BAR = 4096;
constexpr int CW_CNT = 8192;

typedef __bf16 bf16x2_t __attribute__((ext_vector_type(2)));
__device__ __forceinline__ unsigned cvt_pk_bf16(float lo, float hi) { const f32x2 v = {lo, hi}; const bf16x2_t b = __builtin_convertvector(v, bf16x2_t); return __builtin_bit_cast(unsigned, b); }
__device__ __forceinline__ float bf_lo(unsigned u) { return __uint_as_float(u << 16); }
__device__ __forceinline__ float bf_hi(unsigned u) { return __uint_as_float(u & 0xffff0000u); }
__device__ __forceinline__ float shfl_xor_l(float v, int o, int lane) { return __int_as_float(__builtin_amdgcn_ds_bpermute((lane ^ o) << 2, __float_as_int(v))); }
__device__ __forceinline__ float wave_sum(float v, int lane) {
#pragma unroll
    for (int o = 1; o < 64; o <<= 1) v += shfl_xor_l(v, o, lane);
    return v;
}
__device__ __forceinline__ float fast_sigmoid(float x) { return __builtin_amdgcn_rcpf(1.0f + __builtin_amdgcn_exp2f(-x * LOG2E)); }
constexpr float F8_SA = 16.0f, F8_SW = 256.0f, F8_SH = 8.0f;
__device__ __forceinline__ float f8_clamp(float x) { return __builtin_fminf(__builtin_fmaxf(x, -448.0f), 448.0f); }
__device__ __forceinline__ unsigned cvt4_fp8(float a, float b, float c, float d) {
    int r = __builtin_amdgcn_cvt_pk_fp8_f32(f8_clamp(a), f8_clamp(b), 0, false); r = __builtin_amdgcn_cvt_pk_fp8_f32(f8_clamp(c), f8_clamp(d), r, true); return (unsigned)r; }
#define NT_STORE16(p, v) __builtin_nontemporal_store((v), (u32x4*)(p))
#define LDS_WAIT() asm volatile("s_waitcnt lgkmcnt(0)" ::: "memory")
#define VM_WAIT() asm volatile("s_waitcnt vmcnt(0)" ::: "memory")

namespace pg8 {
constexpr int BM = 256, BK = 64, HALF = 128, HTB = HALF * BK * 2, STAGE_BYTES = 8 * HTB, NXCD = 8, WGM = 8;
__host__ __device__ __forceinline__ int lds_byte(int r, int c) { const int st = (r >> 4) * 2 + (c >> 5), rr = r & 15, cc = c & 31, ob = rr * 64 + cc * 2; return st * 1024 + (ob ^ (((ob >> 9) & 1) << 5)); }
__host__ __device__ __forceinline__ void stage_rc(int b, int& R, int& C) { const int st = b / 1024, sb = b % 1024, swz = sb ^ (((sb >> 9) & 1) << 5); R = (st >> 1) * 16 + swz / 64; C = (st & 1) * 32 + (swz % 64) / 2; }
__host__ __device__ __forceinline__ int perm32(int rho) { const int n = rho >> 4, i = rho & 15; return 8 * (i >> 2) + 4 * n + (i & 3); }

struct Unit { const char* a; const char* b; int pm, pn, aux; };
template <class E, class = void> struct epi_chain { static constexpr bool value = false; };
template <class E> struct epi_chain<E, decltype((void)E::CHAIN)> { static constexpr bool value = E::CHAIN; };

struct TileOrder {
    int nM, nN, nwg, G, c, pnfast;
    __device__ __forceinline__ void init(int nM_, int nN_, int G_, int c_, int pnfast_ = 0) { nM = nM_; nN = nN_; nwg = nM * nN; G = G_; c = c_; pnfast = pnfast_; }
    __device__ __forceinline__ bool tile(int i, int& pm, int& pn) const { return tileL((long)i * G + c, pm, pn); }
    __device__ __forceinline__ bool tileL(const long L, int& pm, int& pn) const {
        if (L >= nwg) return false;
        int wgid = (int)L; { const int q = nwg / NXCD, r = nwg % NXCD, xcd = wgid % NXCD, off = wgid / NXCD; wgid = (xcd < r ? xcd * (q + 1) : r * (q + 1) + (xcd - r) * q) + off; }
        const int nig = WGM * nN, gid = wgid / nig, fm = gid * WGM, gsz = (nM - fm) < WGM ? (nM - fm) : WGM;
        if (pnfast) { pn = (wgid % nig) % nN; pm = fm + (wgid % nig) / nN; }
        else { pm = fm + ((wgid % nig) % gsz); pn = (wgid % nig) / gsz; }
        return true;
    }
};

typedef int i32x8 __attribute__((ext_vector_type(8)));
template <class Epi, class Sched, bool GATHER, bool F8 = false>
__device__ __forceinline__ void gemm_phase(LAS unsigned char* lds, const int nt, const int ldaB, const int ldbB, const Sched& S, const Epi& E) {
    int tid_ = threadIdx.x; asm volatile("" : "+v"(tid_));
    const int tid = tid_, wid = __builtin_amdgcn_readfirstlane(tid >> 6), lane = tid & 63, wr = wid >> 2, wc = wid & 3, fr = lane & 15, fq = lane >> 4;
    unsigned voffA[2], voffB[2]; int RA[2], CA[2];
#pragma unroll
    for (int i = 0; i < 2; ++i) { int R, C; stage_rc(tid * 16 + i * 8192, R, C); const int Rb = Epi::PERM ? ((R & ~31) + perm32(R & 31)) : R;
        voffA[i] = (unsigned)(R * ldaB + C * 2); voffB[i] = (unsigned)(Rb * ldbB + C * 2); RA[i] = R; CA[i] = C * 2; }
    const size_t kstep = (size_t)(BK * 2);
    const size_t hstepA = (size_t)HALF * ldaB, hstepB = (size_t)HALF * ldbB;
    const unsigned ldsw = (unsigned)wid * 1024u;
    const int aoff = lds_byte(wr * 64 + fr, fq * 8), boff = lds_byte(wc * 32 + fr, fq * 8);
    unsigned cO[2][2], nO[2][2], sO[2][2];
#define PG8_SA(b, h) (((b) * 2 + (h)) * HTB)
#define PG8_SB(b, h) ((4 + (b) * 2 + (h)) * HTB)
#define PG8_STAGE_B(bufoff, gbase) do { _Pragma("unroll") for (int _i = 0; _i < 2; ++_i) \
        __builtin_amdgcn_global_load_lds((const unsigned*)((const char*)(gbase) + voffB[_i]), (LAS unsigned*)(lds + (bufoff) + ldsw + _i * 8192), 16, 0, 0); } while (0)
#define PG8_STAGE_A(bufoff, gbase, h, O) do { _Pragma("unroll") for (int _i = 0; _i < 2; ++_i) { \
        const char* _p = GATHER ? ((const char*)(gbase) + (O)[h][_i]) : ((const char*)(gbase) + (size_t)(h) * hstepA + voffA[_i]); \
        __builtin_amdgcn_global_load_lds((const unsigned*)_p, (LAS unsigned*)(lds + (bufoff) + ldsw + _i * 8192), 16, 0, 0); } } while (0)
#define PG8_LD16(off) (*(const LAS u32x4*)(lds + (off)))
#define PG8_CAT(lo, hi) __builtin_bit_cast(i32x8, __builtin_shufflevector(lo, hi, 0, 1, 2, 3, 4, 5, 6, 7))
#define PG8_LDA(dst, b, h) do { _Pragma("unroll") for (int m = 0; m < 4; ++m) { if constexpr (F8) dst##8[m] = PG8_CAT(PG8_LD16(PG8_SA(b, h) + aoff + m * 2048), PG8_LD16(PG8_SA(b, h) + aoff + m * 2048 + 1024)); \
        else { _Pragma("unroll") for (int k = 0; k < 2; ++k) dst[m][k] = *(const LAS bf16x8*)(lds + PG8_SA(b, h) + aoff + m * 2048 + k * 1024); } } } while (0)
#define PG8_LDB(dst, b, h) do { _Pragma("unroll") for (int n = 0; n < 2; ++n) { if constexpr (F8) dst##8[n] = PG8_CAT(PG8_LD16(PG8_SB(b, h) + boff + n * 2048), PG8_LD16(PG8_SB(b, h) + boff + n * 2048 + 1024)); \
        else { _Pragma("unroll") for (int k = 0; k < 2; ++k) dst[n][k] = *(const LAS bf16x8*)(lds + PG8_SB(b, h) + boff + n * 2048 + k * 1024); } } } while (0)
#define PG8_MMA(ai, bj, At, Bt) do { __builtin_amdgcn_s_setprio(1); _Pragma("unroll") for (int m = 0; m < 4; ++m) _Pragma("unroll") for (int n = 0; n < 2; ++n) { \
        if constexpr (F8) asm volatile("v_mfma_scale_f32_16x16x128_f8f6f4 %0, %1, %2, %0, %3, %3 op_sel_hi:[0,0,0]" : "+v"(acc[ai][bj][m][n]) : "v"(Bt##8[n]), "v"(At##8[m]), "v"(f8one));   \
        else { _Pragma("unroll") for (int k = 0; k < 2; ++k) acc[ai][bj][m][n] = __builtin_amdgcn_mfma_f32_16x16x32_bf16(Bt[n][k], At[m][k], acc[ai][bj][m][n], 0, 0, 0); } } \
        __builtin_amdgcn_s_setprio(0); } while (0)
#define PG8_WAIT_V(n) asm volatile("s_waitcnt vmcnt(" #n ")" ::: "memory")
#define PG8_WAIT_L(n) asm volatile("s_waitcnt lgkmcnt(" #n ")" ::: "memory")
#define PG8_BAR __builtin_amdgcn_s_barrier()
#define PG8_SCHED __builtin_amdgcn_sched_barrier(0)
#define PG8_ROWS(dst, u) do { const int* _rw = S.rows(u); _Pragma("unroll") for (int _h = 0; _h < 2; ++_h) _Pragma("unroll") for (int _i = 0; _i < 2; ++_i) { \
        int _t = _rw[_h * HALF + RA[_i]]; _t = _t < 0 ? 0 : (_t >= T ? T - 1 : _t); dst[_h][_i] = (unsigned)_t * (unsigned)ldaB + (unsigned)CA[_i]; } } while (0)
    Unit cur, nxt; int ui = 0;
    if (!S.next(0, cur)) return;
    f32x4 acc[2][2][4][2];
#pragma unroll
    for (int a = 0; a < 2; ++a)
#pragma unroll
        for (int b = 0; b < 2; ++b)
#pragma unroll
            for (int m = 0; m < 4; ++m)
#pragma unroll
                for (int n = 0; n < 2; ++n) acc[a][b][m][n] = (f32x4){0.f, 0.f, 0.f, 0.f};
    int f8one = 0x7F7F7F7F; asm volatile("" : "+v"(f8one));
    bf16x8 At[4][2], B0[2][2], B1[2][2]; i32x8 At8[4], B08[2], B18[2];
    const char* cA = cur.a; const char* cB = cur.b;
    if constexpr (GATHER) { PG8_ROWS(cO, cur); }
    PG8_STAGE_B(PG8_SB(0, 0), cB); PG8_STAGE_B(PG8_SB(0, 1), cB + hstepB); PG8_STAGE_A(PG8_SA(0, 0), cA, 0, cO); PG8_STAGE_A(PG8_SA(0, 1), cA, 1, cO);
    if (wr == 1) PG8_BAR;
    PG8_WAIT_V(2); PG8_BAR;
    PG8_STAGE_B(PG8_SB(1, 0), cB + kstep); PG8_STAGE_A(PG8_SA(1, 0), cA + kstep, 0, cO); PG8_STAGE_B(PG8_SB(1, 1), cB + hstepB + kstep);
    PG8_WAIT_V(6); PG8_BAR;
    for (;;) {
        const bool has_next = S.next(ui + 1, nxt);
        const char* nA = has_next ? nxt.a : cA; const char* nB = has_next ? nxt.b : cB;
        if constexpr (GATHER) { if (has_next) { PG8_ROWS(nO, nxt); } else {
#pragma unroll
            for (int h = 0; h < 2; ++h)
#pragma unroll
                for (int i = 0; i < 2; ++i) nO[h][i] = cO[h][i]; } }
        for (int t = 0; t < nt; t += 2) {
            const bool last = (t == nt - 2);
            const char* a1 = cA + (size_t)(t + 1) * kstep;
            const char* a2 = last ? nA : cA + (size_t)(t + 2) * kstep; const char* b2 = last ? nB : cB + (size_t)(t + 2) * kstep;
            const char* a3 = a2 + kstep; const char* b3 = b2 + kstep;
            if constexpr (GATHER) {
#pragma unroll
                for (int h = 0; h < 2; ++h)
#pragma unroll
                    for (int i = 0; i < 2; ++i) sO[h][i] = last ? nO[h][i] : cO[h][i]; }
            PG8_LDB(B0, 0, 0); PG8_LDB(B1, 0, 1); PG8_SCHED; PG8_LDA(At, 0, 0); PG8_STAGE_A(PG8_SA(1, 1), a1, 1, cO);
            PG8_WAIT_V(8); PG8_WAIT_L(0); PG8_BAR; PG8_MMA(0, 0, At, B0); PG8_MMA(0, 1, At, B1); PG8_BAR; PG8_SCHED;
            PG8_LDA(At, 0, 1); PG8_STAGE_B(PG8_SB(0, 0), b2); PG8_STAGE_B(PG8_SB(0, 1), b2 + hstepB); PG8_STAGE_A(PG8_SA(0, 0), a2, 0, sO);
            PG8_WAIT_V(8); PG8_WAIT_L(0); PG8_BAR; PG8_MMA(1, 0, At, B0); PG8_MMA(1, 1, At, B1); PG8_BAR; PG8_SCHED;
            PG8_LDB(B0, 1, 0); PG8_LDB(B1, 1, 1); PG8_SCHED; PG8_LDA(At, 1, 0); PG8_STAGE_A(PG8_SA(0, 1), a2, 1, sO);
            PG8_WAIT_V(8); PG8_WAIT_L(0); PG8_BAR; PG8_MMA(0, 0, At, B0); PG8_MMA(0, 1, At, B1); PG8_BAR; PG8_SCHED;
            PG8_LDA(At, 1, 1); PG8_STAGE_B(PG8_SB(1, 0), b3); PG8_STAGE_B(PG8_SB(1, 1), b3 + hstepB); PG8_STAGE_A(PG8_SA(1, 0), a3, 0, sO);
            PG8_WAIT_V(8); PG8_WAIT_L(0); PG8_BAR; PG8_MMA(1, 0, At, B0); PG8_MMA(1, 1, At, B1); PG8_BAR; PG8_SCHED;
        }
        if (wr == 0) PG8_BAR;
        if constexpr (F8) asm volatile("s_nop 15\n\ts_nop 15" ::: "memory");
        bool keep = false;
        if constexpr (epi_chain<Epi>::value) { if (cur.aux == 0) { E.mid(acc, cur, wr, wc, fr, fq); keep = true; } else E(acc, cur, wr, wc, fr, fq); }
        else E(acc, cur, wr, wc, fr, fq);
        if (!has_next) break;
        if (!keep) {
#pragma unroll
        for (int a = 0; a < 2; ++a)
#pragma unroll
            for (int b = 0; b < 2; ++b)
#pragma unroll
                for (int m = 0; m < 4; ++m)
#pragma unroll
                    for (int n = 0; n < 2; ++n) acc[a][b][m][n] = (f32x4){0.f, 0.f, 0.f, 0.f}; }
        cur = nxt; cA = nA; cB = nB; ++ui;
        if constexpr (GATHER) {
#pragma unroll
            for (int h = 0; h < 2; ++h)
#pragma unroll
                for (int i = 0; i < 2; ++i) cO[h][i] = nO[h][i]; }
        if (wr == 1) PG8_BAR;
    }
    PG8_WAIT_V(0);
    PG8_BAR;
#undef PG8_SA
#undef PG8_SB
#undef PG8_STAGE_A
#undef PG8_STAGE_B
#undef PG8_LDA
#undef PG8_LDB
#undef PG8_MMA
#undef PG8_CAT
#undef PG8_LD16
#undef PG8_WAIT_V
#undef PG8_WAIT_L
#undef PG8_BAR
#undef PG8_SCHED
#undef PG8_ROWS
}
}

using pg8::Unit;
typedef f32x4 Acc[2][2][4][2];

struct EpiIn {
    static constexpr bool PERM = true;
    bf16_t *Q, *Kb, *V, *U, *G; const float* bgate; const float* rope;
    __device__ __forceinline__ void operator()(const Acc& acc, const Unit& u, int wr, int wc, int fr, int fq) const {
        const int row0 = u.pm * 256 + wr * 64 + fr;
        if (u.pn < 8) {
            bf16_t* base = u.pn < 4 ? Q : Kb; const float sc = u.pn < 4 ? QSCALE : 1.0f; const int ct = (u.pn & 3) * 256 + wc * 64 + 8 * fq;
            f32x4 cs[2][2][4];
#define ROPE_LD(bf, st) do { _Pragma("unroll") for (int g = 0; g < 2; ++g) { const int gi = (st) * 2 + g, row = row0 + (gi >> 2) * 128 + (gi & 3) * 16; const float* tb = rope + row_pos(row) * 64 + 8 * fq; \
                cs[bf][g][0] = *(const f32x4*)tb; cs[bf][g][1] = *(const f32x4*)(tb + 4); cs[bf][g][2] = *(const f32x4*)(tb + 32); cs[bf][g][3] = *(const f32x4*)(tb + 36); } } while (0)
#define ROPE_DO(bf, st) do { _Pragma("unroll") for (int g = 0; g < 2; ++g) { const int gi = (st) * 2 + g, ai = gi >> 2, m = gi & 3, row = row0 + ai * 128 + m * 16; \
                const f32x4 c0 = cs[bf][g][0], c1 = cs[bf][g][1], s0 = cs[bf][g][2], s1 = cs[bf][g][3]; \
                const f32x4 t1a = acc[ai][0][m][0], t1b = acc[ai][0][m][1], t2a = acc[ai][1][m][0], t2b = acc[ai][1][m][1]; \
                const f32x4 o1a = (t1a * c0 - t2a * s0) * sc, o1b = (t1b * c1 - t2b * s1) * sc, o2a = (t2a * c0 + t1a * s0) * sc, o2b = (t2b * c1 + t1b * s1) * sc; \
                u32x4 w1, w2; w1.x = cvt_pk_bf16(o1a[0], o1a[1]); w1.y = cvt_pk_bf16(o1a[2], o1a[3]); w1.z = cvt_pk_bf16(o1b[0], o1b[1]); w1.w = cvt_pk_bf16(o1b[2], o1b[3]); \
                w2.x = cvt_pk_bf16(o2a[0], o2a[1]); w2.y = cvt_pk_bf16(o2a[2], o2a[3]); w2.z = cvt_pk_bf16(o2b[0], o2b[1]); w2.w = cvt_pk_bf16(o2b[2], o2b[3]); \
                bf16_t* rp = base + (size_t)row * 1024 + ct; NT_STORE16(rp, w1); NT_STORE16(rp + 32, w2); } } while (0)
            ROPE_LD(0, 0); ROPE_LD(1, 1); __builtin_amdgcn_sched_barrier(0);
            ROPE_DO(0, 0); __builtin_amdgcn_sched_barrier(0); ROPE_LD(0, 2); __builtin_amdgcn_sched_barrier(0);
            ROPE_DO(1, 1); __builtin_amdgcn_sched_barrier(0); ROPE_LD(1, 3); __builtin_amdgcn_sched_barrier(0);
            ROPE_DO(0, 2); __builtin_amdgcn_sched_barrier(0); ROPE_DO(1, 3);
#undef ROPE_LD
#undef ROPE_DO
        } else if (u.pn < 16) {
            bf16_t* base = u.pn < 12 ? V : U; const int ct = (u.pn & 3) * 256 + wc * 32 + 8 * fq;
#pragma unroll
            for (int ai = 0; ai < 2; ++ai)
#pragma unroll
                for (int m = 0; m < 4; ++m) { bf16_t* rp = base + (size_t)(row0 + ai * 128 + m * 16) * 1024 + ct;
#pragma unroll
                    for (int bj = 0; bj < 2; ++bj) { const f32x4 v0 = acc[ai][bj][m][0], v1 = acc[ai][bj][m][1];
                        u32x4 w; w.x = cvt_pk_bf16(v0[0], v0[1]); w.y = cvt_pk_bf16(v0[2], v0[3]); w.z = cvt_pk_bf16(v1[0], v1[1]); w.w = cvt_pk_bf16(v1[2], v1[3]);
                        NT_STORE16(rp + bj * 128, w); } }
        } else {
            const int ct = (u.pn - 16) * 128 + wc * 32 + 8 * fq;
            float nba[8], nbp[8];
#pragma unroll
            for (int n = 0; n < 2; ++n) { const f32x4 a_ = *(const f32x4*)(bgate + ct + 4 * n), p_ = *(const f32x4*)(bgate + 2048 + ct + 4 * n);
#pragma unroll
                for (int j = 0; j < 4; ++j) { nba[n * 4 + j] = a_[j] * -LOG2E; nbp[n * 4 + j] = p_[j] * -LOG2E; } }
#pragma unroll
            for (int ai = 0; ai < 2; ++ai)
#pragma unroll
                for (int m = 0; m < 4; ++m) { bf16_t* rp = G + (size_t)(row0 + ai * 128 + m * 16) * 4096 + ct;
                    float ea[8], ep[8], sp[8];
#pragma unroll
                    for (int j = 0; j < 8; ++j) { ea[j] = __builtin_fmaf(acc[ai][0][m][j >> 2][j & 3], -LOG2E, nba[j]); ep[j] = __builtin_fmaf(acc[ai][1][m][j >> 2][j & 3], -LOG2E, nbp[j]); }
                    __builtin_amdgcn_sched_barrier(0);
#pragma unroll
                    for (int j = 0; j < 8; ++j) { ea[j] = __builtin_amdgcn_exp2f(ea[j]); ep[j] = __builtin_amdgcn_exp2f(ep[j]); }
                    __builtin_amdgcn_sched_barrier(0);
#pragma unroll
                    for (int j = 0; j < 8; ++j) { ea[j] += 1.0f; ep[j] += 1.0f; }
                    __builtin_amdgcn_sched_barrier(0);
#pragma unroll
                    for (int j = 0; j < 8; ++j) { ea[j] = __builtin_amdgcn_rcpf(ea[j]); sp[j] = __builtin_amdgcn_rcpf(ep[j]); }
                    __builtin_amdgcn_sched_barrier(0);
#pragma unroll
                    for (int j = 0; j < 8; ++j) ea[j] *= ep[j];
                    u32x4 w0, w1; w0.x = cvt_pk_bf16(ea[0], ea[1]); w0.y = cvt_pk_bf16(ea[2], ea[3]); w0.z = cvt_pk_bf16(ea[4], ea[5]); w0.w = cvt_pk_bf16(ea[6], ea[7]);
                    w1.x = cvt_pk_bf16(sp[0], sp[1]); w1.y = cvt_pk_bf16(sp[2], sp[3]); w1.z = cvt_pk_bf16(sp[4], sp[5]); w1.w = cvt_pk_bf16(sp[6], sp[7]);
                    NT_STORE16(rp, w0); NT_STORE16(rp + 2048, w1); }
        }
    }
};
struct SchedIn {
    pg8::TileOrder o; const char* A; const char* B;
    __device__ __forceinline__ bool next(int i, Unit& u) const { int pm, pn; if (!o.tile(i, pm, pn)) return false;
        u.pm = pm; u.pn = pn; u.aux = 0; u.a = A + (size_t)pm * 256 * 2048 * 2; u.b = B + (size_t)pn * 256 * 2048 * 2; return true; }
    __device__ __forceinline__ const int* rows(const Unit&) const { return nullptr; }
};

struct SchedInA {
    pg8::TileOrder o; const char* A; const char* B;
    __device__ __forceinline__ bool next(int i, Unit& u) const { int pm, pn;
        if (!o.tile(i, pm, pn)) { const long j = (long)i * o.G + o.c - o.nwg; if (j >= 32) return false; pm = NPAN - 1; pn = (int)j; }
        u.pm = pm; u.pn = pn; u.aux = 0; u.a = A + (size_t)pm * 256 * 2048 * 2; u.b = B + (size_t)pn * 256 * 2048 * 2; return true; }
    __device__ __forceinline__ const int* rows(const Unit&) const { return nullptr; }
};
struct SchedIn8 {
    pg8::TileOrder o; const char* A; const char* B;
    __device__ __forceinline__ bool next(int i, Unit& u) const { int pm, pn; long L;
        if (o.G == 256 && o.nwg == 2048) { if (o.c >= 32) { L = (long)i * 224 + (o.c - 32); if (L >= 2048 - 192) return false; } else { if (i >= 6) return false; L = 2048 - 192 + i * 32 + o.c; } }
        else L = (long)i * o.G + o.c;
        if (!o.tileL(L, pm, pn)) return false;
        u.pm = pm; u.pn = pn; u.aux = 0; u.a = A + (size_t)pm * 256 * 2048; u.b = B + (size_t)pn * 256 * 2048; return true; }
    __device__ __forceinline__ const int* rows(const Unit&) const { return nullptr; }
};
struct EpiGate8 {
    static constexpr bool PERM = true;
    bf16_t* G; const float* bgate;
    __device__ __forceinline__ void operator()(const Acc& acc, const Unit& u, int wr, int wc, int fr, int fq) const {
        const int row0 = u.pm * 256 + wr * 64 + fr, ct = u.pn * 128 + wc * 32 + 8 * fq; constexpr float NS = -LOG2E / (F8_SA * F8_SW);
        float nba[8], nbp[8];
#pragma unroll
        for (int n = 0; n < 2; ++n) { const f32x4 a_ = *(const f32x4*)(bgate + ct + 4 * n), p_ = *(const f32x4*)(bgate + 2048 + ct + 4 * n);
#pragma unroll
            for (int j = 0; j < 4; ++j) { nba[n * 4 + j] = a_[j] * -LOG2E; nbp[n * 4 + j] = p_[j] * -LOG2E; } }
#pragma unroll
        for (int ai = 0; ai < 2; ++ai)
#pragma unroll
            for (int m = 0; m < 4; ++m) { bf16_t* rp = G + (size_t)(row0 + ai * 128 + m * 16) * 4096 + ct;
                float ea[8], ep[8], sp[8];
#pragma unroll
                for (int j = 0; j < 8; ++j) { ea[j] = __builtin_fmaf(acc[ai][0][m][j >> 2][j & 3], NS, nba[j]); ep[j] = __builtin_fmaf(acc[ai][1][m][j >> 2][j & 3], NS, nbp[j]); }
                __builtin_amdgcn_sched_barrier(0);
#pragma unroll
                for (int j = 0; j < 8; ++j) { ea[j] = __builtin_amdgcn_exp2f(ea[j]); ep[j] = __builtin_amdgcn_exp2f(ep[j]); }
                __builtin_amdgcn_sched_barrier(0);
#pragma unroll
                for (int j = 0; j < 8; ++j) { ea[j] += 1.0f; ep[j] += 1.0f; }
                __builtin_amdgcn_sched_barrier(0);
#pragma unroll
                for (int j = 0; j < 8; ++j) { ea[j] = __builtin_amdgcn_rcpf(ea[j]); sp[j] = __builtin_amdgcn_rcpf(ep[j]); }
                __builtin_amdgcn_sched_barrier(0);
#pragma unroll
                for (int j = 0; j < 8; ++j) ea[j] *= ep[j];
                u32x4 w0, w1; w0.x = cvt_pk_bf16(ea[0], ea[1]); w0.y = cvt_pk_bf16(ea[2], ea[3]); w0.z = cvt_pk_bf16(ea[4], ea[5]); w0.w = cvt_pk_bf16(ea[6], ea[7]);
                w1.x = cvt_pk_bf16(sp[0], sp[1]); w1.y = cvt_pk_bf16(sp[2], sp[3]); w1.z = cvt_pk_bf16(sp[4], sp[5]); w1.w = cvt_pk_bf16(sp[6], sp[7]);
                NT_STORE16(rp, w0); NT_STORE16(rp + 2048, w1); }
    }
};

struct SchedWc {
    int G, c; const char* A; const char* B;
    __device__ __forceinline__ bool next(int i, Unit& u) const { const long L = (long)i * G + c; if (L >= 64) return false;
        const int l = (int)L >> 5, g = ((int)L >> 3) & 3, np = (int)L & 7;
        u.pm = l * 8 + np; u.pn = g; u.aux = 0; u.a = A + ((size_t)u.pm * 256 * 1024 + g * 256) * 2; u.b = B + (size_t)(l * 4 + g) * 256 * 256 * 2; return true; }
    __device__ __forceinline__ const int* rows(const Unit&) const { return nullptr; }
};
struct EpiWc {
    static constexpr bool PERM = true;
    bf16_t* D;
    __device__ __forceinline__ void operator()(const Acc& acc, const Unit& u, int wr, int wc, int fr, int fq) const {
        const int row0 = u.pm * 256 + wr * 64 + fr, col0 = u.pn * 256 + wc * 32 + 8 * fq;
#pragma unroll
        for (int ai = 0; ai < 2; ++ai)
#pragma unroll
            for (int m = 0; m < 4; ++m) { bf16_t* rp = D + (size_t)(row0 + ai * 128 + m * 16) * 1024 + col0;
#pragma unroll
                for (int bj = 0; bj < 2; ++bj) { const f32x4 v0 = acc[ai][bj][m][0], v1 = acc[ai][bj][m][1];
                    u32x4 o; o.x = cvt_pk_bf16(v0[0], v0[1]); o.y = cvt_pk_bf16(v0[2], v0[3]); o.z = cvt_pk_bf16(v1[0], v1[1]); o.w = cvt_pk_bf16(v1[2], v1[3]);
                    *(u32x4*)(rp + bj * 128) = o; } }
    }
};

struct EpiY {
    static constexpr bool PERM = true, CHAIN = true;
    bf16_t* Y; const bf16_t* G;
    __device__ __forceinline__ void mid(Acc& acc, const Unit& u, int wr, int wc, int fr, int fq) const {
        const int row0 = u.pm * 256 + wr * 64 + fr, ct = u.pn * 256 + wc * 32 + 8 * fq;
        u32x4 g[2][4][2];
#pragma unroll
        for (int ai = 0; ai < 2; ++ai)
#pragma unroll
            for (int m = 0; m < 4; ++m)
#pragma unroll
                for (int bj = 0; bj < 2; ++bj) g[ai][m][bj] = *(const u32x4*)(G + (size_t)(row0 + ai * 128 + m * 16) * 4096 + ct + bj * 128);
        __builtin_amdgcn_sched_barrier(0);
#pragma unroll
        for (int ai = 0; ai < 2; ++ai)
#pragma unroll
            for (int m = 0; m < 4; ++m)
#pragma unroll
                for (int bj = 0; bj < 2; ++bj) { const u32x4 gg = g[ai][m][bj];
                    f32x4& v0 = acc[ai][bj][m][0]; f32x4& v1 = acc[ai][bj][m][1];
                    v0[0] *= bf_lo(gg.x); v0[1] *= bf_hi(gg.x); v0[2] *= bf_lo(gg.y); v0[3] *= bf_hi(gg.y); v1[0] *= bf_lo(gg.z); v1[1] *= bf_hi(gg.z); v1[2] *= bf_lo(gg.w); v1[3] *= bf_hi(gg.w); }
    }
    __device__ __forceinline__ void operator()(const Acc& acc, const Unit& u, int wr, int wc, int fr, int fq) const {
        const int row0 = u.pm * 256 + wr * 64 + fr, ct = u.pn * 256 + wc * 32 + 8 * fq;
        u32x4 g[2][4][2];
#pragma unroll
        for (int ai = 0; ai < 2; ++ai)
#pragma unroll
            for (int m = 0; m < 4; ++m)
#pragma unroll
                for (int bj = 0; bj < 2; ++bj) g[ai][m][bj] = *(const u32x4*)(G + (size_t)(row0 + ai * 128 + m * 16) * 4096 + 2048 + ct + bj * 128);
        __builtin_amdgcn_sched_barrier(0);
#pragma unroll
        for (int ai = 0; ai < 2; ++ai)
#pragma unroll
            for (int m = 0; m < 4; ++m) { const size_t row = (size_t)(row0 + ai * 128 + m * 16);
#pragma unroll
                for (int bj = 0; bj < 2; ++bj) { const u32x4 gg = g[ai][m][bj];
                    f32x4 v0 = acc[ai][bj][m][0], v1 = acc[ai][bj][m][1];
                    v0[0] *= bf_lo(gg.x); v0[1] *= bf_hi(gg.x); v0[2] *= bf_lo(gg.y); v0[3] *= bf_hi(gg.y); v1[0] *= bf_lo(gg.z); v1[1] *= bf_hi(gg.z); v1[2] *= bf_lo(gg.w); v1[3] *= bf_hi(gg.w);
                    u32x4 w; w.x = cvt_pk_bf16(v0[0], v0[1]); w.y = cvt_pk_bf16(v0[2], v0[3]); w.z = cvt_pk_bf16(v1[0], v1[1]); w.w = cvt_pk_bf16(v1[2], v1[3]);
                    *(u32x4*)(Y + row * 2048 + ct + bj * 128) = w; } }
    }
};
struct SchedY {
    pg8::TileOrder o; const char* A0; const char* A1; const char* B0; const char* B1;
    __device__ __forceinline__ bool next(int i, Unit& u) const { int pm, pn; if (!o.tile(i >> 1, pm, pn)) return false;
        u.pm = pm; u.pn = pn; u.aux = i & 1; u.a = ((i & 1) ? A1 : A0) + (size_t)pm * 256 * 1024 * 2; u.b = ((i & 1) ? B1 : B0) + (size_t)pn * 256 * 1024 * 2; return true; }
    __device__ __forceinline__ const int* rows(const Unit&) const { return nullptr; }
};

struct EpiRes {
    static constexpr bool PERM = false;
    float* HR; float sc;
    __device__ __forceinline__ void operator()(const Acc& acc, const Unit& u, int wr, int wc, int fr, int fq) const {
        const int row0 = u.pm * 256 + wr * 64 + fr, col0 = u.pn * 256 + wc * 32 + 4 * fq;
#pragma unroll
        for (int ai = 0; ai < 2; ++ai)
#pragma unroll
            for (int m = 0; m < 4; ++m) { float* rp = HR + (size_t)(row0 + ai * 128 + m * 16) * 2048 + col0;
#pragma unroll
                for (int bj = 0; bj < 2; ++bj)
#pragma unroll
                    for (int n = 0; n < 2; ++n) { f32x4* p = (f32x4*)(rp + bj * 128 + n * 16); *p = *p + acc[ai][bj][m][n] * sc; } }
    }
};
struct EpiDelta {
    static constexpr bool PERM = true;
    bf16_t* D; float sc;
    __device__ __forceinline__ void operator()(const Acc& acc, const Unit& u, int wr, int wc, int fr, int fq) const {
        const int row0 = u.pm * 256 + wr * 64 + fr, col0 = u.pn * 256 + wc * 32 + 8 * fq;
#pragma unroll
        for (int ai = 0; ai < 2; ++ai)
#pragma unroll
            for (int m = 0; m < 4; ++m) { bf16_t* rp = D + (size_t)(row0 + ai * 128 + m * 16) * 2048 + col0;
#pragma unroll
                for (int bj = 0; bj < 2; ++bj) { const f32x4 v0 = acc[ai][bj][m][0] * sc, v1 = acc[ai][bj][m][1] * sc;
                    u32x4 o; o.x = cvt_pk_bf16(v0[0], v0[1]); o.y = cvt_pk_bf16(v0[2], v0[3]); o.z = cvt_pk_bf16(v1[0], v1[1]); o.w = cvt_pk_bf16(v1[2], v1[3]);
                    NT_STORE16(rp + bj * 128, o); } }
    }
};
struct SchedPlain {
    pg8::TileOrder o; const char* A; const char* B; size_t astep, bstep;
    __device__ __forceinline__ bool next(int i, Unit& u) const { int pm, pn; if (!o.tile(i, pm, pn)) return false;
        u.pm = pm; u.pn = pn; u.aux = 0; u.a = A + (size_t)pm * astep; u.b = B + (size_t)pn * bstep; return true; }
    __device__ __forceinline__ const int* rows(const Unit&) const { return nullptr; }
};

struct EpiSwi {
    static constexpr bool PERM = true;
    bf16_t* HID;
    __device__ __forceinline__ void operator()(const Acc& acc, const Unit& u, int wr, int wc, int fr, int fq) const {
        const int row0 = u.pm * 256 + wr * 64 + fr, ct = u.pn * 128 + wc * 32 + 8 * fq;
#pragma unroll
        for (int ai = 0; ai < 2; ++ai)
#pragma unroll
            for (int m = 0; m < 4; ++m) { f32x4 h0, h1; const f32x4 g0 = acc[ai][0][m][0], g1 = acc[ai][0][m][1], u0 = acc[ai][1][m][0], u1 = acc[ai][1][m][1];
#pragma unroll
                for (int j = 0; j < 4; ++j) { h0[j] = g0[j] * fast_sigmoid(g0[j]) * u0[j]; h1[j] = g1[j] * fast_sigmoid(g1[j]) * u1[j]; }
                u32x4 w; w.x = cvt_pk_bf16(h0[0], h0[1]); w.y = cvt_pk_bf16(h0[2], h0[3]); w.z = cvt_pk_bf16(h1[0], h1[1]); w.w = cvt_pk_bf16(h1[2], h1[3]);
                *(u32x4*)(HID + (size_t)(row0 + ai * 128 + m * 16) * DFF + ct) = w; }
    }
};
struct EpiSwi8 {
    static constexpr bool PERM = true;
    unsigned char* HID8;
    __device__ __forceinline__ void operator()(const Acc& acc, const Unit& u, int wr, int wc, int fr, int fq) const {
        const int row0 = u.pm * 256 + wr * 64 + fr, ct = u.pn * 128 + wc * 32 + 8 * fq;
        constexpr float dq = 1.0f / (F8_SA * F8_SW), C = 1.0f / (dq * dq * F8_SH);
#pragma unroll
        for (int ai = 0; ai < 2; ++ai)
#pragma unroll
            for (int m = 0; m < 4; ++m) { float t[8], p[8];
#pragma unroll
                for (int j = 0; j < 8; ++j) t[j] = acc[ai][0][m][j >> 2][j & 3] * (-LOG2E * dq);
                __builtin_amdgcn_sched_barrier(0);
#pragma unroll
                for (int j = 0; j < 8; ++j) t[j] = __builtin_amdgcn_exp2f(t[j]);
#pragma unroll
                for (int j = 0; j < 8; ++j) p[j] = acc[ai][0][m][j >> 2][j & 3] * acc[ai][1][m][j >> 2][j & 3];
                __builtin_amdgcn_sched_barrier(0);
#pragma unroll
                for (int j = 0; j < 8; ++j) t[j] = __builtin_fmaf(t[j], C, C);
                __builtin_amdgcn_sched_barrier(0);
#pragma unroll
                for (int j = 0; j < 8; ++j) t[j] = __builtin_amdgcn_rcpf(t[j]);
                __builtin_amdgcn_sched_barrier(0);
#pragma unroll
                for (int j = 0; j < 8; ++j) p[j] *= t[j];
                u32x2 w; w.x = cvt4_fp8(p[0], p[1], p[2], p[3]); w.y = cvt4_fp8(p[4], p[5], p[6], p[7]);
                *(u32x2*)(HID8 + (size_t)(row0 + ai * 128 + m * 16) * DFF + ct) = w; }
    }
};
struct MoeMap { int pb[9]; };
__device__ __forceinline__ int moe_expert(const MoeMap& mm, int pm) { int e = 0;
#pragma unroll
    for (int j = 1; j < 8; ++j) e += (pm >= mm.pb[j]) ? 1 : 0;
    return e; }
struct SchedMoeUp {
    pg8::TileOrder o; const char* A; const char* B; MoeMap mm;
    __device__ __forceinline__ bool next(int i, Unit& u) const { int pm, pn; if (!o.tile(i, pm, pn)) return false;
        u.pm = pm; u.pn = pn; u.aux = 0; u.a = A + (size_t)pm * 256 * DM; u.b = B + (size_t)moe_expert(mm, pm) * ((size_t)NHID2 * DM) + (size_t)pn * 256 * DM; return true; }
    __device__ __forceinline__ const int* rows(const Unit&) const { return nullptr; }
};
struct SchedMoeDown {
    pg8::TileOrder o; const char* A; const char* B; MoeMap mm;
    __device__ __forceinline__ bool next(int i, Unit& u) const { int pm, pn; if (!o.tile(i, pm, pn)) return false;
        u.pm = pm; u.pn = pn; u.aux = 0; u.a = A + (size_t)pm * 256 * DFF; u.b = B + (size_t)moe_expert(mm, pm) * ((size_t)DM * DFF) + (size_t)pn * 256 * DFF; return true; }
    __device__ __forceinline__ const int* rows(const Unit&) const { return nullptr; }
};
struct EpiMoeDown {
    static constexpr bool PERM = true;
    bf16_t* O2A; bf16_t* O2B; const int* rowl; const float* roww; float sc;
    __device__ __forceinline__ void operator()(const Acc& acc, const Unit& u, int wr, int wc, int fr, int fq) const {
        const int row0 = u.pm * 256 + wr * 64 + fr, col0 = u.pn * 256 + wc * 32 + 8 * fq;
        int tvs[8]; float wvs[8];
#pragma unroll
        for (int i = 0; i < 8; ++i) { const int sr = row0 + (i >> 2) * 128 + (i & 3) * 16; tvs[i] = rowl[sr]; wvs[i] = roww[sr]; }
        __builtin_amdgcn_sched_barrier(0);
#pragma unroll
        for (int ai = 0; ai < 2; ++ai)
#pragma unroll
            for (int m = 0; m < 4; ++m) { const int tv = tvs[ai * 4 + m]; const int tok = tv & 0x3fffffff; const float w = wvs[ai * 4 + m] * sc;
                if (tv >= 0 && tok < T) { bf16_t* rp = ((tv >> 30) ? O2B : O2A) + (size_t)tok * 2048 + col0;
#pragma unroll
                    for (int bj = 0; bj < 2; ++bj) { const f32x4 v0 = acc[ai][bj][m][0] * w, v1 = acc[ai][bj][m][1] * w;
                        u32x4 o; o.x = cvt_pk_bf16(v0[0], v0[1]); o.y = cvt_pk_bf16(v0[2], v0[3]); o.z = cvt_pk_bf16(v1[0], v1[1]); o.w = cvt_pk_bf16(v1[2], v1[3]);
                        NT_STORE16(rp + bj * 128, o); } } }
    }
};

namespace att {
constexpr int SHM_V = 16384, SHM_K = 8192;
constexpr int OFF_V = 0, OFF_K = 32768, OFF_WS = 49152, OFF_ST = 51200, LDS_BYTES = OFF_ST + 65536;
constexpr int NT = 33;
constexpr float THR2 = 11.5f;
#define SBAR() __builtin_amdgcn_sched_barrier(0)
__device__ __forceinline__ int kswz(int row, int ch) { return row * 128 + ((ch ^ ((row >> 1) & 7)) << 4); }
__device__ __forceinline__ int crow(int r, int hi) { return (r & 3) + 8 * (r >> 2) + 4 * hi; }
__device__ __forceinline__ void partialSM(f32x16& p0, f32x16& p1, float& m_reg, float& alpha) {
    float pmax = p0[0];
#pragma unroll
    for (int r = 1; r < 16; ++r) pmax = fmaxf(pmax, p0[r]);
#pragma unroll
    for (int r = 0; r < 16; ++r) pmax = fmaxf(pmax, p1[r]);
    { auto rr = __builtin_amdgcn_permlane32_swap(__float_as_uint(pmax), __float_as_uint(pmax), false, false); pmax = fmaxf(__uint_as_float(rr[0]), __uint_as_float(rr[1])); }
    float mn;
    if (__builtin_expect(__all(pmax - m_reg <= THR2), 1)) { mn = m_reg; alpha = 1.f; }
    else { mn = fmaxf(m_reg, pmax); alpha = __builtin_amdgcn_exp2f(m_reg - mn); m_reg = mn; }
#pragma unroll
    for (int r = 0; r < 16; ++r) { p0[r] -= mn; p1[r] -= mn; }
#pragma unroll
    for (int r = 0; r < 16; ++r) p0[r] = __builtin_amdgcn_exp2f(p0[r]);
}
__device__ __forceinline__ void finishSM(f32x16& p0, f32x16& p1, float alpha, float& l_reg, bf16x8& pa0, bf16x8& pa1, bf16x8& pa2, bf16x8& pa3) {
#pragma unroll
    for (int r = 0; r < 16; ++r) p1[r] = __builtin_amdgcn_exp2f(p1[r]);
    float ps = 0;
#pragma unroll
    for (int r = 0; r < 16; ++r) ps += p0[r];
#pragma unroll
    for (int r = 0; r < 16; ++r) ps += p1[r];
    { auto rr = __builtin_amdgcn_permlane32_swap(__float_as_uint(ps), __float_as_uint(ps), false, false); ps = __uint_as_float(rr[0]) + __uint_as_float(rr[1]); }
    l_reg = l_reg * alpha + ps;
#define PK4(P, BASE, OUT) do { unsigned a0 = cvt_pk_bf16(P[BASE + 0], P[BASE + 1]), a1 = cvt_pk_bf16(P[BASE + 2], P[BASE + 3]);   \
    unsigned b0 = cvt_pk_bf16(P[BASE + 4], P[BASE + 5]), b1 = cvt_pk_bf16(P[BASE + 6], P[BASE + 7]);                              \
    auto r0 = __builtin_amdgcn_permlane32_swap(a0, b0, false, false); auto r1 = __builtin_amdgcn_permlane32_swap(a1, b1, false, false); \
    u32x4 w = {r0[0], r1[0], r0[1], r1[1]}; OUT = __builtin_bit_cast(bf16x8, w); } while (0)
    PK4(p0, 0, pa0); PK4(p0, 8, pa1); PK4(p1, 0, pa2); PK4(p1, 8, pa3);
#undef PK4
}
__device__ __forceinline__ void exp_first(f32x16& p0, f32x16& p1, float m_reg) {
#pragma unroll
    for (int r = 0; r < 16; ++r) { p0[r] -= m_reg; p1[r] -= m_reg; }
#pragma unroll
    for (int r = 0; r < 16; ++r) p0[r] = __builtin_amdgcn_exp2f(p0[r]);
}
__device__ __forceinline__ float exp_second_sum(f32x16& p0, f32x16& p1) {
#pragma unroll
    for (int r = 0; r < 16; ++r) p1[r] = __builtin_amdgcn_exp2f(p1[r]);
    float ps = 0;
#pragma unroll
    for (int r = 0; r < 16; ++r) ps += p0[r];
#pragma unroll
    for (int r = 0; r < 16; ++r) ps += p1[r];
    { auto rr = __builtin_amdgcn_permlane32_swap(__float_as_uint(ps), __float_as_uint(ps), false, false); ps = __uint_as_float(rr[0]) + __uint_as_float(rr[1]); }
    return ps;
}
__device__ __forceinline__ void pack_p(const f32x16& p0, const f32x16& p1, bf16x8& pa0, bf16x8& pa1, bf16x8& pa2, bf16x8& pa3) {
#define PK4(P, BASE, OUT) do { unsigned a0 = cvt_pk_bf16(P[BASE + 0], P[BASE + 1]), a1 = cvt_pk_bf16(P[BASE + 2], P[BASE + 3]);   \
    unsigned b0 = cvt_pk_bf16(P[BASE + 4], P[BASE + 5]), b1 = cvt_pk_bf16(P[BASE + 6], P[BASE + 7]);                              \
    auto r0 = __builtin_amdgcn_permlane32_swap(a0, b0, false, false); auto r1 = __builtin_amdgcn_permlane32_swap(a1, b1, false, false); \
    u32x4 w = {r0[0], r1[0], r0[1], r1[1]}; OUT = __builtin_bit_cast(bf16x8, w); } while (0)
    PK4(p0, 0, pa0); PK4(p0, 8, pa1); PK4(p1, 0, pa2); PK4(p1, 8, pa3);
#undef PK4
}
__device__ __forceinline__ void qkt(f32x16& p0, f32x16& p1, const LAS unsigned char* Ks, const bf16x8* qr, int r32, int hi) {
    p0 = f32x16{}; p1 = f32x16{};
#pragma unroll
    for (int d0 = 0; d0 < 4; ++d0) {
        const bf16x8 b0 = *(const LAS bf16x8*)(Ks + kswz(r32, d0 * 2 + hi));
        const bf16x8 b1 = *(const LAS bf16x8*)(Ks + kswz(32 + r32, d0 * 2 + hi));
        p0 = __builtin_amdgcn_mfma_f32_32x32x16_bf16(b0, qr[d0], p0, 0, 0, 0);
        p1 = __builtin_amdgcn_mfma_f32_32x32x16_bf16(b1, qr[d0], p1, 0, 0, 0); }
}
__device__ __forceinline__ int v_st(int k, int c) { const int kk = (k & ~0xC) | ((k & 4) << 1) | ((k & 8) >> 1); return ((kk >> 3) * 4 + (c >> 5)) * 512 + ((kk & 7) * 32 + (c & 31)) * 2; }
__device__ __forceinline__ int v_rd_base(int lane) { return ((lane & 3) << 3) | (((lane >> 2) & 3) << 6) | (((lane >> 4) & 1) << 5) | (((lane >> 5) & 1) << 8); }
constexpr int v_rd_off(int d0, int ks, int half) { return d0 * 512 + ks * 4096 + half * 2048; }
template <int OFF> __device__ __forceinline__ s16x4 tr_read(int vb) { s16x4 r; asm volatile("ds_read_b64_tr_b16 %0, %1 offset:%2" : "=&v"(r) : "v"(vb), "i"(OFF) : "memory"); return r; }
template <int D0> __device__ __forceinline__ void pv_one(f32x16& od, int vb, bf16x8 pa0, bf16x8 pa1, bf16x8 pa2, bf16x8 pa3) {
    const s16x4 l0 = tr_read<v_rd_off(D0, 0, 0)>(vb), h0 = tr_read<v_rd_off(D0, 0, 1)>(vb), l1 = tr_read<v_rd_off(D0, 1, 0)>(vb), h1 = tr_read<v_rd_off(D0, 1, 1)>(vb);
    const s16x4 l2 = tr_read<v_rd_off(D0, 2, 0)>(vb), h2 = tr_read<v_rd_off(D0, 2, 1)>(vb), l3 = tr_read<v_rd_off(D0, 3, 0)>(vb), h3 = tr_read<v_rd_off(D0, 3, 1)>(vb);
    asm volatile("s_waitcnt lgkmcnt(0)" ::: "memory"); SBAR();
#define PK(L, H) (bf16x8){L[0], L[1], L[2], L[3], H[0], H[1], H[2], H[3]}
    od = __builtin_amdgcn_mfma_f32_32x32x16_bf16(pa0, PK(l0, h0), od, 0, 0, 0);
    od = __builtin_amdgcn_mfma_f32_32x32x16_bf16(pa1, PK(l1, h1), od, 0, 0, 0);
    od = __builtin_amdgcn_mfma_f32_32x32x16_bf16(pa2, PK(l2, h2), od, 0, 0, 0);
    od = __builtin_amdgcn_mfma_f32_32x32x16_bf16(pa3, PK(l3, h3), od, 0, 0, 0);
#undef PK
}
__device__ __forceinline__ void pv_d0(f32x16* o, int vb, bf16x8 pa0, bf16x8 pa1, bf16x8 pa2, bf16x8 pa3) {
    pv_one<0>(o[0], vb, pa0, pa1, pa2, pa3); pv_one<1>(o[1], vb, pa0, pa1, pa2, pa3); pv_one<2>(o[2], vb, pa0, pa1, pa2, pa3); pv_one<3>(o[3], vb, pa0, pa1, pa2, pa3);
}

__device__ __forceinline__ void attn_pass_exact(const bf16_t* __restrict__ Qb, const bf16_t* __restrict__ Kb, const bf16_t* __restrict__ Vb, int b, int h, int mp, int qrow,
                                          f32x16 (&o)[4], float& l_out, LAS unsigned char* lds) {
    int tid_ = threadIdx.x; asm volatile("" : "+v"(tid_));
    const int tid = tid_, wid = tid >> 6, lane = tid & 63, r32 = lane & 31, hi = lane >> 5;
    LAS unsigned char* V_lds = lds + OFF_V; LAS unsigned char* K_lds = lds + OFF_K;
    LAS float* ws = (LAS float*)(lds + OFF_WS) + wid * 64; LAS float* al_l = ws + 32;
    float m_reg = -1e30f, l_reg = 0.f;
#pragma unroll
    for (int d = 0; d < 4; ++d) o[d] = f32x16{};
    bf16x8 qr[4];
    { const bf16_t* Qw = Qb + (size_t)qrow * 1024 + h * 128 + mp * 64 + hi * 8;
#pragma unroll
      for (int d0 = 0; d0 < 4; ++d0) qr[d0] = *(const bf16x8*)(Qw + d0 * 16); }
    const int sr = tid >> 4, sc = (tid & 15) * 8, vst0 = v_st(sr, sc), vst1 = v_st(32 + sr, sc);
    const int kk = tid >> 3, kch = tid & 7, kst = kswz(kk, kch);
    const int vb0 = (int)(uintptr_t)V_lds + v_rd_base(lane);
    const bf16_t* Kcol = Kb + h * 128 + mp * 64 + kch * 8; const bf16_t* Vcol = Vb + h * 128 + sc;
    const int mrow = TX + b * NMETA, xrow = b * SEQ - 64;
    struct { bf16x8 vs0, vs1, ks; } st_[2];
#define KROW(t, k) ((t) == 0 ? mrow + ((k) & 15) : xrow + (t) * 64 + (k))
#define SLOAD(i, t) do { st_[i].vs0 = *(const bf16x8*)(Vcol + (size_t)KROW(t, sr) * 1024); st_[i].vs1 = *(const bf16x8*)(Vcol + (size_t)KROW(t, 32 + sr) * 1024); \
        st_[i].ks = *(const bf16x8*)(Kcol + (size_t)KROW(t, kk) * 1024); } while (0)
#define SWRITE(bf, i) do { *(LAS bf16x8*)(V_lds + (bf) * SHM_V + vst0) = st_[i].vs0; *(LAS bf16x8*)(V_lds + (bf) * SHM_V + vst1) = st_[i].vs1; \
        *(LAS bf16x8*)(K_lds + (bf) * SHM_K + kst) = st_[i].ks; } while (0)
#define RESC(a) do { if (__any((a) < 1.f)) { if (hi == 0) al_l[r32] = (a); LDS_WAIT(); \
        _Pragma("unroll") for (int d = 0; d < 4; ++d) _Pragma("unroll") for (int r = 0; r < 16; ++r) o[d][r] *= al_l[crow(r, hi)]; } } while (0)
    f32x16 pA0, pA1, pB0, pB1; float alA, alB; bf16x8 pa0, pa1, pa2, pa3;
    constexpr int SE = 0, SO = 1;
    SLOAD(SE, 0); SWRITE(0, SE); __syncthreads();
    qkt(pA0, pA1, K_lds, qr, r32, hi);
#pragma unroll
    for (int r = 8; r < 16; ++r) pA0[r] = -INFINITY;
#pragma unroll
    for (int r = 0; r < 16; ++r) pA1[r] = -INFINITY;
    partialSM(pA0, pA1, m_reg, alA);
    SLOAD(SO, 1); SLOAD(SE, 2);
    SWRITE(1, SO); __syncthreads();
#define HALF_STEP(PN0, PN1, ALN, PP0, PP1, ALP, KBUF, VBUF, LD, LDSLOT, LDT, WR, WRBUF, WRSLOT) do { \
        SBAR(); qkt(PN0, PN1, K_lds + (KBUF) * SHM_K, qr, r32, hi); \
        finishSM(PP0, PP1, ALP, l_reg, pa0, pa1, pa2, pa3); SBAR(); \
        if (LD) { SLOAD(LDSLOT, LDT); } SBAR(); \
        pv_d0(o, vb0 + (VBUF) * SHM_V, pa0, pa1, pa2, pa3); partialSM(PN0, PN1, m_reg, ALN); \
        __syncthreads(); if (WR) { SWRITE(WRBUF, WRSLOT); } \
        RESC(ALN); __syncthreads(); } while (0)
    for (int j = 1; j + 3 < NT; j += 2) {
        HALF_STEP(pB0, pB1, alB, pA0, pA1, alA, 1, 0, true, SO, j + 2, true, 0, SE);
        HALF_STEP(pA0, pA1, alA, pB0, pB1, alB, 0, 1, true, SE, j + 3, true, 1, SO);
    }
    {
        HALF_STEP(pB0, pB1, alB, pA0, pA1, alA, 1, 0, false, SO, 0, true, 0, SE);
        HALF_STEP(pA0, pA1, alA, pB0, pB1, alB, 0, 1, false, SE, 0, false, 1, SO);
    }
    finishSM(pA0, pA1, alA, l_reg, pa0, pa1, pa2, pa3); SBAR();
    pv_d0(o, vb0, pa0, pa1, pa2, pa3);
    l_out = l_reg;
    __syncthreads();
#undef KROW
#undef SLOAD
#undef SWRITE
#undef RESC
#undef HALF_STEP
}

__device__ __forceinline__ bool attn_pass_fast(const bf16_t* __restrict__ Qb, const bf16_t* __restrict__ Kb, const bf16_t* __restrict__ Vb, int b, int h, int mp, int qrow,
                                          f32x16 (&o)[4], float& l_out, LAS unsigned char* lds) {
    int tid_ = threadIdx.x; asm volatile("" : "+v"(tid_));
    const int tid = tid_, wid = tid >> 6, lane = tid & 63, r32 = lane & 31, hi = lane >> 5;
    LAS unsigned char* V_lds = lds + OFF_V; LAS unsigned char* K_lds = lds + OFF_K;
    LAS float* ws = (LAS float*)(lds + OFF_WS) + wid * 64; LAS float* al_l = ws + 32;
    float m_reg = -1e30f, l_reg = 0.f;
#pragma unroll
    for (int d = 0; d < 4; ++d) o[d] = f32x16{};
    bf16x8 qr[4];
    { const bf16_t* Qw = Qb + (size_t)qrow * 1024 + h * 128 + mp * 64 + hi * 8;
#pragma unroll
      for (int d0 = 0; d0 < 4; ++d0) qr[d0] = *(const bf16x8*)(Qw + d0 * 16); }
    const int sr = tid >> 4, sc = (tid & 15) * 8, vst0 = v_st(sr, sc), vst1 = v_st(32 + sr, sc);
    const int kk = tid >> 3, kch = tid & 7, kst = kswz(kk, kch);
    const int vb0 = (int)(uintptr_t)V_lds + v_rd_base(lane);
    const bf16_t* Kcol = Kb + h * 128 + mp * 64 + kch * 8; const bf16_t* Vcol = Vb + h * 128 + sc;
    const int mrow = TX + b * NMETA, xrow = b * SEQ - 64;
    struct { bf16x8 vs0, vs1, ks; } st_[2];
#define KROW(t, k) ((t) == 0 ? mrow + ((k) & 15) : xrow + (t) * 64 + (k))
#define SLOAD(i, t) do { st_[i].vs0 = *(const bf16x8*)(Vcol + (size_t)KROW(t, sr) * 1024); st_[i].vs1 = *(const bf16x8*)(Vcol + (size_t)KROW(t, 32 + sr) * 1024); \
        st_[i].ks = *(const bf16x8*)(Kcol + (size_t)KROW(t, kk) * 1024); } while (0)
#define SWRITE(bf, i) do { *(LAS bf16x8*)(V_lds + (bf) * SHM_V + vst0) = st_[i].vs0; *(LAS bf16x8*)(V_lds + (bf) * SHM_V + vst1) = st_[i].vs1; \
        *(LAS bf16x8*)(K_lds + (bf) * SHM_K + kst) = st_[i].ks; } while (0)
#define RESC(a) do { if (__any((a) < 1.f)) { if (hi == 0) al_l[r32] = (a); LDS_WAIT(); \
        _Pragma("unroll") for (int d = 0; d < 4; ++d) _Pragma("unroll") for (int r = 0; r < 16; ++r) o[d][r] *= al_l[crow(r, hi)]; } } while (0)
    f32x16 pA0, pA1, pB0, pB1; float alA; bf16x8 pa0, pa1, pa2, pa3;
    constexpr int SE = 0, SO = 1;
    SLOAD(SE, 0); SLOAD(SO, 1); SWRITE(0, SE); SLOAD(SE, 2); __syncthreads();
    qkt(pA0, pA1, K_lds, qr, r32, hi);
#pragma unroll
    for (int r = 8; r < 16; ++r) pA0[r] = -INFINITY;
#pragma unroll
    for (int r = 0; r < 16; ++r) pA1[r] = -INFINITY;
    partialSM(pA0, pA1, m_reg, alA);
    SWRITE(1, SO); __syncthreads();
#define HALF_STEP(PN0, PN1, PP0, PP1, KBUF, VBUF, LD, LDSLOT, LDT, WR, WRBUF, WRSLOT, TILE0) do { \
        SBAR(); qkt(PN0, PN1, K_lds + (KBUF) * SHM_K, qr, r32, hi); \
        float ps_ = exp_second_sum(PP0, PP1); \
        l_reg += ps_; pack_p(PP0, PP1, pa0, pa1, pa2, pa3); SBAR(); \
        if (LD) { SLOAD(LDSLOT, LDT); } SBAR(); \
        pv_d0(o, vb0 + (VBUF) * SHM_V, pa0, pa1, pa2, pa3); exp_first(PN0, PN1, m_reg); \
        __syncthreads(); if (WR) { SWRITE(WRBUF, WRSLOT); } \
        __syncthreads(); } while (0)
    for (int j = 1; j + 3 < NT; j += 2) {
        HALF_STEP(pB0, pB1, pA0, pA1, 1, 0, true, SO, j + 2, true, 0, SE, false);
        HALF_STEP(pA0, pA1, pB0, pB1, 0, 1, true, SE, j + 3, true, 1, SO, false);
    }
    {
        HALF_STEP(pB0, pB1, pA0, pA1, 1, 0, false, SO, 0, true, 0, SE, false);
        HALF_STEP(pA0, pA1, pB0, pB1, 0, 1, false, SE, 0, false, 1, SO, false);
    }
    { float ps_ = exp_second_sum(pA0, pA1);
      l_reg += ps_; pack_p(pA0, pA1, pa0, pa1, pa2, pa3); SBAR(); }
    pv_d0(o, vb0, pa0, pa1, pa2, pa3);
    l_out = l_reg;
    if (lane == 0) al_l[0] = __any(!(l_reg <= 1.1529215e18f)) ? 1.0f : 0.0f;
    LDS_WAIT();
    __syncthreads();
    float bad_ = 0.f;
#pragma unroll
    for (int w = 0; w < 8; ++w) bad_ += ((const LAS float*)(lds + OFF_WS))[w * 64 + 32];
    const bool redo = bad_ != 0.f;
#undef KROW
#undef SLOAD
#undef SWRITE
#undef RESC
#undef HALF_STEP
    return redo;
}

struct AttnArgs { const bf16_t* Q; const bf16_t* K; const bf16_t* V; bf16_t* A; const float* subln; float lam, oml; };

__device__ __forceinline__ void attn_unit(const AttnArgs& P, int b, int h, int qb  , LAS unsigned char* lds) {
    int tid_ = threadIdx.x; asm volatile("" : "+v"(tid_));
    const int tid = tid_, wid = tid >> 6, lane = tid & 63, r32 = lane & 31, hi = lane >> 5;
    const bool meta = qb == 8;
    const int qrow = meta ? TX + b * NMETA + (r32 & 15) : b * SEQ + qb * 256 + wid * 32 + r32;
    LAS float* ws = (LAS float*)(lds + OFF_WS) + wid * 64;
    unsigned stb = (unsigned)(uintptr_t)(lds + OFF_ST) + (unsigned)tid * 4u; asm volatile("" : "+v"(stb));
    f32x16 o[4]; float l_reg;
    if (attn_pass_fast(P.Q, P.K, P.V, b, h, 0, qrow, o, l_reg, lds)) attn_pass_exact(P.Q, P.K, P.V, b, h, 0, qrow, o, l_reg, lds);
    if (hi == 0) ws[r32] = l_reg; LDS_WAIT();
    {
#pragma unroll
        for (int r = 0; r < 16; ++r) { const float rl = __builtin_amdgcn_rcpf(ws[crow(r, hi)]);
            *(LAS unsigned*)(stb + (r * 2 + 0) * 2048) = cvt_pk_bf16(o[0][r] * rl, o[1][r] * rl); *(LAS unsigned*)(stb + (r * 2 + 1) * 2048) = cvt_pk_bf16(o[2][r] * rl, o[3][r] * rl); }
    }
    LDS_WAIT();
    if (attn_pass_fast(P.Q, P.K, P.V, b, h, 1, qrow, o, l_reg, lds)) attn_pass_exact(P.Q, P.K, P.V, b, h, 1, qrow, o, l_reg, lds);
    if (hi == 0) ws[r32] = l_reg; LDS_WAIT();
    float ss[16];
#pragma unroll
    for (int r = 0; r < 16; ++r) { const float rl = __builtin_amdgcn_rcpf(ws[crow(r, hi)]) * P.lam;
        const unsigned s0 = *(LAS unsigned*)(stb + (r * 2 + 0) * 2048), s1 = *(LAS unsigned*)(stb + (r * 2 + 1) * 2048);
        o[0][r] = bf_lo(s0) - o[0][r] * rl; o[1][r] = bf_hi(s0) - o[1][r] * rl; o[2][r] = bf_lo(s1) - o[2][r] * rl; o[3][r] = bf_hi(s1) - o[3][r] * rl;
        ss[r] = (o[0][r] * o[0][r] + o[1][r] * o[1][r]) + (o[2][r] * o[2][r] + o[3][r] * o[3][r]); }
#pragma unroll
    for (int r = 0; r < 16; ++r) {
#pragma unroll
        for (int s = 1; s < 32; s <<= 1) ss[r] += shfl_xor_l(ss[r], s, lane);
        ss[r] = __builtin_amdgcn_rsqf(ss[r] * (1.0f / 128.0f) + EPS) * P.oml; }
    float gsub[4];
#pragma unroll
    for (int d = 0; d < 4; ++d) gsub[d] = P.subln[d * 32 + r32];
    const bool wst = !meta || wid == 0;
#pragma unroll
    for (int r = 0; r < 16; ++r) { const int rr = crow(r, hi);
        if (wst && (!meta || rr < 16)) { const int orow = meta ? TX + b * NMETA + rr : b * SEQ + qb * 256 + wid * 32 + rr;
            bf16_t* op = P.A + (size_t)orow * 1024 + h * 128 + r32;
#pragma unroll
            for (int d = 0; d < 4; ++d) op[d * 32] = (bf16_t)(cvt_pk_bf16(o[d][r] * ss[r] * gsub[d], 0.f) & 0xffffu); } }
    LDS_WAIT(); __syncthreads();
}
#undef SBAR
}

#define XB_TMO      128
#define XB_XCNT(j)  (256  + 64 * (j))
#define XB_XSUB(j)  (1280 + 64 * (j))
#define XB_XGEN(j)  (2304 + 64 * (j))
#define XB_TOP      3328
#define XB_TOPGEN   3392
#define XCD_BAR_WORDS 3456
#define XB_SPIN_CAP (1u << 22)
__device__ __forceinline__ unsigned xb_ld(unsigned* p)              { return __hip_atomic_load(p, __ATOMIC_RELAXED, __HIP_MEMORY_SCOPE_AGENT); }
__device__ __forceinline__ unsigned xb_add(unsigned* p, unsigned v) { return __hip_atomic_fetch_add(p, v, __ATOMIC_RELAXED, __HIP_MEMORY_SCOPE_AGENT); }
__device__ __forceinline__ unsigned xb_xcc_id() { return (unsigned)__builtin_amdgcn_s_getreg((3 << 11) | 20) & 0xFu; }
#define XB_SPIN(cond, bar) do { unsigned _sp = 0; while (cond) { __builtin_amdgcn_s_sleep(1); \
    if ((++_sp & 255u) == 0u) { if (xb_ld(&(bar)[XB_TMO])) break; if (_sp > XB_SPIN_CAP) { atomicAdd(&(bar)[XB_TMO], 1u); break; } } } } while (0)
struct XcdBarrier { unsigned* bar; unsigned x; volatile LAS unsigned* st; };
__device__ __forceinline__ XcdBarrier xcd_barrier_post(unsigned* bar, volatile LAS unsigned* st) {
    XcdBarrier b; b.bar = bar; b.x = xb_xcc_id(); b.st = st;
    if (threadIdx.x == 0) (void)xb_add(&bar[XB_XCNT(b.x)], 1u);
    return b;
}
__device__ __forceinline__ void xcd_barrier_complete(unsigned* bar, unsigned x, unsigned& nloc, unsigned& nx) {
    const unsigned G = gridDim.x * gridDim.y * gridDim.z;
    unsigned sum, cnt, mine, sp = 0u;
    for (;;) {
        sum = 0u; cnt = 0u; mine = 0u;
#pragma unroll
        for (unsigned j = 0; j < 16; ++j) { const unsigned c = xb_ld(&bar[XB_XCNT(j)]); sum += c; cnt += (c > 0u) ? 1u : 0u; mine = (j == x) ? c : mine; }
        if (sum == G) break;
        __builtin_amdgcn_s_sleep(1);
        if ((++sp & 255u) == 0u) { if (xb_ld(&bar[XB_TMO])) break; if (sp > XB_SPIN_CAP) { atomicAdd(&bar[XB_TMO], 1u); break; } }
    }
    nloc = mine > 0u ? mine : 1u; nx = cnt > 0u ? cnt : 1u;
}
__device__ __forceinline__ void xcd_barrier(const XcdBarrier& b) {
    asm volatile("s_waitcnt vmcnt(0)" ::: "memory");
    __syncthreads();
    if (threadIdx.x == 0) {
        unsigned* bar = b.bar;
        __builtin_amdgcn_s_waitcnt(0);
        unsigned nloc = b.st[0], nx = b.st[1];
        if (nloc == 0u) { xcd_barrier_complete(bar, b.x, nloc, nx); b.st[0] = nloc; b.st[1] = nx; }
        const unsigned old = xb_add(&bar[XB_XSUB(b.x)], 1u);
        const unsigned gen = old / nloc;
        if (old + 1u == (gen + 1u) * nloc) {
            __builtin_amdgcn_fence(__ATOMIC_RELEASE, "agent");
            asm volatile("s_waitcnt vmcnt(0)" ::: "memory");
            const unsigned og = xb_add(&bar[XB_TOP], 1u);
            const unsigned tg = og / nx;
            if (og + 1u == (tg + 1u) * nx) xb_add(&bar[XB_TOPGEN], 1u);
            else XB_SPIN(xb_ld(&bar[XB_TOPGEN]) == tg, bar);
            __builtin_amdgcn_fence(__ATOMIC_ACQUIRE, "agent");
            xb_add(&bar[XB_XGEN(b.x)], 1u);
            asm volatile("s_waitcnt vmcnt(0)" ::: "memory");
        } else {
            XB_SPIN(xb_ld(&bar[XB_XGEN(b.x)]) == gen, bar);
            __builtin_amdgcn_fence(__ATOMIC_ACQUIRE, "agent");
            asm volatile("s_waitcnt vmcnt(0)" ::: "memory");
        }
    }
    __syncthreads();
}

constexpr int RING_BYTES = 131072, LDSCTL_OFF = RING_BYTES, LDS_BYTES = 147456;
static_assert(att::LDS_BYTES <= RING_BYTES, "attention scratch inside the ring region");
constexpr int NPHASE = 18;

struct Args { const float* in[24]; float* out; unsigned char* ws; int ph_lo, ph_hi; };

template <int MODE> __device__ __forceinline__ int rowmap(int n) {
    if (MODE == 1) return (n >> 7) * 256 + (n & 127);
    if (MODE == 2) return (n >> 7) * 256 + 128 + (n & 127);
    if (MODE == 3) { if (n < 2048) { const int tile = n >> 8, hh = (n >> 6) & 3, bj = (n >> 5) & 1, i = n & 31; return tile * 256 + bj * 128 + hh * 32 + i; }
                     if (n >= 4096) { const int pool = n >= 6144 ? 1 : 0, c = n - 4096 - pool * 2048; return 4096 + (c >> 7) * 256 + pool * 128 + (c & 127); }
                     return n; }
    return n;
}
template <int MODE> __device__ __forceinline__ void transpose_item(const float* __restrict__ W, int K, int N, bf16_t* __restrict__ WT, LAS float* scr, int item, int lane, unsigned char* __restrict__ W8 = nullptr) {
    const int nblk = N / 32, kb = item / nblk, nb = item % nblk, k0 = 64 * kb, n0 = 32 * nb;
#pragma unroll 8
    for (int i = 0; i < 32; ++i) { const int kk = 2 * i + (lane >> 5); scr[kk * 33 + (lane & 31)] = W[(size_t)(k0 + kk) * N + n0 + (lane & 31)]; }
    LDS_WAIT(); asm volatile("" ::: "memory");
    const int c = lane & 7;
#pragma unroll
    for (int j = 0; j < 4; ++j) { const int n = (lane >> 3) + 8 * j; const LAS float* s = scr + (8 * c) * 33 + n;
        u32x4 o; o.x = cvt_pk_bf16(s[0 * 33], s[1 * 33]); o.y = cvt_pk_bf16(s[2 * 33], s[3 * 33]); o.z = cvt_pk_bf16(s[4 * 33], s[5 * 33]); o.w = cvt_pk_bf16(s[6 * 33], s[7 * 33]);
        *(u32x4*)(WT + (size_t)rowmap<MODE>(n0 + n) * K + k0 + 8 * c) = o;
        if (MODE == 3 && n0 >= 4096) {
            u32x2 o8; o8.x = cvt4_fp8(s[0 * 33] * F8_SW, s[1 * 33] * F8_SW, s[2 * 33] * F8_SW, s[3 * 33] * F8_SW); o8.y = cvt4_fp8(s[4 * 33] * F8_SW, s[5 * 33] * F8_SW, s[6 * 33] * F8_SW, s[7 * 33] * F8_SW);
            *(u32x2*)(W8 + (size_t)(rowmap<MODE>(n0 + n) - 4096) * K + k0 + 8 * c) = o8; } }
    LDS_WAIT(); asm volatile("" ::: "memory");
}

template <int MODE> __device__ __forceinline__ void transpose_item_f8(const float* __restrict__ W, int K, int N, unsigned char* __restrict__ WT, LAS float* scr, int item, int lane, float scale) {
    const int nblk = N / 32, kb = item / nblk, nb = item % nblk, k0 = 64 * kb, n0 = 32 * nb;
#pragma unroll 8
    for (int i = 0; i < 32; ++i) { const int kk = 2 * i + (lane >> 5); scr[kk * 33 + (lane & 31)] = W[(size_t)(k0 + kk) * N + n0 + (lane & 31)] * scale; }
    LDS_WAIT(); asm volatile("" ::: "memory");
    const int c = lane & 7;
#pragma unroll
    for (int j = 0; j < 4; ++j) { const int n = (lane >> 3) + 8 * j; const LAS float* s = scr + (8 * c) * 33 + n;
        u32x2 o; o.x = cvt4_fp8(s[0 * 33], s[1 * 33], s[2 * 33], s[3 * 33]); o.y = cvt4_fp8(s[4 * 33], s[5 * 33], s[6 * 33], s[7 * 33]);
        *(u32x2*)(WT + (size_t)rowmap<MODE>(n0 + n) * K + k0 + 8 * c) = o; }
    LDS_WAIT(); asm volatile("" ::: "memory");
}

__device__ __forceinline__ float half_sum(float v, int lane) {
#pragma unroll
    for (int o = 1; o < 32; o <<= 1) v += shfl_xor_l(v, o, lane);
    return v;
}
template <bool HAS0, bool HAS1, bool SRC16 = false, bool OUT16 = false, bool PRELOADED = false>
__device__ __forceinline__ void norm_row2(const void* src, void* hres_out, const float* __restrict__ gain, bf16_t* hout, int lane, bool valid, f32x4 (&v)[16], float& rstd,
                                          const bf16_t* add0 = nullptr, const bf16_t* add1 = nullptr) {
    const int l32 = lane & 31; const f32x4* xr = (const f32x4*)src + l32; float s = 0.f; u32x2 a_[16], b_[16], s_[16];
#pragma unroll
    for (int j = 0; j < 16; ++j) { if (SRC16) s_[j] = ((const u32x2*)src)[l32 + 32 * j]; else if (!PRELOADED) v[j] = xr[32 * j]; if (HAS0) a_[j] = ((const u32x2*)add0)[l32 + 32 * j]; if (HAS1) b_[j] = ((const u32x2*)add1)[l32 + 32 * j]; }
#pragma unroll
    for (int j = 0; j < 16; ++j) {
        if (SRC16) { const u32x2 q = s_[j]; v[j].x = bf_lo(q.x); v[j].y = bf_hi(q.x); v[j].z = bf_lo(q.y); v[j].w = bf_hi(q.y); }
        if (HAS0) { const u32x2 a = a_[j]; v[j].x += bf_lo(a.x); v[j].y += bf_hi(a.x); v[j].z += bf_lo(a.y); v[j].w += bf_hi(a.y); }
        if (HAS1) { const u32x2 b = b_[j]; v[j].x += bf_lo(b.x); v[j].y += bf_hi(b.x); v[j].z += bf_lo(b.y); v[j].w += bf_hi(b.y); }
        s += (v[j].x * v[j].x + v[j].y * v[j].y) + (v[j].z * v[j].z + v[j].w * v[j].w); }
    if (hres_out && valid) {
        if (OUT16) { u32x2* hr = (u32x2*)hres_out + l32;
#pragma unroll
            for (int j = 0; j < 16; ++j) { u32x2 w; w.x = cvt_pk_bf16(v[j].x, v[j].y); w.y = cvt_pk_bf16(v[j].z, v[j].w); hr[32 * j] = w; } }
        else { f32x4* hr = (f32x4*)hres_out + l32;
#pragma unroll
            for (int j = 0; j < 16; ++j) hr[32 * j] = v[j]; } }
    rstd = __builtin_amdgcn_rsqf(half_sum(s, lane) * (1.0f / DM) + EPS);
    const f32x4* gr = (const f32x4*)gain + l32;
#pragma unroll
    for (int j = 0; j < 16; ++j) { const f32x4 g = gr[32 * j]; v[j] = v[j] * rstd * g; }
    if (hout && valid) { u32x2* o8 = (u32x2*)hout + l32;
#pragma unroll
        for (int j = 0; j < 16; ++j) { u32x2 w; w.x = cvt_pk_bf16(v[j].x, v[j].y); w.y = cvt_pk_bf16(v[j].z, v[j].w); o8[32 * j] = w; } }
}

__global__ void __launch_bounds__(NWAVES * 64, 2) fwd_kernel(Args args) {
    extern __shared__ __attribute__((aligned(16))) unsigned char lds_raw[];
    LAS unsigned char* lds = (LAS unsigned char*)lds_raw;
    const int tid = threadIdx.x, lane = tid & 63, wave = __builtin_amdgcn_readfirstlane(tid >> 6);
    const int G = gridDim.x; const int bx = blockIdx.x; const int vcu = (G % 8 == 0) ? (bx % 8) * (G / 8) + bx / 8 : bx;
    unsigned* ctl = (unsigned*)(GAS unsigned*)(args.ws + WS_CTL);
    volatile LAS unsigned* MISC = (volatile LAS unsigned*)(lds + LDSCTL_OFF);
    for (int u = tid; u < (LDS_BYTES - LDSCTL_OFF) / 4; u += NWAVES * 64) ((LAS unsigned*)(lds + LDSCTL_OFF))[u] = 0u;
    __syncthreads();
    const int lo = args.ph_lo, hi = args.ph_hi; (void)lo;
    XcdBarrier bar; bar.bar = ctl + CW_BAR; bar.x = 0; bar.st = nullptr;
    if (hi - lo > 1) bar = xcd_barrier_post(ctl + CW_BAR, MISC + 8);
#if MK_ONE_LAUNCH && MK_PROBE_BUF == 0 && MK_LAST_PHASE == 17
#define IN(k) ((k) < NPHASE)
#define SEAM(k) do { if ((k) + 1 < NPHASE) xcd_barrier(bar); } while (0)
#else
#ifdef ONLY_MASK
#define IN(k) (((ONLY_MASK >> (k)) & 1) != 0 && lo <= (k) && (k) < hi)
#else
#define IN(k) (lo <= (k) && (k) < hi)
#endif
#define SEAM(k) do { if ((k) + 1 < hi) xcd_barrier(bar); } while (0)
#endif
#define PHASE_LOCALS int tidp = threadIdx.x; asm volatile("" : "+v"(tidp)); const int lanep = tidp & 63; GAS unsigned char* wsg_ = (GAS unsigned char*)args.ws; asm volatile("" : "+s"(wsg_)); unsigned char* wsp = (unsigned char*)wsg_; int Gp = gridDim.x; asm volatile("" : "+s"(Gp)); const int NGW = Gp * NWAVES, NGT = Gp * NWAVES * 64; (void)NGT; (void)NGW
    const int gw = vcu * NWAVES + wave;

    const float* x = (const float*)(const GAS float*)args.in[0]; const float* meta_tok = (const float*)(const GAS float*)args.in[1]; const float* norm_mix = (const float*)(const GAS float*)args.in[2]; const float* w_in = (const float*)(const GAS float*)args.in[3]; const float* b_gate = (const float*)(const GAS float*)args.in[4];
    const float* lam_q1 = (const float*)(const GAS float*)args.in[5]; const float* lam_k1 = (const float*)(const GAS float*)args.in[6]; const float* lam_q2 = (const float*)(const GAS float*)args.in[7]; const float* lam_k2 = (const float*)(const GAS float*)args.in[8]; const float* subln = (const float*)(const GAS float*)args.in[9];
    const float* pool_w = (const float*)(const GAS float*)args.in[10]; const float* pool_scale = (const float*)(const GAS float*)args.in[11]; const float* w_ba = (const float*)(const GAS float*)args.in[12]; const float* w_bp = (const float*)(const GAS float*)args.in[13]; const float* w_out = (const float*)(const GAS float*)args.in[14];
    const float* norm_ffn = (const float*)(const GAS float*)args.in[15]; const float* d_wg = (const float*)(const GAS float*)args.in[16]; const float* d_wu = (const float*)(const GAS float*)args.in[17]; const float* d_wd = (const float*)(const GAS float*)args.in[18]; const float* router = (const float*)(const GAS float*)args.in[19];
    const float* m_wg = (const float*)(const GAS float*)args.in[20]; const float* m_wu = (const float*)(const GAS float*)args.in[21]; const float* m_wd = (const float*)(const GAS float*)args.in[22]; const float* norm_final = (const float*)(const GAS float*)args.in[23];
#define ROPE ((float*)(wsp + WS_ROPE))
#define TOKE ((int*)(wsp + WS_TOKE))
#define TOKS ((int*)(wsp + WS_TOKS))
#define TOKW ((float*)(wsp + WS_TOKW))
#define ROWL ((int*)(wsp + WS_ROWL))
#define ROWW ((float*)(wsp + WS_ROWW))
#define WIN ((bf16_t*)(wsp + WS_WIN))
#define WBA ((bf16_t*)(wsp + WS_WBA))
#define WC ((bf16_t*)(wsp + WS_WC))
#define WOUT ((bf16_t*)(wsp + WS_WOUT))
#define DWGU ((bf16_t*)(wsp + WS_DWGU))
#define DWD ((bf16_t*)(wsp + WS_DWD))
#define MWGU ((bf16_t*)(wsp + WS_MWGU))
#define MWD ((bf16_t*)(wsp + WS_MWD))
#define HRES ((float*)(wsp + WS_HRES))
#define HRES16 ((bf16_t*)(wsp + WS_HRES))
#define WBPT ((bf16_t*)(wsp + WS_HRES + 130 * MiB))
#define PB ((bf16_t*)(wsp + WS_HRES + 138 * MiB))
#define H ((bf16_t*)(wsp + WS_H))
#define MB ((bf16_t*)(wsp + WS_H))
#define QB ((bf16_t*)(wsp + WS_Q))
#define KB ((bf16_t*)(wsp + WS_K))
#define VB ((bf16_t*)(wsp + WS_V))
#define UB ((bf16_t*)(wsp + WS_U))
#define GB ((bf16_t*)(wsp + WS_G))
#define YB ((bf16_t*)(wsp + WS_Y))
#define HID ((bf16_t*)(wsp + WS_HID))
#define CNT ((unsigned*)(wsp + WS_CTL) + CW_CNT)
#define H8P ((unsigned char*)(GAS unsigned char*)args.out)
#define WIN8G ((unsigned char*)(GAS unsigned char*)args.out + (size_t)T * DM)

    if (IN(0)) { PHASE_LOCALS;
#pragma unroll 1
      for (int rep0 = 0; rep0 < MK_REP_P0; ++rep0) {
        LAS float* scr = (LAS float*)(lds + wave * 16384);
        constexpr int I_FF = (DM / 64) * (DFF / 32);
        constexpr int I_MOE = NE * 3 * I_FF, I_DENSE = 3 * I_FF;
        constexpr int I_WIN = (DM / 64) * (INC / 32), I_WBA = (AW / 64) * (DM / 32), I_WOUT = (DM / 64) * (DM / 32), I_LAYER = I_WIN + I_WBA + I_WOUT;
        constexpr int NITEMS = I_MOE + I_DENSE + 2 * I_LAYER;
        for (int it = gw; it < NITEMS; it += NGW) {
            int r = it;
            if (r < I_MOE) { const int e = r / (3 * I_FF), q = r % (3 * I_FF), which = q / I_FF, item = q % I_FF;
                if (which == 0) transpose_item_f8<1>(m_wg + (size_t)e * DM * DFF, DM, DFF, (unsigned char*)MWGU + (size_t)e * NHID2 * DM, scr, item, lanep, F8_SW);
                else if (which == 1) transpose_item_f8<2>(m_wu + (size_t)e * DM * DFF, DM, DFF, (unsigned char*)MWGU + (size_t)e * NHID2 * DM, scr, item, lanep, F8_SW);
                else transpose_item_f8<0>(m_wd + (size_t)e * DFF * DM, DFF, DM, (unsigned char*)MWD + (size_t)e * DM * DFF, scr, item, lanep, F8_SW);
                continue; }
            r -= I_MOE;
            if (r < I_DENSE) { const int which = r / I_FF, item = r % I_FF;
                if (MK_F8_DENSE) {
                if (which == 0) transpose_item_f8<1>(d_wg, DM, DFF, (unsigned char*)DWGU, scr, item, lanep, F8_SW);
                else if (which == 1) transpose_item_f8<2>(d_wu, DM, DFF, (unsigned char*)DWGU, scr, item, lanep, F8_SW);
                else transpose_item_f8<0>(d_wd, DFF, DM, (unsigned char*)DWD, scr, item, lanep, F8_SW);
                } else {
                if (which == 0) transpose_item<1>(d_wg, DM, DFF, DWGU, scr, item, lanep);
                else if (which == 1) transpose_item<2>(d_wu, DM, DFF, DWGU, scr, item, lanep);
                else transpose_item<0>(d_wd, DFF, DM, DWD, scr, item, lanep); }
                continue; }
            r -= I_DENSE;
            const int l = r / I_LAYER; r = r % I_LAYER;
            if (r < I_WIN) { transpose_item<3>(w_in + (size_t)l * DM * INC, DM, INC, WIN + (size_t)l * INC * DM, scr, r, lanep, WIN8G + (size_t)l * 4096 * DM); continue; }
            r -= I_WIN;
            if (r < I_WBA) { transpose_item<0>(w_ba + (size_t)l * AW * DM, AW, DM, WBA + (size_t)l * DM * AW, scr, r, lanep); continue; }
            r -= I_WBA;
            transpose_item<0>(w_out + (size_t)l * DM * DM, DM, DM, WOUT + (size_t)l * DM * DM, scr, r, lanep);
        }
        for (int it = gw; it < 2 * 1024; it += NGW) { const int l = it >> 10;
            transpose_item<0>(w_bp + (size_t)l * 1024 * DM, 1024, DM, WBPT + (size_t)l * DM * 1024, scr, it & 1023, lanep); }
        for (int idx = (vcu * NWAVES * 64) + tidp; idx < 2 * 4 * 256 * 32; idx += NGT) { const int e8 = (idx & 31) * 8, lgc = idx >> 5, lg = lgc >> 8;
            const f32x4 p0 = *(const f32x4*)(pool_w + (size_t)lgc * 256 + e8), p1 = *(const f32x4*)(pool_w + (size_t)lgc * 256 + e8 + 4);
            const f32x4 s0 = *(const f32x4*)(pool_scale + lg * 256 + e8), s1 = *(const f32x4*)(pool_scale + lg * 256 + e8 + 4);
            u32x4 o; o.x = cvt_pk_bf16(p0.x * s0.x, p0.y * s0.y); o.y = cvt_pk_bf16(p0.z * s0.z, p0.w * s0.w); o.z = cvt_pk_bf16(p1.x * s1.x, p1.y * s1.y); o.w = cvt_pk_bf16(p1.z * s1.z, p1.w * s1.w);
            *(u32x4*)(PB + (size_t)lgc * 256 + e8) = o; }
        for (int idx = (vcu * NWAVES * 64) + tidp; idx < LTOK * 32; idx += NGT) { const int pos = idx >> 5, i = idx & 31;
            const float inv = __builtin_amdgcn_exp2f((float)(-i) * 0.41524101186092029f); const float ang = (float)pos * inv;
            double rev = (double)ang * 0.15915494309189535; rev -= floor(rev);
            ROPE[pos * 64 + i] = __builtin_amdgcn_cosf((float)rev); ROPE[pos * 64 + 32 + i] = __builtin_amdgcn_sinf((float)rev); }
#define EMB_ROW(r) ((r) < TX ? x + (size_t)(r) * DM : meta_tok + (size_t)(((r) - TX) & (NMETA - 1)) * DM)
        for (int r0 = gw; r0 < T; r0 += 2 * NGW) { const int rr = r0 + (lanep >> 5) * NGW; const bool valid = rr < T; const int r = valid ? rr : r0;
            f32x4 v[16]; float rstd; norm_row2<false, false>(EMB_ROW(r), nullptr, norm_mix, H + (size_t)r * DM, lanep, valid, v, rstd);
            if (valid && r < TX) { unsigned* o4 = (unsigned*)(H8P + (size_t)r * DM) + (lanep & 31);
#pragma unroll
                for (int j = 0; j < 16; ++j) o4[32 * j] = cvt4_fp8(v[j].x * F8_SA, v[j].y * F8_SA, v[j].z * F8_SA, v[j].w * F8_SA); } }
        SEAM(0);
      }
    }

#pragma unroll 1
    for (int layer = 0; layer < 2; ++layer) {
        const int pb = 1 + 8 * layer;
        if (IN(pb + 0)) { PHASE_LOCALS;
            { SchedInA S; S.o.init(NPAN - 1, 16, Gp, bx); S.A = (const char*)H; S.B = (const char*)(WIN + (size_t)layer * INC * DM);
              EpiIn E{QB, KB, VB, UB, GB, b_gate + layer * 4096, ROPE};
              pg8::gemm_phase<EpiIn, SchedInA, false>(lds, DM / 64, DM * 2, DM * 2, S, E); }
            { SchedIn8 S; S.o.init(NPAN - 1, 16, Gp, bx); S.A = (const char*)H8P; S.B = (const char*)(WIN8G + (size_t)layer * 4096 * DM);
              EpiGate8 E{GB, b_gate + layer * 4096};
              pg8::gemm_phase<EpiGate8, SchedIn8, false, true>(lds, DM / 128, DM, DM, S, E); }
            if (layer == 0) { SchedWc S{Gp, bx, (const char*)WBPT, (const char*)PB}; EpiWc E{WC};
              int ntw = 256 / 64; asm volatile("" : "+s"(ntw));
              pg8::gemm_phase<EpiWc, SchedWc, false>(lds, ntw, 1024 * 2, 256 * 2, S, E); }
            SEAM(pb + 0);
        }
        if (IN(pb + 1)) { PHASE_LOCALS;
            const bool split = layer == 0 && (Gp & 1) == 0 && Gp >= 256;
            const int gw_m = split ? (vcu >= Gp / 2 ? (vcu - Gp / 2) * NWAVES + wave : (layer == 0 ? T : TX)) : gw, ngw_m = split ? NGW / 2 : NGW;
#pragma unroll 1
            for (int repm = 0; repm < MK_REP_M; ++repm)
            for (int r = gw_m; r < (layer == 0 ? T : TX); r += ngw_m) { const int b = row_batch(r), pos = row_pos(r), g = lanep >> 4, half = 1 << g;
                const int wlo = max(pos - half, 0), whi = min(pos + half, LTOK);
                float s[16];
#pragma unroll
                for (int q = 0; q < 16; ++q) s[q] = 0.f;
                u32x4 wa[16], wc_[16];
#pragma unroll
                for (int jj = 0; jj < 16; ++jj) { const int j = pos - 8 + jj; const int jc = min(max(j, 0), LTOK - 1);
                    const u32x4* up = (const u32x4*)(UB + (size_t)row_of(b, jc) * 1024 + lanep * 16); wa[jj] = up[0]; wc_[jj] = up[1]; }
#pragma unroll
                for (int jj = 0; jj < 16; ++jj) { const int j = pos - 8 + jj; const unsigned msk = (j >= wlo && j < whi) ? 0xffffffffu : 0u;
                    const u32x4 a = wa[jj] & msk, c = wc_[jj] & msk;
                        s[0] += bf_lo(a.x); s[1] += bf_hi(a.x); s[2] += bf_lo(a.y); s[3] += bf_hi(a.y); s[4] += bf_lo(a.z); s[5] += bf_hi(a.z); s[6] += bf_lo(a.w); s[7] += bf_hi(a.w);
                        s[8] += bf_lo(c.x); s[9] += bf_hi(c.x); s[10] += bf_lo(c.y); s[11] += bf_hi(c.y); s[12] += bf_lo(c.z); s[13] += bf_hi(c.z); s[14] += bf_lo(c.w); s[15] += bf_hi(c.w); }
                const float rc = 1.0f / (float)(whi - wlo);
                const u32x4* up = (const u32x4*)(UB + (size_t)r * 1024 + lanep * 16); const u32x4 a = up[0], c = up[1];
                const float uv[16] = {bf_lo(a.x), bf_hi(a.x), bf_lo(a.y), bf_hi(a.y), bf_lo(a.z), bf_hi(a.z), bf_lo(a.w), bf_hi(a.w), bf_lo(c.x), bf_hi(c.x), bf_lo(c.y), bf_hi(c.y), bf_lo(c.z), bf_hi(c.z), bf_lo(c.w), bf_hi(c.w)};
                u32x4 o0, o1;
                o0.x = cvt_pk_bf16(s[0] * rc - uv[0], s[1] * rc - uv[1]); o0.y = cvt_pk_bf16(s[2] * rc - uv[2], s[3] * rc - uv[3]); o0.z = cvt_pk_bf16(s[4] * rc - uv[4], s[5] * rc - uv[5]); o0.w = cvt_pk_bf16(s[6] * rc - uv[6], s[7] * rc - uv[7]);
                o1.x = cvt_pk_bf16(s[8] * rc - uv[8], s[9] * rc - uv[9]); o1.y = cvt_pk_bf16(s[10] * rc - uv[10], s[11] * rc - uv[11]); o1.z = cvt_pk_bf16(s[12] * rc - uv[12], s[13] * rc - uv[13]); o1.w = cvt_pk_bf16(s[14] * rc - uv[14], s[15] * rc - uv[15]);
                u32x4* mp = (u32x4*)(MB + (size_t)r * 1024 + lanep * 16); mp[0] = o0; mp[1] = o1; }
            const float linit = layer == 0 ? 0.2f : (0.8f - 0.6f * 0.74081822068171788f);
            const float d1 = wave_sum(lam_q1[layer * 64 + lanep] * lam_k1[layer * 64 + lanep], lanep), d2 = wave_sum(lam_q2[layer * 64 + lanep] * lam_k2[layer * 64 + lanep], lanep);
            att::AttnArgs P{QB, KB, VB, QB, subln + layer * 128, expf(d1) - expf(d2) + linit, 1.0f - linit};
            __syncthreads();
#pragma unroll 1
            for (int rep = 0; rep < MK_REP_ATT; ++rep) {
            P.A = (rep + 1 < MK_REP_ATT) ? (bf16_t*)(wsp + WS_H + ZSTEP) : QB;
            const int nm = split ? (vcu < 128 ? 1 : 0) : 0, xlim = (layer == 0 && !split) ? 1152 : 1024;
            for (int it = 0; ; ++it) { int id; if (it < nm) id = 1024 + vcu; else { id = vcu + (it - nm) * Gp; if (id >= xlim) break; }
                const int bh = id < 1024 ? (id >> 3) : (id - 1024); int qb = id < 1024 ? (id & 7) : 8; asm volatile("" : "+s"(qb));
                att::attn_unit(P, bh >> 3, bh & 7, qb, lds);
            } }
            SEAM(pb + 1);
        }
        if (IN(pb + 2)) { PHASE_LOCALS;
            SchedY S; S.o.init(layer == 0 ? NPAN : NPAN - 1, DM / 256, Gp, bx); S.A0 = (const char*)QB; S.A1 = (const char*)MB; S.B0 = (const char*)(WBA + (size_t)layer * DM * AW); S.B1 = (const char*)(WC + (size_t)layer * DM * 1024);
            EpiY E{YB, GB};
#pragma unroll 1
            for (int rep = 0; rep < MK_REP_P3; ++rep) {
            pg8::gemm_phase<EpiY, SchedY, false>(lds, 1024 / 64, 1024 * 2, 1024 * 2, S, E);
            SEAM(pb + 2); }
        }
        if (IN(pb + 3)) { PHASE_LOCALS;
            SchedPlain S; S.o.init(layer == 0 ? NPAN : NPAN - 1, DM / 256, Gp, bx); S.A = (const char*)YB; S.B = (const char*)(WOUT + (size_t)layer * DM * DM); S.astep = (size_t)256 * DM * 2; S.bstep = (size_t)256 * DM * 2;
            EpiDelta E{GB, 1.f};
            pg8::gemm_phase<EpiDelta, SchedPlain, false>(lds, DM / 64, DM * 2, DM * 2, S, E);
            SEAM(pb + 3);
        }
        if (IN(pb + 4)) { PHASE_LOCALS;
            if (layer == 1) {
                for (int i = vcu * NWAVES * 64 + tidp; i < MOE_MAXROWS; i += NGT) { ROWL[i] = -1; ROWW[i] = 0.f; } }
            const int R2 = layer == 0 ? T : TX;
            LAS int* lcnt = (LAS int*)lds; LAS int* lrec = (LAS int*)lds + 16;
            int nit = 0;
            const int nitmax = (R2 + 2 * NGW - 1) / (2 * NGW);
            if (layer == 1) { if (tidp < 16) lcnt[tidp] = 0; for (int i = tidp; i < nitmax * 16; i += NWAVES * 64) lrec[4 * i] = -1; __syncthreads(); }
            for (int r0 = gw; r0 < R2; r0 += 2 * NGW, ++nit) { const int rr = r0 + (lanep >> 5) * NGW; const bool valid = rr < R2; const int r = valid ? rr : r0; const int l32 = lanep & 31;
                f32x4 v[16]; float rstd;
#if MK_HRES16
                if (layer == 0) {
                    const f32x4* xr = (const f32x4*)EMB_ROW(r) + l32;
#pragma unroll
                    for (int j = 0; j < 16; ++j) v[j] = xr[32 * j]; }
                else { u32x2 s_[16];
#pragma unroll
                    for (int j = 0; j < 16; ++j) s_[j] = ((const u32x2*)(HRES16 + (size_t)r * DM))[l32 + 32 * j];
#pragma unroll
                    for (int j = 0; j < 16; ++j) { const u32x2 q = s_[j]; v[j].x = bf_lo(q.x); v[j].y = bf_hi(q.x); v[j].z = bf_lo(q.y); v[j].w = bf_hi(q.y); } }
                norm_row2<true, false, false, true, true>(nullptr, HRES16 + (size_t)r * DM, norm_ffn + layer * DM, nullptr, lanep, valid, v, rstd, GB + (size_t)r * DM);
#else
                const float* hsrc = layer == 0 ? EMB_ROW(r) : HRES + (size_t)r * DM;
                norm_row2<true, false>(hsrc, HRES + (size_t)r * DM, norm_ffn + layer * DM, (layer == 0 && !MK_F8_DENSE) ? H + (size_t)r * DM : nullptr, lanep, valid, v, rstd, GB + (size_t)r * DM);
#endif
                if ((layer == 1 || MK_F8_DENSE) && valid) {
                    unsigned* o4 = (unsigned*)((unsigned char*)H + (size_t)r * DM) + l32;
#pragma unroll
                    for (int j = 0; j < 16; ++j) o4[32 * j] = cvt4_fp8(v[j].x * F8_SA, v[j].y * F8_SA, v[j].z * F8_SA, v[j].w * F8_SA); }
                if (layer == 1) {
                    float lg[8];
#pragma unroll
                    for (int e = 0; e < 8; ++e) lg[e] = 0.f;
#pragma unroll
                    for (int j = 0; j < 16; ++j) { const f32x4* rp = (const f32x4*)(router + (size_t)(4 * (l32 + 32 * j)) * 8);
#pragma unroll
                        for (int q = 0; q < 4; ++q) { const f32x4 ra = rp[2 * q], rb = rp[2 * q + 1]; const float hv = v[j][q];
                            lg[0] += hv * ra.x; lg[1] += hv * ra.y; lg[2] += hv * ra.z; lg[3] += hv * ra.w; lg[4] += hv * rb.x; lg[5] += hv * rb.y; lg[6] += hv * rb.z; lg[7] += hv * rb.w; } }
#pragma unroll
                    for (int e = 0; e < 8; ++e) lg[e] = half_sum(lg[e], lanep);
                    if (l32 == 0 && !valid) lrec[4 * (nit * 16 + wave * 2 + (lanep >> 5))] = -1;
                    if (l32 == 0 && valid) { int e1 = 0; float v1 = lg[0];
#pragma unroll
                        for (int e = 1; e < 8; ++e) if (lg[e] > v1) { v1 = lg[e]; e1 = e; }
                        int e2 = -1; float v2 = -INFINITY;
#pragma unroll
                        for (int e = 0; e < 8; ++e) if (e != e1 && lg[e] > v2) { v2 = lg[e]; e2 = e; }
                        if (e2 < 0) e2 = (e1 + 1) & 7;
                        const float w1 = 1.0f / (1.0f + expf(v2 - v1)), w2 = 1.0f - w1;
                        const int s1 = __hip_atomic_fetch_add(lcnt + e1, 1, __ATOMIC_RELAXED, __HIP_MEMORY_SCOPE_WORKGROUP), s2 = __hip_atomic_fetch_add(lcnt + e2, 1, __ATOMIC_RELAXED, __HIP_MEMORY_SCOPE_WORKGROUP);
                        LAS int* rc = lrec + 4 * (nit * 16 + wave * 2 + (lanep >> 5)); rc[0] = r; rc[1] = e1 | (e2 << 8); rc[2] = s1; rc[3] = s2;
                        TOKE[r] = e1; TOKE[T + r] = e2; TOKW[r] = w1; TOKW[T + r] = w2; }
                }
            }
            if (layer == 1) {
                __syncthreads();
                if (tidp < 8) lcnt[8 + tidp] = (int)atomicAdd(CNT + tidp, (unsigned)lcnt[tidp]);
                __syncthreads();
                for (int i = tidp; i < nitmax * 16; i += NWAVES * 64) { const int r = lrec[4 * i];
                    if (r >= 0) { const int ee = lrec[4 * i + 1]; TOKS[r] = lcnt[8 + (ee & 255)] + lrec[4 * i + 2]; TOKS[T + r] = lcnt[8 + (ee >> 8)] + lrec[4 * i + 3]; } }
                __syncthreads();
            }
            SEAM(pb + 4);
        }
        if (layer == 0) {
            if (IN(6)) { PHASE_LOCALS;
                SchedPlain S; S.o.init(NPAN, NHID2 / 256, Gp, bx); S.A = (const char*)H; S.B = (const char*)DWGU; S.astep = (size_t)256 * DM * 2; S.bstep = (size_t)256 * DM * 2;
#if MK_F8_DENSE
                S.astep = (size_t)256 * DM; S.bstep = (size_t)256 * DM;
                EpiSwi8 E{(unsigned char*)HID};
                pg8::gemm_phase<EpiSwi8, SchedPlain, false, true>(lds, DM / 128, DM, DM, S, E);
                SEAM(6);
#else
                EpiSwi E{HID};
#pragma unroll 1
                for (int rep = 0; rep < MK_REP_P5; ++rep) {
                pg8::gemm_phase<EpiSwi, SchedPlain, false>(lds, DM / 64, DM * 2, DM * 2, S, E);
                SEAM(6); }
#endif
            }
            if (IN(7)) { PHASE_LOCALS;
                SchedPlain S; S.o.init(NPAN, DM / 256, Gp, bx); S.A = (const char*)HID; S.B = (const char*)DWD; S.astep = (size_t)256 * DFF * 2; S.bstep = (size_t)256 * DFF * 2;
#if MK_F8_DENSE
                S.astep = (size_t)256 * DFF; S.bstep = (size_t)256 * DFF;
                EpiDelta E{H, 1.0f / (F8_SH * F8_SW)};
                pg8::gemm_phase<EpiDelta, SchedPlain, false, true>(lds, DFF / 128, DFF, DFF, S, E);
                SEAM(7);
#else
#pragma unroll 1
                for (int rep = 0; rep < MK_REP_P6; ++rep) {
                EpiRes E{HRES, (rep + 1 < MK_REP_P6) ? 0.f : 1.f};
                pg8::gemm_phase<EpiRes, SchedPlain, false>(lds, DFF / 64, DFF * 2, DFF * 2, S, E);
                SEAM(7); }
#endif
            }
            if (IN(8)) { PHASE_LOCALS;
#pragma unroll 1
                for (int rep = 0; rep < MK_REP_N1; ++rep) {
                for (int r0 = gw; r0 < T; r0 += 2 * NGW) { const int rr = r0 + (lanep >> 5) * NGW; const bool valid = rr < T; const int r = valid ? rr : r0;
                    f32x4 v[16]; float rstd;
#if MK_HRES16
                    norm_row2<true, false, true, true>(HRES16 + (size_t)r * DM, HRES16 + (size_t)r * DM, norm_mix + DM, H + (size_t)r * DM, lanep, valid, v, rstd, H + (size_t)r * DM);
#else
                    norm_row2<MK_F8_DENSE != 0, false>(HRES + (size_t)r * DM, HRES + (size_t)r * DM, norm_mix + DM, H + (size_t)r * DM, lanep, valid, v, rstd, H + (size_t)r * DM);
#endif
                    if (valid && r < TX) { unsigned* o4 = (unsigned*)(H8P + (size_t)r * DM) + (lanep & 31);
#pragma unroll
                        for (int j = 0; j < 16; ++j) o4[32 * j] = cvt4_fp8(v[j].x * F8_SA, v[j].y * F8_SA, v[j].z * F8_SA, v[j].w * F8_SA); } }
                SEAM(8); }
            }
        } else {
            MoeMap mm; int rb[9];
            { unsigned char* wsp = (unsigned char*)(GAS unsigned char*)args.ws; int p = 0;
#pragma unroll
              for (int e = 0; e < 8; ++e) { const int c = (int)__hip_atomic_load(CNT + e, __ATOMIC_RELAXED, __HIP_MEMORY_SCOPE_AGENT); mm.pb[e] = p; rb[e] = p * 256; p = min(p + ((c + 255) >> 8), MOE_MAXPAN); }
              mm.pb[8] = p; rb[8] = p * 256; }
            if (IN(14)) { PHASE_LOCALS;
                for (int i = gw * 4 + (lanep >> 4); i < 2 * TX; i += NGW * 4) {
                    const int k = i >= TX ? 1 : 0, tok = i - k * TX; const int e = TOKE[k * T + tok], s = TOKS[k * T + tok];
                    int base = 0;
#pragma unroll
                    for (int j = 0; j < 8; ++j) base = (j == e) ? rb[j] : base;
                    if (e >= 0 && e < 8 && s >= 0 && base + s < MOE_MAXROWS) { const int pos = base + s; const int l16 = lanep & 15;
                        if (l16 == 0) { ROWL[pos] = tok | (k << 30); ROWW[pos] = TOKW[k * T + tok]; }
                        const u32x4* src = (const u32x4*)((const unsigned char*)H + (size_t)tok * DM) + l16; u32x4* dst = (u32x4*)(wsp + WS_H8S + (size_t)pos * DM) + l16;
                        u32x4 t[8];
#pragma unroll
                        for (int j = 0; j < 8; ++j) t[j] = src[16 * j];
#pragma unroll
                        for (int j = 0; j < 8; ++j) dst[16 * j] = t[j]; } }
                SEAM(14);
            }
            if (IN(15)) { PHASE_LOCALS;
                SchedMoeUp S; S.o.init(mm.pb[8], NHID2 / 256, Gp, bx); S.A = (const char*)(wsp + WS_H8S); S.B = (const char*)MWGU; S.mm = mm;
                EpiSwi8 E{(unsigned char*)HID};
                pg8::gemm_phase<EpiSwi8, SchedMoeUp, false, true>(lds, DM / 128, DM, DM, S, E);
                SEAM(15);
            }
            if (IN(16)) { PHASE_LOCALS;
                SchedMoeDown S; S.o.init(mm.pb[8], DM / 256, Gp, bx, 1); S.A = (const char*)HID; S.B = (const char*)MWD; S.mm = mm;
                EpiMoeDown E{(bf16_t*)(wsp + WS_OUT2A), (bf16_t*)(wsp + WS_OUT2B), ROWL, ROWW, 1.0f / (F8_SH * F8_SW)};
                pg8::gemm_phase<EpiMoeDown, SchedMoeDown, false, true>(lds, DFF / 128, DFF, DFF, S, E);
                SEAM(16);
            }
            if (IN(17)) { PHASE_LOCALS;
                for (int r0 = gw; r0 < TX; r0 += 2 * NGW) { const int rr = r0 + (lanep >> 5) * NGW; const bool valid = rr < TX; const int r = valid ? rr : r0;
                    f32x4 v[16]; float rstd; norm_row2<true, true, MK_HRES16 != 0, false>(MK_HRES16 ? (const void*)(HRES16 + (size_t)r * DM) : (const void*)(HRES + (size_t)r * DM), nullptr, norm_final, nullptr, lanep, valid, v, rstd, (const bf16_t*)(wsp + WS_OUT2A) + (size_t)r * DM, (const bf16_t*)(wsp + WS_OUT2B) + (size_t)r * DM);
                    if (valid) { f32x4* op = (f32x4*)((float*)(GAS float*)args.out + (size_t)r * DM) + (lanep & 31);
#pragma unroll
                        for (int j = 0; j < 16; ++j) op[32 * j] = v[j]; } }
            }
        }
    }
    if (MK_PROBE_BUF != 0 && IN(20)) { PHASE_LOCALS;
        for (int r = gw; r < TX; r += NGW) {
            float* op = (float*)(GAS float*)args.out + (size_t)r * DM; const int rs = MK_PROBE_META ? TX + (r & 255) : r;
            for (int c = lanep; c < DM; c += 64) { bf16_t v;
                if (MK_PROBE_BUF == 1) v = c < 1024 ? QB[(size_t)rs * 1024 + c] : KB[(size_t)rs * 1024 + c - 1024];
                else if (MK_PROBE_BUF == 2) v = c < 1024 ? VB[(size_t)rs * 1024 + c] : UB[(size_t)rs * 1024 + c - 1024];
                else if (MK_PROBE_BUF == 3) v = GB[(size_t)rs * 4096 + c];
                else if (MK_PROBE_BUF == 4) v = GB[(size_t)rs * 4096 + 2048 + c];
                else if (MK_PROBE_BUF == 5) v = c < 1024 ? QB[(size_t)rs * 1024 + c] : MB[(size_t)rs * 1024 + c - 1024];
                else if (MK_PROBE_BUF == 7) v = c < 1024 ? QB[(size_t)rs * 1024 + c] : (bf16_t)0;
                else if (MK_PROBE_BUF == 8) v = c < 1024 ? MB[(size_t)rs * 1024 + c] : (bf16_t)0;
                else v = YB[(size_t)rs * 2048 + c];
                float fv = __uint_as_float((unsigned)v << 16); if (!(fabsf(fv) < 1e30f)) fv = 12345.0f;
                op[c] = fv; } }
    }
#undef IN
#undef SEAM
#undef PHASE_LOCALS
}

extern "C" void kernel_launch(void* const* d_in, const int* in_sizes, int n_in, void* d_out, int out_size, void* d_ws, size_t ws_size, hipStream_t stream) {
    static int grid = 0;
    if (grid == 0) {
        if (n_in != 24 || out_size != TX * DM || ws_size < WS_END) { fprintf(stderr, "kernel_launch: unexpected shapes (n_in %d, out %d, ws %zu < %zu)\n", n_in, out_size, ws_size, (size_t)WS_END); grid = -1; return; }
        int dev = 0, cus = 0;
        if (hipGetDevice(&dev) != hipSuccess || hipDeviceGetAttribute(&cus, hipDeviceAttributeMultiprocessorCount, dev) != hipSuccess) { grid = -1; return; }
        if (hipFuncSetAttribute((const void*)fwd_kernel, hipFuncAttributeMaxDynamicSharedMemorySize, LDS_BYTES) != hipSuccess) { fprintf(stderr, "kernel_launch: hipFuncSetAttribute failed\n"); grid = -1; return; }
        int per_cu = 0;
        if (hipOccupancyMaxActiveBlocksPerMultiprocessor(&per_cu, (const void*)fwd_kernel, NWAVES * 64, LDS_BYTES) != hipSuccess || per_cu < 1) fprintf(stderr, "kernel_launch: occupancy query reports %d\n", per_cu);
        (void)hipGetLastError();
        grid = cus;
    }
    if (grid < 0) return;
    (void)hipMemsetAsync((char*)d_ws + WS_CTL, 0, CTL_ZERO_BYTES, stream);
    Args a{};
    for (int i = 0; i < 24; ++i) a.in[i] = (const float*)d_in[i];
    a.out = (float*)d_out; a.ws = (unsigned char*)d_ws;
#if MK_ONE_LAUNCH
    a.ph_lo = 0; a.ph_hi = NPHASE;
    hipLaunchKernelGGL(fwd_kernel, dim3(grid), dim3(NWAVES * 64), LDS_BYTES, stream, a);
#else
    for (int p = 0; p <= MK_LAST_PHASE; ++p) { a.ph_lo = p; a.ph_hi = p + 1; hipLaunchKernelGGL(fwd_kernel, dim3(grid), dim3(NWAVES * 64), LDS_BYTES, stream, a); }
    if (MK_PROBE_BUF != 0) { a.ph_lo = 20; a.ph_hi = 21; hipLaunchKernelGGL(fwd_kernel, dim3(grid), dim3(NWAVES * 64), LDS_BYTES, stream, a); }
    else if (MK_LAST_PHASE < 17) { a.ph_lo = 17; a.ph_hi = 18; hipLaunchKernelGGL(fwd_kernel, dim3(grid), dim3(NWAVES * 64), LDS_BYTES, stream, a); }
#endif
}
```

```cpp
#include <hip/hip_runtime.h>
#include <cstdio>
#include <cstdint>

#ifndef MK_ONE_LAUNCH
#define MK_ONE_LAUNCH 1
#endif
#ifndef MK_REP_P0
#define MK_REP_P0 1
#endif
#ifndef MK_REP_P5
#define MK_REP_P5 1
#endif
#ifndef MK_REP_ATT
#define MK_REP_ATT 1
#endif
#ifndef MK_REP_M
#define MK_REP_M 1
#endif
#ifndef MK_REP_P1
#define MK_REP_P1 1
#endif
#ifndef MK_REP_P3
#define MK_REP_P3 1
#endif
#ifndef MK_REP_N1
#define MK_REP_N1 1
#endif
#ifndef MK_REP_P4
#define MK_REP_P4 1
#endif
#ifndef MK_REP_P6
#define MK_REP_P6 1
#endif
#ifndef MK_REP_MUP
#define MK_REP_MUP 1
#endif
#ifndef MK_F8_DENSE
#define MK_F8_DENSE 1
#endif
#ifndef MK_REP_MOE
#define MK_REP_MOE 1
#endif
#ifndef MK_HRES16
#define MK_HRES16 1
#endif
#ifndef MK_REP_EPI
#define MK_REP_EPI 1
#endif
#ifndef MK_PROBE_META
#define MK_PROBE_META 0
#endif
#ifndef MK_PROBE_BUF
#define MK_PROBE_BUF 0
#endif
#ifndef MK_LAST_PHASE
#define MK_LAST_PHASE 17
#endif

#define LAS __attribute__((address_space(3)))
#define GAS __attribute__((address_space(1)))
typedef unsigned short bf16_t;
typedef short bf16x8 __attribute__((ext_vector_type(8)));
typedef short s16x4 __attribute__((ext_vector_type(4)));
typedef float f32x2 __attribute__((ext_vector_type(2)));
typedef float f32x4 __attribute__((ext_vector_type(4)));
typedef float f32x16 __attribute__((ext_vector_type(16)));
typedef unsigned u32x2 __attribute__((ext_vector_type(2)));
typedef unsigned u32x4 __attribute__((ext_vector_type(4)));

constexpr int NB = 16, SEQ = 2048, NMETA = 16, LTOK = SEQ + NMETA, DM = 2048;
constexpr int T = NB * LTOK;
constexpr int TX = NB * SEQ;
constexpr int NPAN = T / 256;
constexpr int AW = 1024, NH = 8, DFF = 5632, NE = 8, INC = 8192;
constexpr int NHID2 = 2 * DFF;
constexpr float EPS = 1e-5f;
constexpr float LOG2E = 1.4426950408889634f;
constexpr float QSCALE = 0.125f * LOG2E;
constexpr int MOE_MAXPAN = 264, MOE_MAXROWS = MOE_MAXPAN * 256;
constexpr int NWAVES = 8;

__device__ __forceinline__ int row_pos(int r) { return r < TX ? NMETA + (r & (SEQ - 1)) : ((r - TX) & (NMETA - 1)); }
__device__ __forceinline__ int row_batch(int r) { return r < TX ? (r >> 11) : ((r - TX) >> 4); }
__device__ __forceinline__ int row_of(int b, int pos) { return pos < NMETA ? TX + b * NMETA + pos : b * SEQ + pos - NMETA; }

constexpr size_t MiB = 1u << 20;
constexpr size_t WS_CTL = 0, CTL_ZERO_BYTES = 1 * MiB;
constexpr size_t WS_ROPE = 1 * MiB;
constexpr size_t WS_TOKE = 2 * MiB, WS_TOKS = 2 * MiB + 320 * 1024, WS_TOKW = 2 * MiB + 640 * 1024;
constexpr size_t WS_ROWL = 3 * MiB, WS_ROWW = 3 * MiB + 320 * 1024;
constexpr size_t WS_WIN = 5 * MiB;
constexpr size_t WS_WBA = 69 * MiB;
constexpr size_t WS_WC = 77 * MiB;
constexpr size_t WS_WOUT = 85 * MiB;
constexpr size_t WS_DWGU = 101 * MiB;
constexpr size_t WS_DWD = 145 * MiB;
constexpr size_t WS_MWGU = 167 * MiB;
constexpr size_t WS_MWD = 519 * MiB;
constexpr size_t WS_HRES = 695 * MiB;
constexpr size_t WS_H = 953 * MiB;
constexpr size_t WS_Z = 1082 * MiB;
constexpr size_t ZSTEP = (size_t)T * 1024 * 2;
constexpr size_t WS_Q = WS_Z, WS_K = WS_Z + ZSTEP, WS_V = WS_Z + 2 * ZSTEP, WS_U = WS_Z + 3 * ZSTEP, WS_G = WS_Z + 4 * ZSTEP;
constexpr size_t WS_Y = WS_K;
constexpr size_t WS_HID = WS_Z;
constexpr size_t WS_OUT2A = WS_WIN, WS_OUT2B = WS_H;
static_assert(WS_OUT2A + (size_t)T * 2048 * 2 <= WS_MWGU, "OUT2A over dead weights");
constexpr size_t WS_H8S = WS_Z + 368 * MiB;
constexpr size_t WS_END = WS_Z + 8 * ZSTEP;
static_assert(WS_MWD + (size_t)8 * 2048 * 5632 * 2 <= WS_HRES && WS_HRES + (size_t)T * 2048 * 4 <= WS_H && WS_H + (size_t)T * 2048 * 2 <= WS_Z, "ws map");
static_assert((size_t)MOE_MAXROWS * DFF <= 368 * MiB && WS_H8S + (size_t)MOE_MAXROWS * DM <= WS_END && (size_t)T * DFF * 2 <= 8 * ZSTEP, "hidden / gathered rows fit Z"); static_assert((size_t)MOE_MAXROWS * 4 <= 320 * 1024, "row tables");
constexpr int CW_BAR = 4096;
constexpr int CW_CNT = 8192;

typedef __bf16 bf16x2_t __attribute__((ext_vector_type(2)));
__device__ __forceinline__ unsigned cvt_pk_bf16(float lo, float hi) { const f32x2 v = {lo, hi}; const bf16x2_t b = __builtin_convertvector(v, bf16x2_t); return __builtin_bit_cast(unsigned, b); }
__device__ __forceinline__ float bf_lo(unsigned u) { return __uint_as_float(u << 16); }
__device__ __forceinline__ float bf_hi(unsigned u) { return __uint_as_float(u & 0xffff0000u); }
__device__ __forceinline__ float shfl_xor_l(float v, int o, int lane) { return __int_as_float(__builtin_amdgcn_ds_bpermute((lane ^ o) << 2, __float_as_int(v))); }
__device__ __forceinline__ float wave_sum(float v, int lane) {
#pragma unroll
    for (int o = 1; o < 64; o <<= 1) v += shfl_xor_l(v, o, lane);
    return v;
}
__device__ __forceinline__ float fast_sigmoid(float x) { return __builtin_amdgcn_rcpf(1.0f + __builtin_amdgcn_exp2f(-x * LOG2E)); }
constexpr float F8_SA = 16.0f, F8_SW = 256.0f, F8_SH = 8.0f;
__device__ __forceinline__ float f8_clamp(float x) { return __builtin_fminf(__builtin_fmaxf(x, -448.0f), 448.0f); }
__device__ __forceinline__ unsigned cvt4_fp8(float a, float b, float c, float d) {
    int r = __builtin_amdgcn_cvt_pk_fp8_f32(f8_clamp(a), f8_clamp(b), 0, false); r = __builtin_amdgcn_cvt_pk_fp8_f32(f8_clamp(c), f8_clamp(d), r, true); return (unsigned)r; }
#define NT_STORE16(p, v) __builtin_nontemporal_store((v), (u32x4*)(p))
#define LDS_WAIT() asm volatile("s_waitcnt lgkmcnt(0)" ::: "memory")
#define VM_WAIT() asm volatile("s_waitcnt vmcnt(0)" ::: "memory")

namespace pg8 {
constexpr int BM = 256, BK = 64, HALF = 128, HTB = HALF * BK * 2, STAGE_BYTES = 8 * HTB, NXCD = 8, WGM = 8;
__host__ __device__ __forceinline__ int lds_byte(int r, int c) { const int st = (r >> 4) * 2 + (c >> 5), rr = r & 15, cc = c & 31, ob = rr * 64 + cc * 2; return st * 1024 + (ob ^ (((ob >> 9) & 1) << 5)); }
__host__ __device__ __forceinline__ void stage_rc(int b, int& R, int& C) { const int st = b / 1024, sb = b % 1024, swz = sb ^ (((sb >> 9) & 1) << 5); R = (st >> 1) * 16 + swz / 64; C = (st & 1) * 32 + (swz % 64) / 2; }
__host__ __device__ __forceinline__ int perm32(int rho) { const int n = rho >> 4, i = rho & 15; return 8 * (i >> 2) + 4 * n + (i & 3); }

struct Unit { const char* a; const char* b; int pm, pn, aux; };
template <class E, class = void> struct epi_chain { static constexpr bool value = false; };
template <class E> struct epi_chain<E, decltype((void)E::CHAIN)> { static constexpr bool value = E::CHAIN; };

struct TileOrder {
    int nM, nN, nwg, G, c, pnfast;
    __device__ __forceinline__ void init(int nM_, int nN_, int G_, int c_, int pnfast_ = 0) { nM = nM_; nN = nN_; nwg = nM * nN; G = G_; c = c_; pnfast = pnfast_; }
    __device__ __forceinline__ bool tile(int i, int& pm, int& pn) const { return tileL((long)i * G + c, pm, pn); }
    __device__ __forceinline__ bool tileL(const long L, int& pm, int& pn) const {
        if (L >= nwg) return false;
        int wgid = (int)L; { const int q = nwg / NXCD, r = nwg % NXCD, xcd = wgid % NXCD, off = wgid / NXCD; wgid = (xcd < r ? xcd * (q + 1) : r * (q + 1) + (xcd - r) * q) + off; }
        const int nig = WGM * nN, gid = wgid / nig, fm = gid * WGM, gsz = (nM - fm) < WGM ? (nM - fm) : WGM;
        if (pnfast) { pn = (wgid % nig) % nN; pm = fm + (wgid % nig) / nN; }
        else { pm = fm + ((wgid % nig) % gsz); pn = (wgid % nig) / gsz; }
        return true;
    }
};

typedef int i32x8 __attribute__((ext_vector_type(8)));
template <class Epi, class Sched, bool GATHER, bool F8 = false>
__device__ __forceinline__ void gemm_phase(LAS unsigned char* lds, const int nt, const int ldaB, const int ldbB, const Sched& S, const Epi& E) {
    int tid_ = threadIdx.x; asm volatile("" : "+v"(tid_));
    const int tid = tid_, wid = __builtin_amdgcn_readfirstlane(tid >> 6), lane = tid & 63, wr = wid >> 2, wc = wid & 3, fr = lane & 15, fq = lane >> 4;
    unsigned voffA[2], voffB[2]; int RA[2], CA[2];
#pragma unroll
    for (int i = 0; i < 2; ++i) { int R, C; stage_rc(tid * 16 + i * 8192, R, C); const int Rb = Epi::PERM ? ((R & ~31) + perm32(R & 31)) : R;
        voffA[i] = (unsigned)(R * ldaB + C * 2); voffB[i] = (unsigned)(Rb * ldbB + C * 2); RA[i] = R; CA[i] = C * 2; }
    const size_t kstep = (size_t)(BK * 2);
    const size_t hstepA = (size_t)HALF * ldaB, hstepB = (size_t)HALF * ldbB;
    const unsigned ldsw = (unsigned)wid * 1024u;
    const int aoff = lds_byte(wr * 64 + fr, fq * 8), boff = lds_byte(wc * 32 + fr, fq * 8);
    unsigned cO[2][2], nO[2][2], sO[2][2];
#define PG8_SA(b, h) (((b) * 2 + (h)) * HTB)
#define PG8_SB(b, h) ((4 + (b) * 2 + (h)) * HTB)
#define PG8_STAGE_B(bufoff, gbase) do { _Pragma("unroll") for (int _i = 0; _i < 2; ++_i) \
        __builtin_amdgcn_global_load_lds((const unsigned*)((const char*)(gbase) + voffB[_i]), (LAS unsigned*)(lds + (bufoff) + ldsw + _i * 8192), 16, 0, 0); } while (0)
#define PG8_STAGE_A(bufoff, gbase, h, O) do { _Pragma("unroll") for (int _i = 0; _i < 2; ++_i) { \
        const char* _p = GATHER ? ((const char*)(gbase) + (O)[h][_i]) : ((const char*)(gbase) + (size_t)(h) * hstepA + voffA[_i]); \
        __builtin_amdgcn_global_load_lds((const unsigned*)_p, (LAS unsigned*)(lds + (bufoff) + ldsw + _i * 8192), 16, 0, 0); } } while (0)
#define PG8_LD16(off) (*(const LAS u32x4*)(lds + (off)))
#define PG8_CAT(lo, hi) __builtin_bit_cast(i32x8, __builtin_shufflevector(lo, hi, 0, 1, 2, 3, 4, 5, 6, 7))
#define PG8_LDA(dst, b, h) do { _Pragma("unroll") for (int m = 0; m < 4; ++m) { if constexpr (F8) dst##8[m] = PG8_CAT(PG8_LD16(PG8_SA(b, h) + aoff + m * 2048), PG8_LD16(PG8_SA(b, h) + aoff + m * 2048 + 1024)); \
        else { _Pragma("unroll") for (int k = 0; k < 2; ++k) dst[m][k] = *(const LAS bf16x8*)(lds + PG8_SA(b, h) + aoff + m * 2048 + k * 1024); } } } while (0)
#define PG8_LDB(dst, b, h) do { _Pragma("unroll") for (int n = 0; n < 2; ++n) { if constexpr (F8) dst##8[n] = PG8_CAT(PG8_LD16(PG8_SB(b, h) + boff + n * 2048), PG8_LD16(PG8_SB(b, h) + boff + n * 2048 + 1024)); \
        else { _Pragma("unroll") for (int k = 0; k < 2; ++k) dst[n][k] = *(const LAS bf16x8*)(lds + PG8_SB(b, h) + boff + n * 2048 + k * 1024); } } } while (0)
#define PG8_MMA(ai, bj, At, Bt) do { __builtin_amdgcn_s_setprio(1); _Pragma("unroll") for (int m = 0; m < 4; ++m) _Pragma("unroll") for (int n = 0; n < 2; ++n) { \
        if constexpr (F8) asm volatile("v_mfma_scale_f32_16x16x128_f8f6f4 %0, %1, %2, %0, %3, %3 op_sel_hi:[0,0,0]" : "+v"(acc[ai][bj][m][n]) : "v"(Bt##8[n]), "v"(At##8[m]), "v"(f8one));   \
        else { _Pragma("unroll") for (int k = 0; k < 2; ++k) acc[ai][bj][m][n] = __builtin_amdgcn_mfma_f32_16x16x32_bf16(Bt[n][k], At[m][k], acc[ai][bj][m][n], 0, 0, 0); } } \
        __builtin_amdgcn_s_setprio(0); } while (0)
#define PG8_WAIT_V(n) asm volatile("s_waitcnt vmcnt(" #n ")" ::: "memory")
#define PG8_WAIT_L(n) asm volatile("s_waitcnt lgkmcnt(" #n ")" ::: "memory")
#define PG8_BAR __builtin_amdgcn_s_barrier()
#define PG8_SCHED __builtin_amdgcn_sched_barrier(0)
#define PG8_ROWS(dst, u) do { const int* _rw = S.rows(u); _Pragma("unroll") for (int _h = 0; _h < 2; ++_h) _Pragma("unroll") for (int _i = 0; _i < 2; ++_i) { \
        int _t = _rw[_h * HALF + RA[_i]]; _t = _t < 0 ? 0 : (_t >= T ? T - 1 : _t); dst[_h][_i] = (unsigned)_t * (unsigned)ldaB + (unsigned)CA[_i]; } } while (0)
    Unit cur, nxt; int ui = 0;
    if (!S.next(0, cur)) return;
    f32x4 acc[2][2][4][2];
#pragma unroll
    for (int a = 0; a < 2; ++a)
#pragma unroll
        for (int b = 0; b < 2; ++b)
#pragma unroll
            for (int m = 0; m < 4; ++m)
#pragma unroll
                for (int n = 0; n < 2; ++n) acc[a][b][m][n] = (f32x4){0.f, 0.f, 0.f, 0.f};
    int f8one = 0x7F7F7F7F; asm volatile("" : "+v"(f8one));
    bf16x8 At[4][2], B0[2][2], B1[2][2]; i32x8 At8[4], B08[2], B18[2];
    const char* cA = cur.a; const char* cB = cur.b;
    if constexpr (GATHER) { PG8_ROWS(cO, cur); }
    PG8_STAGE_B(PG8_SB(0, 0), cB); PG8_STAGE_B(PG8_SB(0, 1), cB + hstepB); PG8_STAGE_A(PG8_SA(0, 0), cA, 0, cO); PG8_STAGE_A(PG8_SA(0, 1), cA, 1, cO);
    if (wr == 1) PG8_BAR;
    PG8_WAIT_V(2); PG8_BAR;
    PG8_STAGE_B(PG8_SB(1, 0), cB + kstep); PG8_STAGE_A(PG8_SA(1, 0), cA + kstep, 0, cO); PG8_STAGE_B(PG8_SB(1, 1), cB + hstepB + kstep);
    PG8_WAIT_V(6); PG8_BAR;
    for (;;) {
        const bool has_next = S.next(ui + 1, nxt);
        const char* nA = has_next ? nxt.a : cA; const char* nB = has_next ? nxt.b : cB;
        if constexpr (GATHER) { if (has_next) { PG8_ROWS(nO, nxt); } else {
#pragma unroll
            for (int h = 0; h < 2; ++h)
#pragma unroll
                for (int i = 0; i < 2; ++i) nO[h][i] = cO[h][i]; } }
        for (int t = 0; t < nt; t += 2) {
            const bool last = (t == nt - 2);
            const char* a1 = cA + (size_t)(t + 1) * kstep;
            const char* a2 = last ? nA : cA + (size_t)(t + 2) * kstep; const char* b2 = last ? nB : cB + (size_t)(t + 2) * kstep;
            const char* a3 = a2 + kstep; const char* b3 = b2 + kstep;
            if constexpr (GATHER) {
#pragma unroll
                for (int h = 0; h < 2; ++h)
#pragma unroll
                    for (int i = 0; i < 2; ++i) sO[h][i] = last ? nO[h][i] : cO[h][i]; }
            PG8_LDB(B0, 0, 0); PG8_LDB(B1, 0, 1); PG8_SCHED; PG8_LDA(At, 0, 0); PG8_STAGE_A(PG8_SA(1, 1), a1, 1, cO);
            PG8_WAIT_V(8); PG8_WAIT_L(0); PG8_BAR; PG8_MMA(0, 0, At, B0); PG8_MMA(0, 1, At, B1); PG8_BAR; PG8_SCHED;
            PG8_LDA(At, 0, 1); PG8_STAGE_B(PG8_SB(0, 0), b2); PG8_STAGE_B(PG8_SB(0, 1), b2 + hstepB); PG8_STAGE_A(PG8_SA(0, 0), a2, 0, sO);
            PG8_WAIT_V(8); PG8_WAIT_L(0); PG8_BAR; PG8_MMA(1, 0, At, B0); PG8_MMA(1, 1, At, B1); PG8_BAR; PG8_SCHED;
            PG8_LDB(B0, 1, 0); PG8_LDB(B1, 1, 1); PG8_SCHED; PG8_LDA(At, 1, 0); PG8_STAGE_A(PG8_SA(0, 1), a2, 1, sO);
            PG8_WAIT_V(8); PG8_WAIT_L(0); PG8_BAR; PG8_MMA(0, 0, At, B0); PG8_MMA(0, 1, At, B1); PG8_BAR; PG8_SCHED;
            PG8_LDA(At, 1, 1); PG8_STAGE_B(PG8_SB(1, 0), b3); PG8_STAGE_B(PG8_SB(1, 1), b3 + hstepB); PG8_STAGE_A(PG8_SA(1, 0), a3, 0, sO);
            PG8_WAIT_V(8); PG8_WAIT_L(0); PG8_BAR; PG8_MMA(1, 0, At, B0); PG8_MMA(1, 1, At, B1); PG8_BAR; PG8_SCHED;
        }
        if (wr == 0) PG8_BAR;
        if constexpr (F8) asm volatile("s_nop 15\n\ts_nop 15" ::: "memory");
        bool keep = false;
        if constexpr (epi_chain<Epi>::value) { if (cur.aux == 0) { E.mid(acc, cur, wr, wc, fr, fq); keep = true; } else E(acc, cur, wr, wc, fr, fq); }
        else E(acc, cur, wr, wc, fr, fq);
        if (!has_next) break;
        if (!keep) {
#pragma unroll
        for (int a = 0; a < 2; ++a)
#pragma unroll
            for (int b = 0; b < 2; ++b)
#pragma unroll
                for (int m = 0; m < 4; ++m)
#pragma unroll
                    for (int n = 0; n < 2; ++n) acc[a][b][m][n] = (f32x4){0.f, 0.f, 0.f, 0.f}; }
        cur = nxt; cA = nA; cB = nB; ++ui;
        if constexpr (GATHER) {
#pragma unroll
            for (int h = 0; h < 2; ++h)
#pragma unroll
                for (int i = 0; i < 2; ++i) cO[h][i] = nO[h][i]; }
        if (wr == 1) PG8_BAR;
    }
    PG8_WAIT_V(0);
    PG8_BAR;
#undef PG8_SA
#undef PG8_SB
#undef PG8_STAGE_A
#undef PG8_STAGE_B
#undef PG8_LDA
#undef PG8_LDB
#undef PG8_MMA
#undef PG8_CAT
#undef PG8_LD16
#undef PG8_WAIT_V
#undef PG8_WAIT_L
#undef PG8_BAR
#undef PG8_SCHED
#undef PG8_ROWS
}
}

using pg8::Unit;
typedef f32x4 Acc[2][2][4][2];

struct EpiIn {
    static constexpr bool PERM = true;
    bf16_t *Q, *Kb, *V, *U, *G; const float* bgate; const float* rope;
    __device__ __forceinline__ void operator()(const Acc& acc, const Unit& u, int wr, int wc, int fr, int fq) const {
        const int row0 = u.pm * 256 + wr * 64 + fr;
        if (u.pn < 8) {
            bf16_t* base = u.pn < 4 ? Q : Kb; const float sc = u.pn < 4 ? QSCALE : 1.0f; const int ct = (u.pn & 3) * 256 + wc * 64 + 8 * fq;
            f32x4 cs[2][2][4];
#define ROPE_LD(bf, st) do { _Pragma("unroll") for (int g = 0; g < 2; ++g) { const int gi = (st) * 2 + g, row = row0 + (gi >> 2) * 128 + (gi & 3) * 16; const float* tb = rope + row_pos(row) * 64 + 8 * fq; \
                cs[bf][g][0] = *(const f32x4*)tb; cs[bf][g][1] = *(const f32x4*)(tb + 4); cs[bf][g][2] = *(const f32x4*)(tb + 32); cs[bf][g][3] = *(const f32x4*)(tb + 36); } } while (0)
#define ROPE_DO(bf, st) do { _Pragma("unroll") for (int g = 0; g < 2; ++g) { const int gi = (st) * 2 + g, ai = gi >> 2, m = gi & 3, row = row0 + ai * 128 + m * 16; \
                const f32x4 c0 = cs[bf][g][0], c1 = cs[bf][g][1], s0 = cs[bf][g][2], s1 = cs[bf][g][3]; \
                const f32x4 t1a = acc[ai][0][m][0], t1b = acc[ai][0][m][1], t2a = acc[ai][1][m][0], t2b = acc[ai][1][m][1]; \
                const f32x4 o1a = (t1a * c0 - t2a * s0) * sc, o1b = (t1b * c1 - t2b * s1) * sc, o2a = (t2a * c0 + t1a * s0) * sc, o2b = (t2b * c1 + t1b * s1) * sc; \
                u32x4 w1, w2; w1.x = cvt_pk_bf16(o1a[0], o1a[1]); w1.y = cvt_pk_bf16(o1a[2], o1a[3]); w1.z = cvt_pk_bf16(o1b[0], o1b[1]); w1.w = cvt_pk_bf16(o1b[2], o1b[3]); \
                w2.x = cvt_pk_bf16(o2a[0], o2a[1]); w2.y = cvt_pk_bf16(o2a[2], o2a[3]); w2.z = cvt_pk_bf16(o2b[0], o2b[1]); w2.w = cvt_pk_bf16(o2b[2], o2b[3]); \
                bf16_t* rp = base + (size_t)row * 1024 + ct; NT_STORE16(rp, w1); NT_STORE16(rp + 32, w2); } } while (0)
            ROPE_LD(0, 0); ROPE_LD(1, 1); __builtin_amdgcn_sched_barrier(0);
            ROPE_DO(0, 0); __builtin_amdgcn_sched_barrier(0); ROPE_LD(0, 2); __builtin_amdgcn_sched_barrier(0);
            ROPE_DO(1, 1); __builtin_amdgcn_sched_barrier(0); ROPE_LD(1, 3); __builtin_amdgcn_sched_barrier(0);
            ROPE_DO(0, 2); __builtin_amdgcn_sched_barrier(0); ROPE_DO(1, 3);
#undef ROPE_LD
#undef ROPE_DO
        } else if (u.pn < 16) {
            bf16_t* base = u.pn < 12 ? V : U; const int ct = (u.pn & 3) * 256 + wc * 32 + 8 * fq;
#pragma unroll
            for (int ai = 0; ai < 2; ++ai)
#pragma unroll
                for (int m = 0; m < 4; ++m) { bf16_t* rp = base + (size_t)(row0 + ai * 128 + m * 16) * 1024 + ct;
#pragma unroll
                    for (int bj = 0; bj < 2; ++bj) { const f32x4 v0 = acc[ai][bj][m][0], v1 = acc[ai][bj][m][1];
                        u32x4 w; w.x = cvt_pk_bf16(v0[0], v0[1]); w.y = cvt_pk_bf16(v0[2], v0[3]); w.z = cvt_pk_bf16(v1[0], v1[1]); w.w = cvt_pk_bf16(v1[2], v1[3]);
                        NT_STORE16(rp + bj * 128, w); } }
        } else {
            const int ct = (u.pn - 16) * 128 + wc * 32 + 8 * fq;
            float nba[8], nbp[8];
#pragma unroll
            for (int n = 0; n < 2; ++n) { const f32x4 a_ = *(const f32x4*)(bgate + ct + 4 * n), p_ = *(const f32x4*)(bgate + 2048 + ct + 4 * n);
#pragma unroll
                for (int j = 0; j < 4; ++j) { nba[n * 4 + j] = a_[j] * -LOG2E; nbp[n * 4 + j] = p_[j] * -LOG2E; } }
#pragma unroll
            for (int ai = 0; ai < 2; ++ai)
#pragma unroll
                for (int m = 0; m < 4; ++m) { bf16_t* rp = G + (size_t)(row0 + ai * 128 + m * 16) * 4096 + ct;
                    float ea[8], ep[8], sp[8];
#pragma unroll
                    for (int j = 0; j < 8; ++j) { ea[j] = __builtin_fmaf(acc[ai][0][m][j >> 2][j & 3], -LOG2E, nba[j]); ep[j] = __builtin_fmaf(acc[ai][1][m][j >> 2][j & 3], -LOG2E, nbp[j]); }
                    __builtin_amdgcn_sched_barrier(0);
#pragma unroll
                    for (int j = 0; j < 8; ++j) { ea[j] = __builtin_amdgcn_exp2f(ea[j]); ep[j] = __builtin_amdgcn_exp2f(ep[j]); }
                    __builtin_amdgcn_sched_barrier(0);
#pragma unroll
                    for (int j = 0; j < 8; ++j) { ea[j] += 1.0f; ep[j] += 1.0f; }
                    __builtin_amdgcn_sched_barrier(0);
#pragma unroll
                    for (int j = 0; j < 8; ++j) { ea[j] = __builtin_amdgcn_rcpf(ea[j]); sp[j] = __builtin_amdgcn_rcpf(ep[j]); }
                    __builtin_amdgcn_sched_barrier(0);
#pragma unroll
                    for (int j = 0; j < 8; ++j) ea[j] *= ep[j];
                    u32x4 w0, w1; w0.x = cvt_pk_bf16(ea[0], ea[1]); w0.y = cvt_pk_bf16(ea[2], ea[3]); w0.z = cvt_pk_bf16(ea[4], ea[5]); w0.w = cvt_pk_bf16(ea[6], ea[7]);
                    w1.x = cvt_pk_bf16(sp[0], sp[1]); w1.y = cvt_pk_bf16(sp[2], sp[3]); w1.z = cvt_pk_bf16(sp[4], sp[5]); w1.w = cvt_pk_bf16(sp[6], sp[7]);
                    NT_STORE16(rp, w0); NT_STORE16(rp + 2048, w1); }
        }
    }
};
struct SchedIn {
    pg8::TileOrder o; const char* A; const char* B;
    __device__ __forceinline__ bool next(int i, Unit& u) const { int pm, pn; if (!o.tile(i, pm, pn)) return false;
        u.pm = pm; u.pn = pn; u.aux = 0; u.a = A + (size_t)pm * 256 * 2048 * 2; u.b = B + (size_t)pn * 256 * 2048 * 2; return true; }
    __device__ __forceinline__ const int* rows(const Unit&) const { return nullptr; }
};

struct SchedInA {
    pg8::TileOrder o; const char* A; const char* B;
    __device__ __forceinline__ bool next(int i, Unit& u) const { int pm, pn;
        if (!o.tile(i, pm, pn)) { const long j = (long)i * o.G + o.c - o.nwg; if (j >= 32) return false; pm = NPAN - 1; pn = (int)j; }
        u.pm = pm; u.pn = pn; u.aux = 0; u.a = A + (size_t)pm * 256 * 2048 * 2; u.b = B + (size_t)pn * 256 * 2048 * 2; return true; }
    __device__ __forceinline__ const int* rows(const Unit&) const { return nullptr; }
};
struct SchedIn8 {
    pg8::TileOrder o; const char* A; const char* B;
    __device__ __forceinline__ bool next(int i, Unit& u) const { int pm, pn; long L;
        if (o.G == 256 && o.nwg == 2048) { if (o.c >= 32) { L = (long)i * 224 + (o.c - 32); if (L >= 2048 - 192) return false; } else { if (i >= 6) return false; L = 2048 - 192 + i * 32 + o.c; } }
        else L = (long)i * o.G + o.c;
        if (!o.tileL(L, pm, pn)) return false;
        u.pm = pm; u.pn = pn; u.aux = 0; u.a = A + (size_t)pm * 256 * 2048; u.b = B + (size_t)pn * 256 * 2048; return true; }
    __device__ __forceinline__ const int* rows(const Unit&) const { return nullptr; }
};
struct EpiGate8 {
    static constexpr bool PERM = true;
    bf16_t* G; const float* bgate;
    __device__ __forceinline__ void operator()(const Acc& acc, const Unit& u, int wr, int wc, int fr, int fq) const {
        const int row0 = u.pm * 256 + wr * 64 + fr, ct = u.pn * 128 + wc * 32 + 8 * fq; constexpr float NS = -LOG2E / (F8_SA * F8_SW);
        float nba[8], nbp[8];
#pragma unroll
        for (int n = 0; n < 2; ++n) { const f32x4 a_ = *(const f32x4*)(bgate + ct + 4 * n), p_ = *(const f32x4*)(bgate + 2048 + ct + 4 * n);
#pragma unroll
            for (int j = 0; j < 4; ++j) { nba[n * 4 + j] = a_[j] * -LOG2E; nbp[n * 4 + j] = p_[j] * -LOG2E; } }
#pragma unroll
        for (int ai = 0; ai < 2; ++ai)
#pragma unroll
            for (int m = 0; m < 4; ++m) { bf16_t* rp = G + (size_t)(row0 + ai * 128 + m * 16) * 4096 + ct;
                float ea[8], ep[8], sp[8];
#pragma unroll
                for (int j = 0; j < 8; ++j) { ea[j] = __builtin_fmaf(acc[ai][0][m][j >> 2][j & 3], NS, nba[j]); ep[j] = __builtin_fmaf(acc[ai][1][m][j >> 2][j & 3], NS, nbp[j]); }
                __builtin_amdgcn_sched_barrier(0);
#pragma unroll
                for (int j = 0; j < 8; ++j) { ea[j] = __builtin_amdgcn_exp2f(ea[j]); ep[j] = __builtin_amdgcn_exp2f(ep[j]); }
                __builtin_amdgcn_sched_barrier(0);
#pragma unroll
                for (int j = 0; j < 8; ++j) { ea[j] += 1.0f; ep[j] += 1.0f; }
                __builtin_amdgcn_sched_barrier(0);
#pragma unroll
                for (int j = 0; j < 8; ++j) { ea[j] = __builtin_amdgcn_rcpf(ea[j]); sp[j] = __builtin_amdgcn_rcpf(ep[j]); }
                __builtin_amdgcn_sched_barrier(0);
#pragma unroll
                for (int j = 0; j < 8; ++j) ea[j] *= ep[j];
                u32x4 w0, w1; w0.x = cvt_pk_bf16(ea[0], ea[1]); w0.y = cvt_pk_bf16(ea[2], ea[3]); w0.z = cvt_pk_bf16(ea[4], ea[5]); w0.w = cvt_pk_bf16(ea[6], ea[7]);
                w1.x = cvt_pk_bf16(sp[0], sp[1]); w1.y = cvt_pk_bf16(sp[2], sp[3]); w1.z = cvt_pk_bf16(sp[4], sp[5]); w1.w = cvt_pk_bf16(sp[6], sp[7]);
                NT_STORE16(rp, w0); NT_STORE16(rp + 2048, w1); }
    }
};

struct SchedWc {
    int G, c; const char* A; const char* B;
    __device__ __forceinline__ bool next(int i, Unit& u) const { const long L = (long)i * G + c; if (L >= 64) return false;
        const int l = (int)L >> 5, g = ((int)L >> 3) & 3, np = (int)L & 7;
        u.pm = l * 8 + np; u.pn = g; u.aux = 0; u.a = A + ((size_t)u.pm * 256 * 1024 + g * 256) * 2; u.b = B + (size_t)(l * 4 + g) * 256 * 256 * 2; return true; }
    __device__ __forceinline__ const int* rows(const Unit&) const { return nullptr; }
};
struct EpiWc {
    static constexpr bool PERM = true;
    bf16_t* D;
    __device__ __forceinline__ void operator()(const Acc& acc, const Unit& u, int wr, int wc, int fr, int fq) const {
        const int row0 = u.pm * 256 + wr * 64 + fr, col0 = u.pn * 256 + wc * 32 + 8 * fq;
#pragma unroll
        for (int ai = 0; ai < 2; ++ai)
#pragma unroll
            for (int m = 0; m < 4; ++m) { bf16_t* rp = D + (size_t)(row0 + ai * 128 + m * 16) * 1024 + col0;
#pragma unroll
                for (int bj = 0; bj < 2; ++bj) { const f32x4 v0 = acc[ai][bj][m][0], v1 = acc[ai][bj][m][1];
                    u32x4 o; o.x = cvt_pk_bf16(v0[0], v0[1]); o.y = cvt_pk_bf16(v0[2], v0[3]); o.z = cvt_pk_bf16(v1[0], v1[1]); o.w = cvt_pk_bf16(v1[2], v1[3]);
                    *(u32x4*)(rp + bj * 128) = o; } }
    }
};

struct EpiY {
    static constexpr bool PERM = true, CHAIN = true;
    bf16_t* Y; const bf16_t* G;
    __device__ __forceinline__ void mid(Acc& acc, const Unit& u, int wr, int wc, int fr, int fq) const {
        const int row0 = u.pm * 256 + wr * 64 + fr, ct = u.pn * 256 + wc * 32 + 8 * fq;
        u32x4 g[2][4][2];
#pragma unroll
        for (int ai = 0; ai < 2; ++ai)
#pragma unroll
            for (int m = 0; m < 4; ++m)
#pragma unroll
                for (int bj = 0; bj < 2; ++bj) g[ai][m][bj] = *(const u32x4*)(G + (size_t)(row0 + ai * 128 + m * 16) * 4096 + ct + bj * 128);
        __builtin_amdgcn_sched_barrier(0);
#pragma unroll
        for (int ai = 0; ai < 2; ++ai)
#pragma unroll
            for (int m = 0; m < 4; ++m)
#pragma unroll
                for (int bj = 0; bj < 2; ++bj) { const u32x4 gg = g[ai][m][bj];
                    f32x4& v0 = acc[ai][bj][m][0]; f32x4& v1 = acc[ai][bj][m][1];
                    v0[0] *= bf_lo(gg.x); v0[1] *= bf_hi(gg.x); v0[2] *= bf_lo(gg.y); v0[3] *= bf_hi(gg.y); v1[0] *= bf_lo(gg.z); v1[1] *= bf_hi(gg.z); v1[2] *= bf_lo(gg.w); v1[3] *= bf_hi(gg.w); }
    }
    __device__ __forceinline__ void operator()(const Acc& acc, const Unit& u, int wr, int wc, int fr, int fq) const {
        const int row0 = u.pm * 256 + wr * 64 + fr, ct = u.pn * 256 + wc * 32 + 8 * fq;
        u32x4 g[2][4][2];
#pragma unroll
        for (int ai = 0; ai < 2; ++ai)
#pragma unroll
            for (int m = 0; m < 4; ++m)
#pragma unroll
                for (int bj = 0; bj < 2; ++bj) g[ai][m][bj] = *(const u32x4*)(G + (size_t)(row0 + ai * 128 + m * 16) * 4096 + 2048 + ct + bj * 128);
        __builtin_amdgcn_sched_barrier(0);
#pragma unroll
        for (int ai = 0; ai < 2; ++ai)
#pragma unroll
            for (int m = 0; m < 4; ++m) { const size_t row = (size_t)(row0 + ai * 128 + m * 16);
#pragma unroll
                for (int bj = 0; bj < 2; ++bj) { const u32x4 gg = g[ai][m][bj];
                    f32x4 v0 = acc[ai][bj][m][0], v1 = acc[ai][bj][m][1];
                    v0[0] *= bf_lo(gg.x); v0[1] *= bf_hi(gg.x); v0[2] *= bf_lo(gg.y); v0[3] *= bf_hi(gg.y); v1[0] *= bf_lo(gg.z); v1[1] *= bf_hi(gg.z); v1[2] *= bf_lo(gg.w); v1[3] *= bf_hi(gg.w);
                    u32x4 w; w.x = cvt_pk_bf16(v0[0], v0[1]); w.y = cvt_pk_bf16(v0[2], v0[3]); w.z = cvt_pk_bf16(v1[0], v1[1]); w.w = cvt_pk_bf16(v1[2], v1[3]);
                    *(u32x4*)(Y + row * 2048 + ct + bj * 128) = w; } }
    }
};
struct SchedY {
    pg8::TileOrder o; const char* A0; const char* A1; const char* B0; const char* B1;
    __device__ __forceinline__ bool next(int i, Unit& u) const { int pm, pn; if (!o.tile(i >> 1, pm, pn)) return false;
        u.pm = pm; u.pn = pn; u.aux = i & 1; u.a = ((i & 1) ? A1 : A0) + (size_t)pm * 256 * 1024 * 2; u.b = ((i & 1) ? B1 : B0) + (size_t)pn * 256 * 1024 * 2; return true; }
    __device__ __forceinline__ const int* rows(const Unit&) const { return nullptr; }
};

struct EpiRes {
    static constexpr bool PERM = false;
    float* HR; float sc;
    __device__ __forceinline__ void operator()(const Acc& acc, const Unit& u, int wr, int wc, int fr, int fq) const {
        const int row0 = u.pm * 256 + wr * 64 + fr, col0 = u.pn * 256 + wc * 32 + 4 * fq;
#pragma unroll
        for (int ai = 0; ai < 2; ++ai)
#pragma unroll
            for (int m = 0; m < 4; ++m) { float* rp = HR + (size_t)(row0 + ai * 128 + m * 16) * 2048 + col0;
#pragma unroll
                for (int bj = 0; bj < 2; ++bj)
#pragma unroll
                    for (int n = 0; n < 2; ++n) { f32x4* p = (f32x4*)(rp + bj * 128 + n * 16); *p = *p + acc[ai][bj][m][n] * sc; } }
    }
};
struct EpiDelta {
    static constexpr bool PERM = true;
    bf16_t* D; float sc;
    __device__ __forceinline__ void operator()(const Acc& acc, const Unit& u, int wr, int wc, int fr, int fq) const {
        const int row0 = u.pm * 256 + wr * 64 + fr, col0 = u.pn * 256 + wc * 32 + 8 * fq;
#pragma unroll
        for (int ai = 0; ai < 2; ++ai)
#pragma unroll
            for (int m = 0; m < 4; ++m) { bf16_t* rp = D + (size_t)(row0 + ai * 128 + m * 16) * 2048 + col0;
#pragma unroll
                for (int bj = 0; bj < 2; ++bj) { const f32x4 v0 = acc[ai][bj][m][0] * sc, v1 = acc[ai][bj][m][1] * sc;
                    u32x4 o; o.x = cvt_pk_bf16(v0[0], v0[1]); o.y = cvt_pk_bf16(v0[2], v0[3]); o.z = cvt_pk_bf16(v1[0], v1[1]); o.w = cvt_pk_bf16(v1[2], v1[3]);
                    NT_STORE16(rp + bj * 128, o); } }
    }
};
struct SchedPlain {
    pg8::TileOrder o; const char* A; const char* B; size_t astep, bstep;
    __device__ __forceinline__ bool next(int i, Unit& u) const { int pm, pn; if (!o.tile(i, pm, pn)) return false;
        u.pm = pm; u.pn = pn; u.aux = 0; u.a = A + (size_t)pm * astep; u.b = B + (size_t)pn * bstep; return true; }
    __device__ __forceinline__ const int* rows(const Unit&) const { return nullptr; }
};

struct EpiSwi {
    static constexpr bool PERM = true;
    bf16_t* HID;
    __device__ __forceinline__ void operator()(const Acc& acc, const Unit& u, int wr, int wc, int fr, int fq) const {
        const int row0 = u.pm * 256 + wr * 64 + fr, ct = u.pn * 128 + wc * 32 + 8 * fq;
#pragma unroll
        for (int ai = 0; ai < 2; ++ai)
#pragma unroll
            for (int m = 0; m < 4; ++m) { f32x4 h0, h1; const f32x4 g0 = acc[ai][0][m][0], g1 = acc[ai][0][m][1], u0 = acc[ai][1][m][0], u1 = acc[ai][1][m][1];
#pragma unroll
                for (int j = 0; j < 4; ++j) { h0[j] = g0[j] * fast_sigmoid(g0[j]) * u0[j]; h1[j] = g1[j] * fast_sigmoid(g1[j]) * u1[j]; }
                u32x4 w; w.x = cvt_pk_bf16(h0[0], h0[1]); w.y = cvt_pk_bf16(h0[2], h0[3]); w.z = cvt_pk_bf16(h1[0], h1[1]); w.w = cvt_pk_bf16(h1[2], h1[3]);
                *(u32x4*)(HID + (size_t)(row0 + ai * 128 + m * 16) * DFF + ct) = w; }
    }
};
struct EpiSwi8 {
    static constexpr bool PERM = true;
    unsigned char* HID8;
    __device__ __forceinline__ void operator()(const Acc& acc, const Unit& u, int wr, int wc, int fr, int fq) const {
        const int row0 = u.pm * 256 + wr * 64 + fr, ct = u.pn * 128 + wc * 32 + 8 * fq;
        constexpr float dq = 1.0f / (F8_SA * F8_SW), C = 1.0f / (dq * dq * F8_SH);
#pragma unroll
        for (int ai = 0; ai < 2; ++ai)
#pragma unroll
            for (int m = 0; m < 4; ++m) { float t[8], p[8];
#pragma unroll
                for (int j = 0; j < 8; ++j) t[j] = acc[ai][0][m][j >> 2][j & 3] * (-LOG2E * dq);
                __builtin_amdgcn_sched_barrier(0);
#pragma unroll
                for (int j = 0; j < 8; ++j) t[j] = __builtin_amdgcn_exp2f(t[j]);
#pragma unroll
                for (int j = 0; j < 8; ++j) p[j] = acc[ai][0][m][j >> 2][j & 3] * acc[ai][1][m][j >> 2][j & 3];
                __builtin_amdgcn_sched_barrier(0);
#pragma unroll
                for (int j = 0; j < 8; ++j) t[j] = __builtin_fmaf(t[j], C, C);
                __builtin_amdgcn_sched_barrier(0);
#pragma unroll
                for (int j = 0; j < 8; ++j) t[j] = __builtin_amdgcn_rcpf(t[j]);
                __builtin_amdgcn_sched_barrier(0);
#pragma unroll
                for (int j = 0; j < 8; ++j) p[j] *= t[j];
                u32x2 w; w.x = cvt4_fp8(p[0], p[1], p[2], p[3]); w.y = cvt4_fp8(p[4], p[5], p[6], p[7]);
                *(u32x2*)(HID8 + (size_t)(row0 + ai * 128 + m * 16) * DFF + ct) = w; }
    }
};
struct MoeMap { int pb[9]; };
__device__ __forceinline__ int moe_expert(const MoeMap& mm, int pm) { int e = 0;
#pragma unroll
    for (int j = 1; j < 8; ++j) e += (pm >= mm.pb[j]) ? 1 : 0;
    return e; }
struct SchedMoeUp {
    pg8::TileOrder o; const char* A; const char* B; MoeMap mm;
    __device__ __forceinline__ bool next(int i, Unit& u) const { int pm, pn; if (!o.tile(i, pm, pn)) return false;
        u.pm = pm; u.pn = pn; u.aux = 0; u.a = A + (size_t)pm * 256 * DM; u.b = B + (size_t)moe_expert(mm, pm) * ((size_t)NHID2 * DM) + (size_t)pn * 256 * DM; return true; }
    __device__ __forceinline__ const int* rows(const Unit&) const { return nullptr; }
};
struct SchedMoeDown {
    pg8::TileOrder o; const char* A; const char* B; MoeMap mm;
    __device__ __forceinline__ bool next(int i, Unit& u) const { int pm, pn; if (!o.tile(i, pm, pn)) return false;
        u.pm = pm; u.pn = pn; u.aux = 0; u.a = A + (size_t)pm * 256 * DFF; u.b = B + (size_t)moe_expert(mm, pm) * ((size_t)DM * DFF) + (size_t)pn * 256 * DFF; return true; }
    __device__ __forceinline__ const int* rows(const Unit&) const { return nullptr; }
};
struct EpiMoeDown {
    static constexpr bool PERM = true;
    bf16_t* O2A; bf16_t* O2B; const int* rowl; const float* roww; float sc;
    __device__ __forceinline__ void operator()(const Acc& acc, const Unit& u, int wr, int wc, int fr, int fq) const {
        const int row0 = u.pm * 256 + wr * 64 + fr, col0 = u.pn * 256 + wc * 32 + 8 * fq;
        int tvs[8]; float wvs[8];
#pragma unroll
        for (int i = 0; i < 8; ++i) { const int sr = row0 + (i >> 2) * 128 + (i & 3) * 16; tvs[i] = rowl[sr]; wvs[i] = roww[sr]; }
        __builtin_amdgcn_sched_barrier(0);
#pragma unroll
        for (int ai = 0; ai < 2; ++ai)
#pragma unroll
            for (int m = 0; m < 4; ++m) { const int tv = tvs[ai * 4 + m]; const int tok = tv & 0x3fffffff; const float w = wvs[ai * 4 + m] * sc;
                if (tv >= 0 && tok < T) { bf16_t* rp = ((tv >> 30) ? O2B : O2A) + (size_t)tok * 2048 + col0;
#pragma unroll
                    for (int bj = 0; bj < 2; ++bj) { const f32x4 v0 = acc[ai][bj][m][0] * w, v1 = acc[ai][bj][m][1] * w;
                        u32x4 o; o.x = cvt_pk_bf16(v0[0], v0[1]); o.y = cvt_pk_bf16(v0[2], v0[3]); o.z = cvt_pk_bf16(v1[0], v1[1]); o.w = cvt_pk_bf16(v1[2], v1[3]);
                        NT_STORE16(rp + bj * 128, o); } } }
    }
};

namespace att {
constexpr int SHM_V = 16384, SHM_K = 8192;
constexpr int OFF_V = 0, OFF_K = 32768, OFF_WS = 49152, OFF_ST = 51200, LDS_BYTES = OFF_ST + 65536;
constexpr int NT = 33;
constexpr float THR2 = 11.5f;
#define SBAR() __builtin_amdgcn_sched_barrier(0)
__device__ __forceinline__ int kswz(int row, int ch) { return row * 128 + ((ch ^ ((row >> 1) & 7)) << 4); }
__device__ __forceinline__ int crow(int r, int hi) { return (r & 3) + 8 * (r >> 2) + 4 * hi; }
__device__ __forceinline__ void partialSM(f32x16& p0, f32x16& p1, float& m_reg, float& alpha) {
    float pmax = p0[0];
#pragma unroll
    for (int r = 1; r < 16; ++r) pmax = fmaxf(pmax, p0[r]);
#pragma unroll
    for (int r = 0; r < 16; ++r) pmax = fmaxf(pmax, p1[r]);
    { auto rr = __builtin_amdgcn_permlane32_swap(__float_as_uint(pmax), __float_as_uint(pmax), false, false); pmax = fmaxf(__uint_as_float(rr[0]), __uint_as_float(rr[1])); }
    float mn;
    if (__builtin_expect(__all(pmax - m_reg <= THR2), 1)) { mn = m_reg; alpha = 1.f; }
    else { mn = fmaxf(m_reg, pmax); alpha = __builtin_amdgcn_exp2f(m_reg - mn); m_reg = mn; }
#pragma unroll
    for (int r = 0; r < 16; ++r) { p0[r] -= mn; p1[r] -= mn; }
#pragma unroll
    for (int r = 0; r < 16; ++r) p0[r] = __builtin_amdgcn_exp2f(p0[r]);
}
__device__ __forceinline__ void finishSM(f32x16& p0, f32x16& p1, float alpha, float& l_reg, bf16x8& pa0, bf16x8& pa1, bf16x8& pa2, bf16x8& pa3) {
#pragma unroll
    for (int r = 0; r < 16; ++r) p1[r] = __builtin_amdgcn_exp2f(p1[r]);
    float ps = 0;
#pragma unroll
    for (int r = 0; r < 16; ++r) ps += p0[r];
#pragma unroll
    for (int r = 0; r < 16; ++r) ps += p1[r];
    { auto rr = __builtin_amdgcn_permlane32_swap(__float_as_uint(ps), __float_as_uint(ps), false, false); ps = __uint_as_float(rr[0]) + __uint_as_float(rr[1]); }
    l_reg = l_reg * alpha + ps;
#define PK4(P, BASE, OUT) do { unsigned a0 = cvt_pk_bf16(P[BASE + 0], P[BASE + 1]), a1 = cvt_pk_bf16(P[BASE + 2], P[BASE + 3]);   \
    unsigned b0 = cvt_pk_bf16(P[BASE + 4], P[BASE + 5]), b1 = cvt_pk_bf16(P[BASE + 6], P[BASE + 7]);                              \
    auto r0 = __builtin_amdgcn_permlane32_swap(a0, b0, false, false); auto r1 = __builtin_amdgcn_permlane32_swap(a1, b1, false, false); \
    u32x4 w = {r0[0], r1[0], r0[1], r1[1]}; OUT = __builtin_bit_cast(bf16x8, w); } while (0)
    PK4(p0, 0, pa0); PK4(p0, 8, pa1); PK4(p1, 0, pa2); PK4(p1, 8, pa3);
#undef PK4
}
__device__ __forceinline__ void exp_first(f32x16& p0, f32x16& p1, float m_reg) {
#pragma unroll
    for (int r = 0; r < 16; ++r) { p0[r] -= m_reg; p1[r] -= m_reg; }
#pragma unroll
    for (int r = 0; r < 16; ++r) p0[r] = __builtin_amdgcn_exp2f(p0[r]);
}
__device__ __forceinline__ float exp_second_sum(f32x16& p0, f32x16& p1) {
#pragma unroll
    for (int r = 0; r < 16; ++r) p1[r] = __builtin_amdgcn_exp2f(p1[r]);
    float ps = 0;
#pragma unroll
    for (int r = 0; r < 16; ++r) ps += p0[r];
#pragma unroll
    for (int r = 0; r < 16; ++r) ps += p1[r];
    { auto rr = __builtin_amdgcn_permlane32_swap(__float_as_uint(ps), __float_as_uint(ps), false, false); ps = __uint_as_float(rr[0]) + __uint_as_float(rr[1]); }
    return ps;
}
__device__ __forceinline__ void pack_p(const f32x16& p0, const f32x16& p1, bf16x8& pa0, bf16x8& pa1, bf16x8& pa2, bf16x8& pa3) {
#define PK4(P, BASE, OUT) do { unsigned a0 = cvt_pk_bf16(P[BASE + 0], P[BASE + 1]), a1 = cvt_pk_bf16(P[BASE + 2], P[BASE + 3]);   \
    unsigned b0 = cvt_pk_bf16(P[BASE + 4], P[BASE + 5]), b1 = cvt_pk_bf16(P[BASE + 6], P[BASE + 7]);                              \
    auto r0 = __builtin_amdgcn_permlane32_swap(a0, b0, false, false); auto r1 = __builtin_amdgcn_permlane32_swap(a1, b1, false, false); \
    u32x4 w = {r0[0], r1[0], r0[1], r1[1]}; OUT = __builtin_bit_cast(bf16x8, w); } while (0)
    PK4(p0, 0, pa0); PK4(p0, 8, pa1); PK4(p1, 0, pa2); PK4(p1, 8, pa3);
#undef PK4
}
__device__ __forceinline__ void qkt(f32x16& p0, f32x16& p1, const LAS unsigned char* Ks, const bf16x8* qr, int r32, int hi) {
    p0 = f32x16{}; p1 = f32x16{};
#pragma unroll
    for (int d0 = 0; d0 < 4; ++d0) {
        const bf16x8 b0 = *(const LAS bf16x8*)(Ks + kswz(r32, d0 * 2 + hi));
        const bf16x8 b1 = *(const LAS bf16x8*)(Ks + kswz(32 + r32, d0 * 2 + hi));
        p0 = __builtin_amdgcn_mfma_f32_32x32x16_bf16(b0, qr[d0], p0, 0, 0, 0);
        p1 = __builtin_amdgcn_mfma_f32_32x32x16_bf16(b1, qr[d0], p1, 0, 0, 0); }
}
__device__ __forceinline__ int v_st(int k, int c) { const int kk = (k & ~0xC) | ((k & 4) << 1) | ((k & 8) >> 1); return ((kk >> 3) * 4 + (c >> 5)) * 512 + ((kk & 7) * 32 + (c & 31)) * 2; }
__device__ __forceinline__ int v_rd_base(int lane) { return ((lane & 3) << 3) | (((lane >> 2) & 3) << 6) | (((lane >> 4) & 1) << 5) | (((lane >> 5) & 1) << 8); }
constexpr int v_rd_off(int d0, int ks, int half) { return d0 * 512 + ks * 4096 + half * 2048; }
template <int OFF> __device__ __forceinline__ s16x4 tr_read(int vb) { s16x4 r; asm volatile("ds_read_b64_tr_b16 %0, %1 offset:%2" : "=&v"(r) : "v"(vb), "i"(OFF) : "memory"); return r; }
template <int D0> __device__ __forceinline__ void pv_one(f32x16& od, int vb, bf16x8 pa0, bf16x8 pa1, bf16x8 pa2, bf16x8 pa3) {
    const s16x4 l0 = tr_read<v_rd_off(D0, 0, 0)>(vb), h0 = tr_read<v_rd_off(D0, 0, 1)>(vb), l1 = tr_read<v_rd_off(D0, 1, 0)>(vb), h1 = tr_read<v_rd_off(D0, 1, 1)>(vb);
    const s16x4 l2 = tr_read<v_rd_off(D0, 2, 0)>(vb), h2 = tr_read<v_rd_off(D0, 2, 1)>(vb), l3 = tr_read<v_rd_off(D0, 3, 0)>(vb), h3 = tr_read<v_rd_off(D0, 3, 1)>(vb);
    asm volatile("s_waitcnt lgkmcnt(0)" ::: "memory"); SBAR();
#define PK(L, H) (bf16x8){L[0], L[1], L[2], L[3], H[0], H[1], H[2], H[3]}
    od = __builtin_amdgcn_mfma_f32_32x32x16_bf16(pa0, PK(l0, h0), od, 0, 0, 0);
    od = __builtin_amdgcn_mfma_f32_32x32x16_bf16(pa1, PK(l1, h1), od, 0, 0, 0);
    od = __builtin_amdgcn_mfma_f32_32x32x16_bf16(pa2, PK(l2, h2), od, 0, 0, 0);
    od = __builtin_amdgcn_mfma_f32_32x32x16_bf16(pa3, PK(l3, h3), od, 0, 0, 0);
#undef PK
}
__device__ __forceinline__ void pv_d0(f32x16* o, int vb, bf16x8 pa0, bf16x8 pa1, bf16x8 pa2, bf16x8 pa3) {
    pv_one<0>(o[0], vb, pa0, pa1, pa2, pa3); pv_one<1>(o[1], vb, pa0, pa1, pa2, pa3); pv_one<2>(o[2], vb, pa0, pa1, pa2, pa3); pv_one<3>(o[3], vb, pa0, pa1, pa2, pa3);
}

__device__ __forceinline__ void attn_pass_exact(const bf16_t* __restrict__ Qb, const bf16_t* __restrict__ Kb, const bf16_t* __restrict__ Vb, int b, int h, int mp, int qrow,
                                          f32x16 (&o)[4], float& l_out, LAS unsigned char* lds) {
    int tid_ = threadIdx.x; asm volatile("" : "+v"(tid_));
    const int tid = tid_, wid = tid >> 6, lane = tid & 63, r32 = lane & 31, hi = lane >> 5;
    LAS unsigned char* V_lds = lds + OFF_V; LAS unsigned char* K_lds = lds + OFF_K;
    LAS float* ws = (LAS float*)(lds + OFF_WS) + wid * 64; LAS float* al_l = ws + 32;
    float m_reg = -1e30f, l_reg = 0.f;
#pragma unroll
    for (int d = 0; d < 4; ++d) o[d] = f32x16{};
    bf16x8 qr[4];
    { const bf16_t* Qw = Qb + (size_t)qrow * 1024 + h * 128 + mp * 64 + hi * 8;
#pragma unroll
      for (int d0 = 0; d0 < 4; ++d0) qr[d0] = *(const bf16x8*)(Qw + d0 * 16); }
    const int sr = tid >> 4, sc = (tid & 15) * 8, vst0 = v_st(sr, sc), vst1 = v_st(32 + sr, sc);
    const int kk = tid >> 3, kch = tid & 7, kst = kswz(kk, kch);
    const int vb0 = (int)(uintptr_t)V_lds + v_rd_base(lane);
    const bf16_t* Kcol = Kb + h * 128 + mp * 64 + kch * 8; const bf16_t* Vcol = Vb + h * 128 + sc;
    const int mrow = TX + b * NMETA, xrow = b * SEQ - 64;
    struct { bf16x8 vs0, vs1, ks; } st_[2];
#define KROW(t, k) ((t) == 0 ? mrow + ((k) & 15) : xrow + (t) * 64 + (k))
#define SLOAD(i, t) do { st_[i].vs0 = *(const bf16x8*)(Vcol + (size_t)KROW(t, sr) * 1024); st_[i].vs1 = *(const bf16x8*)(Vcol + (size_t)KROW(t, 32 + sr) * 1024); \
        st_[i].ks = *(const bf16x8*)(Kcol + (size_t)KROW(t, kk) * 1024); } while (0)
#define SWRITE(bf, i) do { *(LAS bf16x8*)(V_lds + (bf) * SHM_V + vst0) = st_[i].vs0; *(LAS bf16x8*)(V_lds + (bf) * SHM_V + vst1) = st_[i].vs1; \
        *(LAS bf16x8*)(K_lds + (bf) * SHM_K + kst) = st_[i].ks; } while (0)
#define RESC(a) do { if (__any((a) < 1.f)) { if (hi == 0) al_l[r32] = (a); LDS_WAIT(); \
        _Pragma("unroll") for (int d = 0; d < 4; ++d) _Pragma("unroll") for (int r = 0; r < 16; ++r) o[d][r] *= al_l[crow(r, hi)]; } } while (0)
    f32x16 pA0, pA1, pB0, pB1; float alA, alB; bf16x8 pa0, pa1, pa2, pa3;
    constexpr int SE = 0, SO = 1;
    SLOAD(SE, 0); SWRITE(0, SE); __syncthreads();
    qkt(pA0, pA1, K_lds, qr, r32, hi);
#pragma unroll
    for (int r = 8; r < 16; ++r) pA0[r] = -INFINITY;
#pragma unroll
    for (int r = 0; r < 16; ++r) pA1[r] = -INFINITY;
    partialSM(pA0, pA1, m_reg, alA);
    SLOAD(SO, 1); SLOAD(SE, 2);
    SWRITE(1, SO); __syncthreads();
#define HALF_STEP(PN0, PN1, ALN, PP0, PP1, ALP, KBUF, VBUF, LD, LDSLOT, LDT, WR, WRBUF, WRSLOT) do { \
        SBAR(); qkt(PN0, PN1, K_lds + (KBUF) * SHM_K, qr, r32, hi); \
        finishSM(PP0, PP1, ALP, l_reg, pa0, pa1, pa2, pa3); SBAR(); \
        if (LD) { SLOAD(LDSLOT, LDT); } SBAR(); \
        pv_d0(o, vb0 + (VBUF) * SHM_V, pa0, pa1, pa2, pa3); partialSM(PN0, PN1, m_reg, ALN); \
        __syncthreads(); if (WR) { SWRITE(WRBUF, WRSLOT); } \
        RESC(ALN); __syncthreads(); } while (0)
    for (int j = 1; j + 3 < NT; j += 2) {
        HALF_STEP(pB0, pB1, alB, pA0, pA1, alA, 1, 0, true, SO, j + 2, true, 0, SE);
        HALF_STEP(pA0, pA1, alA, pB0, pB1, alB, 0, 1, true, SE, j + 3, true, 1, SO);
    }
    {
        HALF_STEP(pB0, pB1, alB, pA0, pA1, alA, 1, 0, false, SO, 0, true, 0, SE);
        HALF_STEP(pA0, pA1, alA, pB0, pB1, alB, 0, 1, false, SE, 0, false, 1, SO);
    }
    finishSM(pA0, pA1, alA, l_reg, pa0, pa1, pa2, pa3); SBAR();
    pv_d0(o, vb0, pa0, pa1, pa2, pa3);
    l_out = l_reg;
    __syncthreads();
#undef KROW
#undef SLOAD
#undef SWRITE
#undef RESC
#undef HALF_STEP
}

__device__ __forceinline__ bool attn_pass_fast(const bf16_t* __restrict__ Qb, const bf16_t* __restrict__ Kb, const bf16_t* __restrict__ Vb, int b, int h, int mp, int qrow,
                                          f32x16 (&o)[4], float& l_out, LAS unsigned char* lds) {
    int tid_ = threadIdx.x; asm volatile("" : "+v"(tid_));
    const int tid = tid_, wid = tid >> 6, lane = tid & 63, r32 = lane & 31, hi = lane >> 5;
    LAS unsigned char* V_lds = lds + OFF_V; LAS unsigned char* K_lds = lds + OFF_K;
    LAS float* ws = (LAS float*)(lds + OFF_WS) + wid * 64; LAS float* al_l = ws + 32;
    float m_reg = -1e30f, l_reg = 0.f;
#pragma unroll
    for (int d = 0; d < 4; ++d) o[d] = f32x16{};
    bf16x8 qr[4];
    { const bf16_t* Qw = Qb + (size_t)qrow * 1024 + h * 128 + mp * 64 + hi * 8;
#pragma unroll
      for (int d0 = 0; d0 < 4; ++d0) qr[d0] = *(const bf16x8*)(Qw + d0 * 16); }
    const int sr = tid >> 4, sc = (tid & 15) * 8, vst0 = v_st(sr, sc), vst1 = v_st(32 + sr, sc);
    const int kk = tid >> 3, kch = tid & 7, kst = kswz(kk, kch);
    const int vb0 = (int)(uintptr_t)V_lds + v_rd_base(lane);
    const bf16_t* Kcol = Kb + h * 128 + mp * 64 + kch * 8; const bf16_t* Vcol = Vb + h * 128 + sc;
    const int mrow = TX + b * NMETA, xrow = b * SEQ - 64;
    struct { bf16x8 vs0, vs1, ks; } st_[2];
#define KROW(t, k) ((t) == 0 ? mrow + ((k) & 15) : xrow + (t) * 64 + (k))
#define SLOAD(i, t) do { st_[i].vs0 = *(const bf16x8*)(Vcol + (size_t)KROW(t, sr) * 1024); st_[i].vs1 = *(const bf16x8*)(Vcol + (size_t)KROW(t, 32 + sr) * 1024); \
        st_[i].ks = *(const bf16x8*)(Kcol + (size_t)KROW(t, kk) * 1024); } while (0)
#define SWRITE(bf, i) do { *(LAS bf16x8*)(V_lds + (bf) * SHM_V + vst0) = st_[i].vs0; *(LAS bf16x8*)(V_lds + (bf) * SHM_V + vst1) = st_[i].vs1; \
        *(LAS bf16x8*)(K_lds + (bf) * SHM_K + kst) = st_[i].ks; } while (0)
#define RESC(a) do { if (__any((a) < 1.f)) { if (hi == 0) al_l[r32] = (a); LDS_WAIT(); \
        _Pragma("unroll") for (int d = 0; d < 4; ++d) _Pragma("unroll") for (int r = 0; r < 16; ++r) o[d][r] *= al_l[crow(r, hi)]; } } while (0)
    f32x16 pA0, pA1, pB0, pB1; float alA; bf16x8 pa0, pa1, pa2, pa3;
    constexpr int SE = 0, SO = 1;
    SLOAD(SE, 0); SLOAD(SO, 1); SWRITE(0, SE); SLOAD(SE, 2); __syncthreads();
    qkt(pA0, pA1, K_lds, qr, r32, hi);
#pragma unroll
    for (int r = 8; r < 16; ++r) pA0[r] = -INFINITY;
#pragma unroll
    for (int r = 0; r < 16; ++r) pA1[r] = -INFINITY;
    partialSM(pA0, pA1, m_reg, alA);
    SWRITE(1, SO); __syncthreads();
#define HALF_STEP(PN0, PN1, PP0, PP1, KBUF, VBUF, LD, LDSLOT, LDT, WR, WRBUF, WRSLOT, TILE0) do { \
        SBAR(); qkt(PN0, PN1, K_lds + (KBUF) * SHM_K, qr, r32, hi); \
        float ps_ = exp_second_sum(PP0, PP1); \
        l_reg += ps_; pack_p(PP0, PP1, pa0, pa1, pa2, pa3); SBAR(); \
        if (LD) { SLOAD(LDSLOT, LDT); } SBAR(); \
        pv_d0(o, vb0 + (VBUF) * SHM_V, pa0, pa1, pa2, pa3); exp_first(PN0, PN1, m_reg); \
        __syncthreads(); if (WR) { SWRITE(WRBUF, WRSLOT); } \
        __syncthreads(); } while (0)
    for (int j = 1; j + 3 < NT; j += 2) {
        HALF_STEP(pB0, pB1, pA0, pA1, 1, 0, true, SO, j + 2, true, 0, SE, false);
        HALF_STEP(pA0, pA1, pB0, pB1, 0, 1, true, SE, j + 3, true, 1, SO, false);
    }
    {
        HALF_STEP(pB0, pB1, pA0, pA1, 1, 0, false, SO, 0, true, 0, SE, false);
        HALF_STEP(pA0, pA1, pB0, pB1, 0, 1, false, SE, 0, false, 1, SO, false);
    }
    { float ps_ = exp_second_sum(pA0, pA1);
      l_reg += ps_; pack_p(pA0, pA1, pa0, pa1, pa2, pa3); SBAR(); }
    pv_d0(o, vb0, pa0, pa1, pa2, pa3);
    l_out = l_reg;
    if (lane == 0) al_l[0] = __any(!(l_reg <= 1.1529215e18f)) ? 1.0f : 0.0f;
    LDS_WAIT();
    __syncthreads();
    float bad_ = 0.f;
#pragma unroll
    for (int w = 0; w < 8; ++w) bad_ += ((const LAS float*)(lds + OFF_WS))[w * 64 + 32];
    const bool redo = bad_ != 0.f;
#undef KROW
#undef SLOAD
#undef SWRITE
#undef RESC
#undef HALF_STEP
    return redo;
}

struct AttnArgs { const bf16_t* Q; const bf16_t* K; const bf16_t* V; bf16_t* A; const float* subln; float lam, oml; };

__device__ __forceinline__ void attn_unit(const AttnArgs& P, int b, int h, int qb  , LAS unsigned char* lds) {
    int tid_ = threadIdx.x; asm volatile("" : "+v"(tid_));
    const int tid = tid_, wid = tid >> 6, lane = tid & 63, r32 = lane & 31, hi = lane >> 5;
    const bool meta = qb == 8;
    const int qrow = meta ? TX + b * NMETA + (r32 & 15) : b * SEQ + qb * 256 + wid * 32 + r32;
    LAS float* ws = (LAS float*)(lds + OFF_WS) + wid * 64;
    unsigned stb = (unsigned)(uintptr_t)(lds + OFF_ST) + (unsigned)tid * 4u; asm volatile("" : "+v"(stb));
    f32x16 o[4]; float l_reg;
    if (attn_pass_fast(P.Q, P.K, P.V, b, h, 0, qrow, o, l_reg, lds)) attn_pass_exact(P.Q, P.K, P.V, b, h, 0, qrow, o, l_reg, lds);
    if (hi == 0) ws[r32] = l_reg; LDS_WAIT();
    {
#pragma unroll
        for (int r = 0; r < 16; ++r) { const float rl = __builtin_amdgcn_rcpf(ws[crow(r, hi)]);
            *(LAS unsigned*)(stb + (r * 2 + 0) * 2048) = cvt_pk_bf16(o[0][r] * rl, o[1][r] * rl); *(LAS unsigned*)(stb + (r * 2 + 1) * 2048) = cvt_pk_bf16(o[2][r] * rl, o[3][r] * rl); }
    }
    LDS_WAIT();
    if (attn_pass_fast(P.Q, P.K, P.V, b, h, 1, qrow, o, l_reg, lds)) attn_pass_exact(P.Q, P.K, P.V, b, h, 1, qrow, o, l_reg, lds);
    if (hi == 0) ws[r32] = l_reg; LDS_WAIT();
    float ss[16];
#pragma unroll
    for (int r = 0; r < 16; ++r) { const float rl = __builtin_amdgcn_rcpf(ws[crow(r, hi)]) * P.lam;
        const unsigned s0 = *(LAS unsigned*)(stb + (r * 2 + 0) * 2048), s1 = *(LAS unsigned*)(stb + (r * 2 + 1) * 2048);
        o[0][r] = bf_lo(s0) - o[0][r] * rl; o[1][r] = bf_hi(s0) - o[1][r] * rl; o[2][r] = bf_lo(s1) - o[2][r] * rl; o[3][r] = bf_hi(s1) - o[3][r] * rl;
        ss[r] = (o[0][r] * o[0][r] + o[1][r] * o[1][r]) + (o[2][r] * o[2][r] + o[3][r] * o[3][r]); }
#pragma unroll
    for (int r = 0; r < 16; ++r) {
#pragma unroll
        for (int s = 1; s < 32; s <<= 1) ss[r] += shfl_xor_l(ss[r], s, lane);
        ss[r] = __builtin_amdgcn_rsqf(ss[r] * (1.0f / 128.0f) + EPS) * P.oml; }
    float gsub[4];
#pragma unroll
    for (int d = 0; d < 4; ++d) gsub[d] = P.subln[d * 32 + r32];
    const bool wst = !meta || wid == 0;
#pragma unroll
    for (int r = 0; r < 16; ++r) { const int rr = crow(r, hi);
        if (wst && (!meta || rr < 16)) { const int orow = meta ? TX + b * NMETA + rr : b * SEQ + qb * 256 + wid * 32 + rr;
            bf16_t* op = P.A + (size_t)orow * 1024 + h * 128 + r32;
#pragma unroll
            for (int d = 0; d < 4; ++d) op[d * 32] = (bf16_t)(cvt_pk_bf16(o[d][r] * ss[r] * gsub[d], 0.f) & 0xffffu); } }
    LDS_WAIT(); __syncthreads();
}
#undef SBAR
}

#define XB_TMO      128
#define XB_XCNT(j)  (256  + 64 * (j))
#define XB_XSUB(j)  (1280 + 64 * (j))
#define XB_XGEN(j)  (2304 + 64 * (j))
#define XB_TOP      3328
#define XB_TOPGEN   3392
#define XCD_BAR_WORDS 3456
#define XB_SPIN_CAP (1u << 22)
__device__ __forceinline__ unsigned xb_ld(unsigned* p)              { return __hip_atomic_load(p, __ATOMIC_RELAXED, __HIP_MEMORY_SCOPE_AGENT); }
__device__ __forceinline__ unsigned xb_add(unsigned* p, unsigned v) { return __hip_atomic_fetch_add(p, v, __ATOMIC_RELAXED, __HIP_MEMORY_SCOPE_AGENT); }
__device__ __forceinline__ unsigned xb_xcc_id() { return (unsigned)__builtin_amdgcn_s_getreg((3 << 11) | 20) & 0xFu; }
#define XB_SPIN(cond, bar) do { unsigned _sp = 0; while (cond) { __builtin_amdgcn_s_sleep(1); \
    if ((++_sp & 255u) == 0u) { if (xb_ld(&(bar)[XB_TMO])) break; if (_sp > XB_SPIN_CAP) { atomicAdd(&(bar)[XB_TMO], 1u); break; } } } } while (0)
struct XcdBarrier { unsigned* bar; unsigned x; volatile LAS unsigned* st; };
__device__ __forceinline__ XcdBarrier xcd_barrier_post(unsigned* bar, volatile LAS unsigned* st) {
    XcdBarrier b; b.bar = bar; b.x = xb_xcc_id(); b.st = st;
    if (threadIdx.x == 0) (void)xb_add(&bar[XB_XCNT(b.x)], 1u);
    return b;
}
__device__ __forceinline__ void xcd_barrier_complete(unsigned* bar, unsigned x, unsigned& nloc, unsigned& nx) {
    const unsigned G = gridDim.x * gridDim.y * gridDim.z;
    unsigned sum, cnt, mine, sp = 0u;
    for (;;) {
        sum = 0u; cnt = 0u; mine = 0u;
#pragma unroll
        for (unsigned j = 0; j < 16; ++j) { const unsigned c = xb_ld(&bar[XB_XCNT(j)]); sum += c; cnt += (c > 0u) ? 1u : 0u; mine = (j == x) ? c : mine; }
        if (sum == G) break;
        __builtin_amdgcn_s_sleep(1);
        if ((++sp & 255u) == 0u) { if (xb_ld(&bar[XB_TMO])) break; if (sp > XB_SPIN_CAP) { atomicAdd(&bar[XB_TMO], 1u); break; } }
    }
    nloc = mine > 0u ? mine : 1u; nx = cnt > 0u ? cnt : 1u;
}
__device__ __forceinline__ void xcd_barrier(const XcdBarrier& b) {
    asm volatile("s_waitcnt vmcnt(0)" ::: "memory");
    __syncthreads();
    if (threadIdx.x == 0) {
        unsigned* bar = b.bar;
        __builtin_amdgcn_s_waitcnt(0);
        unsigned nloc = b.st[0], nx = b.st[1];
        if (nloc == 0u) { xcd_barrier_complete(bar, b.x, nloc, nx); b.st[0] = nloc; b.st[1] = nx; }
        const unsigned old = xb_add(&bar[XB_XSUB(b.x)], 1u);
        const unsigned gen = old / nloc;
        if (old + 1u == (gen + 1u) * nloc) {
            __builtin_amdgcn_fence(__ATOMIC_RELEASE, "agent");
            asm volatile("s_waitcnt vmcnt(0)" ::: "memory");
            const unsigned og = xb_add(&bar[XB_TOP], 1u);
            const unsigned tg = og / nx;
            if (og + 1u == (tg + 1u) * nx) xb_add(&bar[XB_TOPGEN], 1u);
            else XB_SPIN(xb_ld(&bar[XB_TOPGEN]) == tg, bar);
            __builtin_amdgcn_fence(__ATOMIC_ACQUIRE, "agent");
            xb_add(&bar[XB_XGEN(b.x)], 1u);
            asm volatile("s_waitcnt vmcnt(0)" ::: "memory");
        } else {
            XB_SPIN(xb_ld(&bar[XB_XGEN(b.x)]) == gen, bar);
            __builtin_amdgcn_fence(__ATOMIC_ACQUIRE, "agent");
            asm volatile("s_waitcnt vmcnt(0)" ::: "memory");
        }
    }
    __syncthreads();
}

constexpr int RING_BYTES = 131072, LDSCTL_OFF = RING_BYTES, LDS_BYTES = 147456;
static_assert(att::LDS_BYTES <= RING_BYTES, "attention scratch inside the ring region");
constexpr int NPHASE = 18;

struct Args { const float* in[24]; float* out; unsigned char* ws; int ph_lo, ph_hi; };

template <int MODE> __device__ __forceinline__ int rowmap(int n) {
    if (MODE == 1) return (n >> 7) * 256 + (n & 127);
    if (MODE == 2) return (n >> 7) * 256 + 128 + (n & 127);
    if (MODE == 3) { if (n < 2048) { const int tile = n >> 8, hh = (n >> 6) & 3, bj = (n >> 5) & 1, i = n & 31; return tile * 256 + bj * 128 + hh * 32 + i; }
                     if (n >= 4096) { const int pool = n >= 6144 ? 1 : 0, c = n - 4096 - pool * 2048; return 4096 + (c >> 7) * 256 + pool * 128 + (c & 127); }
                     return n; }
    return n;
}
template <int MODE> __device__ __forceinline__ void transpose_item(const float* __restrict__ W, int K, int N, bf16_t* __restrict__ WT, LAS float* scr, int item, int lane, unsigned char* __restrict__ W8 = nullptr) {
    const int nblk = N / 32, kb = item / nblk, nb = item % nblk, k0 = 64 * kb, n0 = 32 * nb;
#pragma unroll 8
    for (int i = 0; i < 32; ++i) { const int kk = 2 * i + (lane >> 5); scr[kk * 33 + (lane & 31)] = W[(size_t)(k0 + kk) * N + n0 + (lane & 31)]; }
    LDS_WAIT(); asm volatile("" ::: "memory");
    const int c = lane & 7;
#pragma unroll
    for (int j = 0; j < 4; ++j) { const int n = (lane >> 3) + 8 * j; const LAS float* s = scr + (8 * c) * 33 + n;
        u32x4 o; o.x = cvt_pk_bf16(s[0 * 33], s[1 * 33]); o.y = cvt_pk_bf16(s[2 * 33], s[3 * 33]); o.z = cvt_pk_bf16(s[4 * 33], s[5 * 33]); o.w = cvt_pk_bf16(s[6 * 33], s[7 * 33]);
        *(u32x4*)(WT + (size_t)rowmap<MODE>(n0 + n) * K + k0 + 8 * c) = o;
        if (MODE == 3 && n0 >= 4096) {
            u32x2 o8; o8.x = cvt4_fp8(s[0 * 33] * F8_SW, s[1 * 33] * F8_SW, s[2 * 33] * F8_SW, s[3 * 33] * F8_SW); o8.y = cvt4_fp8(s[4 * 33] * F8_SW, s[5 * 33] * F8_SW, s[6 * 33] * F8_SW, s[7 * 33] * F8_SW);
            *(u32x2*)(W8 + (size_t)(rowmap<MODE>(n0 + n) - 4096) * K + k0 + 8 * c) = o8; } }
    LDS_WAIT(); asm volatile("" ::: "memory");
}

template <int MODE> __device__ __forceinline__ void transpose_item_f8(const float* __restrict__ W, int K, int N, unsigned char* __restrict__ WT, LAS float* scr, int item, int lane, float scale) {
    const int nblk = N / 32, kb = item / nblk, nb = item % nblk, k0 = 64 * kb, n0 = 32 * nb;
#pragma unroll 8
    for (int i = 0; i < 32; ++i) { const int kk = 2 * i + (lane >> 5); scr[kk * 33 + (lane & 31)] = W[(size_t)(k0 + kk) * N + n0 + (lane & 31)] * scale; }
    LDS_WAIT(); asm volatile("" ::: "memory");
    const int c = lane & 7;
#pragma unroll
    for (int j = 0; j < 4; ++j) { const int n = (lane >> 3) + 8 * j; const LAS float* s = scr + (8 * c) * 33 + n;
        u32x2 o; o.x = cvt4_fp8(s[0 * 33], s[1 * 33], s[2 * 33], s[3 * 33]); o.y = cvt4_fp8(s[4 * 33], s[5 * 33], s[6 * 33], s[7 * 33]);
        *(u32x2*)(WT + (size_t)rowmap<MODE>(n0 + n) * K + k0 + 8 * c) = o; }
    LDS_WAIT(); asm volatile("" ::: "memory");
}

__device__ __forceinline__ float half_sum(float v, int lane) {
#pragma unroll
    for (int o = 1; o < 32; o <<= 1) v += shfl_xor_l(v, o, lane);
    return v;
}
template <bool HAS0, bool HAS1, bool SRC16 = false, bool OUT16 = false, bool PRELOADED = false>
__device__ __forceinline__ void norm_row2(const void* src, void* hres_out, const float* __restrict__ gain, bf16_t* hout, int lane, bool valid, f32x4 (&v)[16], float& rstd,
                                          const bf16_t* add0 = nullptr, const bf16_t* add1 = nullptr) {
    const int l32 = lane & 31; const f32x4* xr = (const f32x4*)src + l32; float s = 0.f; u32x2 a_[16], b_[16], s_[16];
#pragma unroll
    for (int j = 0; j < 16; ++j) { if (SRC16) s_[j] = ((const u32x2*)src)[l32 + 32 * j]; else if (!PRELOADED) v[j] = xr[32 * j]; if (HAS0) a_[j] = ((const u32x2*)add0)[l32 + 32 * j]; if (HAS1) b_[j] = ((const u32x2*)add1)[l32 + 32 * j]; }
#pragma unroll
    for (int j = 0; j < 16; ++j) {
        if (SRC16) { const u32x2 q = s_[j]; v[j].x = bf_lo(q.x); v[j].y = bf_hi(q.x); v[j].z = bf_lo(q.y); v[j].w = bf_hi(q.y); }
        if (HAS0) { const u32x2 a = a_[j]; v[j].x += bf_lo(a.x); v[j].y += bf_hi(a.x); v[j].z += bf_lo(a.y); v[j].w += bf_hi(a.y); }
        if (HAS1) { const u32x2 b = b_[j]; v[j].x += bf_lo(b.x); v[j].y += bf_hi(b.x); v[j].z += bf_lo(b.y); v[j].w += bf_hi(b.y); }
        s += (v[j].x * v[j].x + v[j].y * v[j].y) + (v[j].z * v[j].z + v[j].w * v[j].w); }
    if (hres_out && valid) {
        if (OUT16) { u32x2* hr = (u32x2*)hres_out + l32;
#pragma unroll
            for (int j = 0; j < 16; ++j) { u32x2 w; w.x = cvt_pk_bf16(v[j].x, v[j].y); w.y = cvt_pk_bf16(v[j].z, v[j].w); hr[32 * j] = w; } }
        else { f32x4* hr = (f32x4*)hres_out + l32;
#pragma unroll
            for (int j = 0; j < 16; ++j) hr[32 * j] = v[j]; } }
    rstd = __builtin_amdgcn_rsqf(half_sum(s, lane) * (1.0f / DM) + EPS);
    const f32x4* gr = (const f32x4*)gain + l32;
#pragma unroll
    for (int j = 0; j < 16; ++j) { const f32x4 g = gr[32 * j]; v[j] = v[j] * rstd * g; }
    if (hout && valid) { u32x2* o8 = (u32x2*)hout + l32;
#pragma unroll
        for (int j = 0; j < 16; ++j) { u32x2 w; w.x = cvt_pk_bf16(v[j].x, v[j].y); w.y = cvt_pk_bf16(v[j].z, v[j].w); o8[32 * j] = w; } }
}

__global__ void __launch_bounds__(NWAVES * 64, 2) fwd_kernel(Args args) {
    extern __shared__ __attribute__((aligned(16))) unsigned char lds_raw[];
    LAS unsigned char* lds = (LAS unsigned char*)lds_raw;
    const int tid = threadIdx.x, lane = tid & 63, wave = __builtin_amdgcn_readfirstlane(tid >> 6);
    const int G = gridDim.x; const int bx = blockIdx.x; const int vcu = (G % 8 == 0) ? (bx % 8) * (G / 8) + bx / 8 : bx;
    unsigned* ctl = (unsigned*)(GAS unsigned*)(args.ws + WS_CTL);
    volatile LAS unsigned* MISC = (volatile LAS unsigned*)(lds + LDSCTL_OFF);
    for (int u = tid; u < (LDS_BYTES - LDSCTL_OFF) / 4; u += NWAVES * 64) ((LAS unsigned*)(lds + LDSCTL_OFF))[u] = 0u;
    __syncthreads();
    const int lo = args.ph_lo, hi = args.ph_hi; (void)lo;
    XcdBarrier bar; bar.bar = ctl + CW_BAR; bar.x = 0; bar.st = nullptr;
    if (hi - lo > 1) bar = xcd_barrier_post(ctl + CW_BAR, MISC + 8);
#if MK_ONE_LAUNCH && MK_PROBE_BUF == 0 && MK_LAST_PHASE == 17
#define IN(k) ((k) < NPHASE)
#define SEAM(k) do { if ((k) + 1 < NPHASE) xcd_barrier(bar); } while (0)
#else
#ifdef ONLY_MASK
#define IN(k) (((ONLY_MASK >> (k)) & 1) != 0 && lo <= (k) && (k) < hi)
#else
#define IN(k) (lo <= (k) && (k) < hi)
#endif
#define SEAM(k) do { if ((k) + 1 < hi) xcd_barrier(bar); } while (0)
#endif
#define PHASE_LOCALS int tidp = threadIdx.x; asm volatile("" : "+v"(tidp)); const int lanep = tidp & 63; GAS unsigned char* wsg_ = (GAS unsigned char*)args.ws; asm volatile("" : "+s"(wsg_)); unsigned char* wsp = (unsigned char*)wsg_; int Gp = gridDim.x; asm volatile("" : "+s"(Gp)); const int NGW = Gp * NWAVES, NGT = Gp * NWAVES * 64; (void)NGT; (void)NGW
    const int gw = vcu * NWAVES + wave;

    const float* x = (const float*)(const GAS float*)args.in[0]; const float* meta_tok = (const float*)(const GAS float*)args.in[1]; const float* norm_mix = (const float*)(const GAS float*)args.in[2]; const float* w_in = (const float*)(const GAS float*)args.in[3]; const float* b_gate = (const float*)(const GAS float*)args.in[4];
    const float* lam_q1 = (const float*)(const GAS float*)args.in[5]; const float* lam_k1 = (const float*)(const GAS float*)args.in[6]; const float* lam_q2 = (const float*)(const GAS float*)args.in[7]; const float* lam_k2 = (const float*)(const GAS float*)args.in[8]; const float* subln = (const float*)(const GAS float*)args.in[9];
    const float* pool_w = (const float*)(const GAS float*)args.in[10]; const float* pool_scale = (const float*)(const GAS float*)args.in[11]; const float* w_ba = (const float*)(const GAS float*)args.in[12]; const float* w_bp = (const float*)(const GAS float*)args.in[13]; const float* w_out = (const float*)(const GAS float*)args.in[14];
    const float* norm_ffn = (const float*)(const GAS float*)args.in[15]; const float* d_wg = (const float*)(const GAS float*)args.in[16]; const float* d_wu = (const float*)(const GAS float*)args.in[17]; const float* d_wd = (const float*)(const GAS float*)args.in[18]; const float* router = (const float*)(const GAS float*)args.in[19];
    const float* m_wg = (const float*)(const GAS float*)args.in[20]; const float* m_wu = (const float*)(const GAS float*)args.in[21]; const float* m_wd = (const float*)(const GAS float*)args.in[22]; const float* norm_final = (const float*)(const GAS float*)args.in[23];
#define ROPE ((float*)(wsp + WS_ROPE))
#define TOKE ((int*)(wsp + WS_TOKE))
#define TOKS ((int*)(wsp + WS_TOKS))
#define TOKW ((float*)(wsp + WS_TOKW))
#define ROWL ((int*)(wsp + WS_ROWL))
#define ROWW ((float*)(wsp + WS_ROWW))
#define WIN ((bf16_t*)(wsp + WS_WIN))
#define WBA ((bf16_t*)(wsp + WS_WBA))
#define WC ((bf16_t*)(wsp + WS_WC))
#define WOUT ((bf16_t*)(wsp + WS_WOUT))
#define DWGU ((bf16_t*)(wsp + WS_DWGU))
#define DWD ((bf16_t*)(wsp + WS_DWD))
#define MWGU ((bf16_t*)(wsp + WS_MWGU))
#define MWD ((bf16_t*)(wsp + WS_MWD))
#define HRES ((float*)(wsp + WS_HRES))
#define HRES16 ((bf16_t*)(wsp + WS_HRES))
#define WBPT ((bf16_t*)(wsp + WS_HRES + 130 * MiB))
#define PB ((bf16_t*)(wsp + WS_HRES + 138 * MiB))
#define H ((bf16_t*)(wsp + WS_H))
#define MB ((bf16_t*)(wsp + WS_H))
#define QB ((bf16_t*)(wsp + WS_Q))
#define KB ((bf16_t*)(wsp + WS_K))
#define VB ((bf16_t*)(wsp + WS_V))
#define UB ((bf16_t*)(wsp + WS_U))
#define GB ((bf16_t*)(wsp + WS_G))
#define YB ((bf16_t*)(wsp + WS_Y))
#define HID ((bf16_t*)(wsp + WS_HID))
#define CNT ((unsigned*)(wsp + WS_CTL) + CW_CNT)
#define H8P ((unsigned char*)(GAS unsigned char*)args.out)
#define WIN8G ((unsigned char*)(GAS unsigned char*)args.out + (size_t)T * DM)

    if (IN(0)) { PHASE_LOCALS;
#pragma unroll 1
      for (int rep0 = 0; rep0 < MK_REP_P0; ++rep0) {
        LAS float* scr = (LAS float*)(lds + wave * 16384);
        constexpr int I_FF = (DM / 64) * (DFF / 32);
        constexpr int I_MOE = NE * 3 * I_FF, I_DENSE = 3 * I_FF;
        constexpr int I_WIN = (DM / 64) * (INC / 32), I_WBA = (AW / 64) * (DM / 32), I_WOUT = (DM / 64) * (DM / 32), I_LAYER = I_WIN + I_WBA + I_WOUT;
        constexpr int NITEMS = I_MOE + I_DENSE + 2 * I_LAYER;
        for (int it = gw; it < NITEMS; it += NGW) {
            int r = it;
            if (r < I_MOE) { const int e = r / (3 * I_FF), q = r % (3 * I_FF), which = q / I_FF, item = q % I_FF;
                if (which == 0) transpose_item_f8<1>(m_wg + (size_t)e * DM * DFF, DM, DFF, (unsigned char*)MWGU + (size_t)e * NHID2 * DM, scr, item, lanep, F8_SW);
                else if (which == 1) transpose_item_f8<2>(m_wu + (size_t)e * DM * DFF, DM, DFF, (unsigned char*)MWGU + (size_t)e * NHID2 * DM, scr, item, lanep, F8_SW);
                else transpose_item_f8<0>(m_wd + (size_t)e * DFF * DM, DFF, DM, (unsigned char*)MWD + (size_t)e * DM * DFF, scr, item, lanep, F8_SW);
                continue; }
            r -= I_MOE;
            if (r < I_DENSE) { const int which = r / I_FF, item = r % I_FF;
                if (MK_F8_DENSE) {
                if (which == 0) transpose_item_f8<1>(d_wg, DM, DFF, (unsigned char*)DWGU, scr, item, lanep, F8_SW);
                else if (which == 1) transpose_item_f8<2>(d_wu, DM, DFF, (unsigned char*)DWGU, scr, item, lanep, F8_SW);
                else transpose_item_f8<0>(d_wd, DFF, DM, (unsigned char*)DWD, scr, item, lanep, F8_SW);
                } else {
                if (which == 0) transpose_item<1>(d_wg, DM, DFF, DWGU, scr, item, lanep);
                else if (which == 1) transpose_item<2>(d_wu, DM, DFF, DWGU, scr, item, lanep);
                else transpose_item<0>(d_wd, DFF, DM, DWD, scr, item, lanep); }
                continue; }
            r -= I_DENSE;
            const int l = r / I_LAYER; r = r % I_LAYER;
            if (r < I_WIN) { transpose_item<3>(w_in + (size_t)l * DM * INC, DM, INC, WIN + (size_t)l * INC * DM, scr, r, lanep, WIN8G + (size_t)l * 4096 * DM); continue; }
            r -= I_WIN;
            if (r < I_WBA) { transpose_item<0>(w_ba + (size_t)l * AW * DM, AW, DM, WBA + (size_t)l * DM * AW, scr, r, lanep); continue; }
            r -= I_WBA;
            transpose_item<0>(w_out + (size_t)l * DM * DM, DM, DM, WOUT + (size_t)l * DM * DM, scr, r, lanep);
        }
        for (int it = gw; it < 2 * 1024; it += NGW) { const int l = it >> 10;
            transpose_item<0>(w_bp + (size_t)l * 1024 * DM, 1024, DM, WBPT + (size_t)l * DM * 1024, scr, it & 1023, lanep); }
        for (int idx = (vcu * NWAVES * 64) + tidp; idx < 2 * 4 * 256 * 32; idx += NGT) { const int e8 = (idx & 31) * 8, lgc = idx >> 5, lg = lgc >> 8;
            const f32x4 p0 = *(const f32x4*)(pool_w + (size_t)lgc * 256 + e8), p1 = *(const f32x4*)(pool_w + (size_t)lgc * 256 + e8 + 4);
            const f32x4 s0 = *(const f32x4*)(pool_scale + lg * 256 + e8), s1 = *(const f32x4*)(pool_scale + lg * 256 + e8 + 4);
            u32x4 o; o.x = cvt_pk_bf16(p0.x * s0.x, p0.y * s0.y); o.y = cvt_pk_bf16(p0.z * s0.z, p0.w * s0.w); o.z = cvt_pk_bf16(p1.x * s1.x, p1.y * s1.y); o.w = cvt_pk_bf16(p1.z * s1.z, p1.w * s1.w);
            *(u32x4*)(PB + (size_t)lgc * 256 + e8) = o; }
        for (int idx = (vcu * NWAVES * 64) + tidp; idx < LTOK * 32; idx += NGT) { const int pos = idx >> 5, i = idx & 31;
            const float inv = __builtin_amdgcn_exp2f((float)(-i) * 0.41524101186092029f); const float ang = (float)pos * inv;
            double rev = (double)ang * 0.15915494309189535; rev -= floor(rev);
            ROPE[pos * 64 + i] = __builtin_amdgcn_cosf((float)rev); ROPE[pos * 64 + 32 + i] = __builtin_amdgcn_sinf((float)rev); }
#define EMB_ROW(r) ((r) < TX ? x + (size_t)(r) * DM : meta_tok + (size_t)(((r) - TX) & (NMETA - 1)) * DM)
        for (int r0 = gw; r0 < T; r0 += 2 * NGW) { const int rr = r0 + (lanep >> 5) * NGW; const bool valid = rr < T; const int r = valid ? rr : r0;
            f32x4 v[16]; float rstd; norm_row2<false, false>(EMB_ROW(r), nullptr, norm_mix, H + (size_t)r * DM, lanep, valid, v, rstd);
            if (valid && r < TX) { unsigned* o4 = (unsigned*)(H8P + (size_t)r * DM) + (lanep & 31);
#pragma unroll
                for (int j = 0; j < 16; ++j) o4[32 * j] = cvt4_fp8(v[j].x * F8_SA, v[j].y * F8_SA, v[j].z * F8_SA, v[j].w * F8_SA); } }
        SEAM(0);
      }
    }

#pragma unroll 1
    for (int layer = 0; layer < 2; ++layer) {
        const int pb = 1 + 8 * layer;
        if (IN(pb + 0)) { PHASE_LOCALS;
            { SchedInA S; S.o.init(NPAN - 1, 16, Gp, bx); S.A = (const char*)H; S.B = (const char*)(WIN + (size_t)layer * INC * DM);
              EpiIn E{QB, KB, VB, UB, GB, b_gate + layer * 4096, ROPE};
              pg8::gemm_phase<EpiIn, SchedInA, false>(lds, DM / 64, DM * 2, DM * 2, S, E); }
            { SchedIn8 S; S.o.init(NPAN - 1, 16, Gp, bx); S.A = (const char*)H8P; S.B = (const char*)(WIN8G + (size_t)layer * 4096 * DM);
              EpiGate8 E{GB, b_gate + layer * 4096};
              pg8::gemm_phase<EpiGate8, SchedIn8, false, true>(lds, DM / 128, DM, DM, S, E); }
            if (layer == 0) { SchedWc S{Gp, bx, (const char*)WBPT, (const char*)PB}; EpiWc E{WC};
              int ntw = 256 / 64; asm volatile("" : "+s"(ntw));
              pg8::gemm_phase<EpiWc, SchedWc, false>(lds, ntw, 1024 * 2, 256 * 2, S, E); }
            SEAM(pb + 0);
        }
        if (IN(pb + 1)) { PHASE_LOCALS;
            const bool split = layer == 0 && (Gp & 1) == 0 && Gp >= 256;
            const int gw_m = split ? (vcu >= Gp / 2 ? (vcu - Gp / 2) * NWAVES + wave : (layer == 0 ? T : TX)) : gw, ngw_m = split ? NGW / 2 : NGW;
#pragma unroll 1
            for (int repm = 0; repm < MK_REP_M; ++repm)
            for (int r = gw_m; r < (layer == 0 ? T : TX); r += ngw_m) { const int b = row_batch(r), pos = row_pos(r), g = lanep >> 4, half = 1 << g;
                const int wlo = max(pos - half, 0), whi = min(pos + half, LTOK);
                float s[16];
#pragma unroll
                for (int q = 0; q < 16; ++q) s[q] = 0.f;
                u32x4 wa[16], wc_[16];
#pragma unroll
                for (int jj = 0; jj < 16; ++jj) { const int j = pos - 8 + jj; const int jc = min(max(j, 0), LTOK - 1);
                    const u32x4* up = (const u32x4*)(UB + (size_t)row_of(b, jc) * 1024 + lanep * 16); wa[jj] = up[0]; wc_[jj] = up[1]; }
#pragma unroll
                for (int jj = 0; jj < 16; ++jj) { const int j = pos - 8 + jj; const unsigned msk = (j >= wlo && j < whi) ? 0xffffffffu : 0u;
                    const u32x4 a = wa[jj] & msk, c = wc_[jj] & msk;
                        s[0] += bf_lo(a.x); s[1] += bf_hi(a.x); s[2] += bf_lo(a.y); s[3] += bf_hi(a.y); s[4] += bf_lo(a.z); s[5] += bf_hi(a.z); s[6] += bf_lo(a.w); s[7] += bf_hi(a.w);
                        s[8] += bf_lo(c.x); s[9] += bf_hi(c.x); s[10] += bf_lo(c.y); s[11] += bf_hi(c.y); s[12] += bf_lo(c.z); s[13] += bf_hi(c.z); s[14] += bf_lo(c.w); s[15] += bf_hi(c.w); }
                const float rc = 1.0f / (float)(whi - wlo);
                const u32x4* up = (const u32x4*)(UB + (size_t)r * 1024 + lanep * 16); const u32x4 a = up[0], c = up[1];
                const float uv[16] = {bf_lo(a.x), bf_hi(a.x), bf_lo(a.y), bf_hi(a.y), bf_lo(a.z), bf_hi(a.z), bf_lo(a.w), bf_hi(a.w), bf_lo(c.x), bf_hi(c.x), bf_lo(c.y), bf_hi(c.y), bf_lo(c.z), bf_hi(c.z), bf_lo(c.w), bf_hi(c.w)};
                u32x4 o0, o1;
                o0.x = cvt_pk_bf16(s[0] * rc - uv[0], s[1] * rc - uv[1]); o0.y = cvt_pk_bf16(s[2] * rc - uv[2], s[3] * rc - uv[3]); o0.z = cvt_pk_bf16(s[4] * rc - uv[4], s[5] * rc - uv[5]); o0.w = cvt_pk_bf16(s[6] * rc - uv[6], s[7] * rc - uv[7]);
                o1.x = cvt_pk_bf16(s[8] * rc - uv[8], s[9] * rc - uv[9]); o1.y = cvt_pk_bf16(s[10] * rc - uv[10], s[11] * rc - uv[11]); o1.z = cvt_pk_bf16(s[12] * rc - uv[12], s[13] * rc - uv[13]); o1.w = cvt_pk_bf16(s[14] * rc - uv[14], s[15] * rc - uv[15]);
                u32x4* mp = (u32x4*)(MB + (size_t)r * 1024 + lanep * 16); mp[0] = o0; mp[1] = o1; }
            const float linit = layer == 0 ? 0.2f : (0.8f - 0.6f * 0.74081822068171788f);
            const float d1 = wave_sum(lam_q1[layer * 64 + lanep] * lam_k1[layer * 64 + lanep], lanep), d2 = wave_sum(lam_q2[layer * 64 + lanep] * lam_k2[layer * 64 + lanep], lanep);
            att::AttnArgs P{QB, KB, VB, QB, subln + layer * 128, expf(d1) - expf(d2) + linit, 1.0f - linit};
            __syncthreads();
#pragma unroll 1
            for (int rep = 0; rep < MK_REP_ATT; ++rep) {
            P.A = (rep + 1 < MK_REP_ATT) ? (bf16_t*)(wsp + WS_H + ZSTEP) : QB;
            const int nm = split ? (vcu < 128 ? 1 : 0) : 0, xlim = (layer == 0 && !split) ? 1152 : 1024;
            for (int it = 0; ; ++it) { int id; if (it < nm) id = 1024 + vcu; else { id = vcu + (it - nm) * Gp; if (id >= xlim) break; }
                const int bh = id < 1024 ? (id >> 3) : (id - 1024); int qb = id < 1024 ? (id & 7) : 8; asm volatile("" : "+s"(qb));
                att::attn_unit(P, bh >> 3, bh & 7, qb, lds);
            } }
            SEAM(pb + 1);
        }
        if (IN(pb + 2)) { PHASE_LOCALS;
            SchedY S; S.o.init(layer == 0 ? NPAN : NPAN - 1, DM / 256, Gp, bx); S.A0 = (const char*)QB; S.A1 = (const char*)MB; S.B0 = (const char*)(WBA + (size_t)layer * DM * AW); S.B1 = (const char*)(WC + (size_t)layer * DM * 1024);
            EpiY E{YB, GB};
#pragma unroll 1
            for (int rep = 0; rep < MK_REP_P3; ++rep) {
            pg8::gemm_phase<EpiY, SchedY, false>(lds, 1024 / 64, 1024 * 2, 1024 * 2, S, E);
            SEAM(pb + 2); }
        }
        if (IN(pb + 3)) { PHASE_LOCALS;
            SchedPlain S; S.o.init(layer == 0 ? NPAN : NPAN - 1, DM / 256, Gp, bx); S.A = (const char*)YB; S.B = (const char*)(WOUT + (size_t)layer * DM * DM); S.astep = (size_t)256 * DM * 2; S.bstep = (size_t)256 * DM * 2;
            EpiDelta E{GB, 1.f};
            pg8::gemm_phase<EpiDelta, SchedPlain, false>(lds, DM / 64, DM * 2, DM * 2, S, E);
            SEAM(pb + 3);
        }
        if (IN(pb + 4)) { PHASE_LOCALS;
            if (layer == 1) {
                for (int i = vcu * NWAVES * 64 + tidp; i < MOE_MAXROWS; i += NGT) { ROWL[i] = -1; ROWW[i] = 0.f; } }
            const int R2 = layer == 0 ? T : TX;
            LAS int* lcnt = (LAS int*)lds; LAS int* lrec = (LAS int*)lds + 16;
            int nit = 0;
            const int nitmax = (R2 + 2 * NGW - 1) / (2 * NGW);
            LAS f32x4* lrt = (LAS f32x4*)(lds + 4096);
            if (layer == 1) { if (tidp < 16) lcnt[tidp] = 0; for (int i = tidp; i < nitmax * 16; i += NWAVES * 64) lrec[4 * i] = -1;
                for (int u = tidp; u < 4096; u += NWAVES * 64) { const int l32_ = u & 31, half = (u >> 5) & 1, q = (u >> 6) & 3, j = u >> 8;
                    lrt[u] = *(const f32x4*)(router + (size_t)(4 * (l32_ + 32 * j) + q) * 8 + 4 * half); }
                __syncthreads(); }
            for (int r0 = gw; r0 < R2; r0 += 2 * NGW, ++nit) { const int rr = r0 + (lanep >> 5) * NGW; const bool valid = rr < R2; const int r = valid ? rr : r0; const int l32 = lanep & 31;
                f32x4 v[16]; float rstd;
#if MK_HRES16
                if (layer == 0) {
                    const f32x4* xr = (const f32x4*)EMB_ROW(r) + l32;
#pragma unroll
                    for (int j = 0; j < 16; ++j) v[j] = xr[32 * j]; }
                else { u32x2 s_[16];
#pragma unroll
                    for (int j = 0; j < 16; ++j) s_[j] = ((const u32x2*)(HRES16 + (size_t)r * DM))[l32 + 32 * j];
#pragma unroll
                    for (int j = 0; j < 16; ++j) { const u32x2 q = s_[j]; v[j].x = bf_lo(q.x); v[j].y = bf_hi(q.x); v[j].z = bf_lo(q.y); v[j].w = bf_hi(q.y); } }
                norm_row2<true, false, false, true, true>(nullptr, HRES16 + (size_t)r * DM, norm_ffn + layer * DM, nullptr, lanep, valid, v, rstd, GB + (size_t)r * DM);
#else
                const float* hsrc = layer == 0 ? EMB_ROW(r) : HRES + (size_t)r * DM;
                norm_row2<true, false>(hsrc, HRES + (size_t)r * DM, norm_ffn + layer * DM, (layer == 0 && !MK_F8_DENSE) ? H + (size_t)r * DM : nullptr, lanep, valid, v, rstd, GB + (size_t)r * DM);
#endif
                if ((layer == 1 || MK_F8_DENSE) && valid) {
                    unsigned* o4 = (unsigned*)((unsigned char*)H + (size_t)r * DM) + l32;
#pragma unroll
                    for (int j = 0; j < 16; ++j) o4[32 * j] = cvt4_fp8(v[j].x * F8_SA, v[j].y * F8_SA, v[j].z * F8_SA, v[j].w * F8_SA); }
                if (layer == 1) {
                    float lg[8];
#pragma unroll
                    for (int e = 0; e < 8; ++e) lg[e] = 0.f;
#pragma unroll
                    for (int j = 0; j < 16; ++j) {
#pragma unroll
                        for (int q = 0; q < 4; ++q) { const f32x4 ra = lrt[((j * 4 + q) * 2 + 0) * 32 + l32], rb = lrt[((j * 4 + q) * 2 + 1) * 32 + l32]; const float hv = v[j][q];
                            lg[0] += hv * ra.x; lg[1] += hv * ra.y; lg[2] += hv * ra.z; lg[3] += hv * ra.w; lg[4] += hv * rb.x; lg[5] += hv * rb.y; lg[6] += hv * rb.z; lg[7] += hv * rb.w; } }
#pragma unroll
                    for (int e = 0; e < 8; ++e) lg[e] = half_sum(lg[e], lanep);
                    if (l32 == 0 && !valid) lrec[4 * (nit * 16 + wave * 2 + (lanep >> 5))] = -1;
                    if (l32 == 0 && valid) { int e1 = 0; float v1 = lg[0];
#pragma unroll
                        for (int e = 1; e < 8; ++e) if (lg[e] > v1) { v1 = lg[e]; e1 = e; }
                        int e2 = -1; float v2 = -INFINITY;
#pragma unroll
                        for (int e = 0; e < 8; ++e) if (e != e1 && lg[e] > v2) { v2 = lg[e]; e2 = e; }
                        if (e2 < 0) e2 = (e1 + 1) & 7;
                        const float w1 = 1.0f / (1.0f + expf(v2 - v1)), w2 = 1.0f - w1;
                        const int s1 = __hip_atomic_fetch_add(lcnt + e1, 1, __ATOMIC_RELAXED, __HIP_MEMORY_SCOPE_WORKGROUP), s2 = __hip_atomic_fetch_add(lcnt + e2, 1, __ATOMIC_RELAXED, __HIP_MEMORY_SCOPE_WORKGROUP);
                        LAS int* rc = lrec + 4 * (nit * 16 + wave * 2 + (lanep >> 5)); rc[0] = r; rc[1] = e1 | (e2 << 8); rc[2] = s1; rc[3] = s2;
                        TOKE[r] = e1; TOKE[T + r] = e2; TOKW[r] = w1; TOKW[T + r] = w2; }
                }
            }
            if (layer == 1) {
                __syncthreads();
                if (tidp < 8) lcnt[8 + tidp] = (int)atomicAdd(CNT + tidp, (unsigned)lcnt[tidp]);
                __syncthreads();
                for (int i = tidp; i < nitmax * 16; i += NWAVES * 64) { const int r = lrec[4 * i];
                    if (r >= 0) { const int ee = lrec[4 * i + 1]; TOKS[r] = lcnt[8 + (ee & 255)] + lrec[4 * i + 2]; TOKS[T + r] = lcnt[8 + (ee >> 8)] + lrec[4 * i + 3]; } }
                __syncthreads();
            }
            SEAM(pb + 4);
        }
        if (layer == 0) {
            if (IN(6)) { PHASE_LOCALS;
                SchedPlain S; S.o.init(NPAN, NHID2 / 256, Gp, bx); S.A = (const char*)H; S.B = (const char*)DWGU; S.astep = (size_t)256 * DM * 2; S.bstep = (size_t)256 * DM * 2;
#if MK_F8_DENSE
                S.astep = (size_t)256 * DM; S.bstep = (size_t)256 * DM;
                EpiSwi8 E{(unsigned char*)HID};
                pg8::gemm_phase<EpiSwi8, SchedPlain, false, true>(lds, DM / 128, DM, DM, S, E);
                SEAM(6);
#else
                EpiSwi E{HID};
#pragma unroll 1
                for (int rep = 0; rep < MK_REP_P5; ++rep) {
                pg8::gemm_phase<EpiSwi, SchedPlain, false>(lds, DM / 64, DM * 2, DM * 2, S, E);
                SEAM(6); }
#endif
            }
            if (IN(7)) { PHASE_LOCALS;
                SchedPlain S; S.o.init(NPAN, DM / 256, Gp, bx); S.A = (const char*)HID; S.B = (const char*)DWD; S.astep = (size_t)256 * DFF * 2; S.bstep = (size_t)256 * DFF * 2;
#if MK_F8_DENSE
                S.astep = (size_t)256 * DFF; S.bstep = (size_t)256 * DFF;
                EpiDelta E{H, 1.0f / (F8_SH * F8_SW)};
                pg8::gemm_phase<EpiDelta, SchedPlain, false, true>(lds, DFF / 128, DFF, DFF, S, E);
                SEAM(7);
#else
#pragma unroll 1
                for (int rep = 0; rep < MK_REP_P6; ++rep) {
                EpiRes E{HRES, (rep + 1 < MK_REP_P6) ? 0.f : 1.f};
                pg8::gemm_phase<EpiRes, SchedPlain, false>(lds, DFF / 64, DFF * 2, DFF * 2, S, E);
                SEAM(7); }
#endif
            }
            if (IN(8)) { PHASE_LOCALS;
#pragma unroll 1
                for (int rep = 0; rep < MK_REP_N1; ++rep) {
                for (int r0 = gw; r0 < T; r0 += 2 * NGW) { const int rr = r0 + (lanep >> 5) * NGW; const bool valid = rr < T; const int r = valid ? rr : r0;
                    f32x4 v[16]; float rstd;
#if MK_HRES16
                    norm_row2<true, false, true, true>(HRES16 + (size_t)r * DM, HRES16 + (size_t)r * DM, norm_mix + DM, H + (size_t)r * DM, lanep, valid, v, rstd, H + (size_t)r * DM);
#else
                    norm_row2<MK_F8_DENSE != 0, false>(HRES + (size_t)r * DM, HRES + (size_t)r * DM, norm_mix + DM, H + (size_t)r * DM, lanep, valid, v, rstd, H + (size_t)r * DM);
#endif
                    if (valid && r < TX) { unsigned* o4 = (unsigned*)(H8P + (size_t)r * DM) + (lanep & 31);
#pragma unroll
                        for (int j = 0; j < 16; ++j) o4[32 * j] = cvt4_fp8(v[j].x * F8_SA, v[j].y * F8_SA, v[j].z * F8_SA, v[j].w * F8_SA); } }
                SEAM(8); }
            }
        } else {
            MoeMap mm; int rb[9];
            { unsigned char* wsp = (unsigned char*)(GAS unsigned char*)args.ws; int p = 0;
#pragma unroll
              for (int e = 0; e < 8; ++e) { const int c = (int)__hip_atomic_load(CNT + e, __ATOMIC_RELAXED, __HIP_MEMORY_SCOPE_AGENT); mm.pb[e] = p; rb[e] = p * 256; p = min(p + ((c + 255) >> 8), MOE_MAXPAN); }
              mm.pb[8] = p; rb[8] = p * 256; }
            if (IN(14)) { PHASE_LOCALS;
                for (int i = gw * 4 + (lanep >> 4); i < 2 * TX; i += NGW * 4) {
                    const int k = i >= TX ? 1 : 0, tok = i - k * TX; const int e = TOKE[k * T + tok], s = TOKS[k * T + tok];
                    int base = 0;
#pragma unroll
                    for (int j = 0; j < 8; ++j) base = (j == e) ? rb[j] : base;
                    if (e >= 0 && e < 8 && s >= 0 && base + s < MOE_MAXROWS) { const int pos = base + s; const int l16 = lanep & 15;
                        if (l16 == 0) { ROWL[pos] = tok | (k << 30); ROWW[pos] = TOKW[k * T + tok]; }
                        const u32x4* src = (const u32x4*)((const unsigned char*)H + (size_t)tok * DM) + l16; u32x4* dst = (u32x4*)(wsp + WS_H8S + (size_t)pos * DM) + l16;
                        u32x4 t[8];
#pragma unroll
                        for (int j = 0; j < 8; ++j) t[j] = src[16 * j];
#pragma unroll
                        for (int j = 0; j < 8; ++j) dst[16 * j] = t[j]; } }
                SEAM(14);
            }
            if (IN(15)) { PHASE_LOCALS;
                SchedMoeUp S; S.o.init(mm.pb[8], NHID2 / 256, Gp, bx); S.A = (const char*)(wsp + WS_H8S); S.B = (const char*)MWGU; S.mm = mm;
                EpiSwi8 E{(unsigned char*)HID};
                pg8::gemm_phase<EpiSwi8, SchedMoeUp, false, true>(lds, DM / 128, DM, DM, S, E);
                SEAM(15);
            }
            if (IN(16)) { PHASE_LOCALS;
                SchedMoeDown S; S.o.init(mm.pb[8], DM / 256, Gp, bx, 1); S.A = (const char*)HID; S.B = (const char*)MWD; S.mm = mm;
                EpiMoeDown E{(bf16_t*)(wsp + WS_OUT2A), (bf16_t*)(wsp + WS_OUT2B), ROWL, ROWW, 1.0f / (F8_SH * F8_SW)};
                pg8::gemm_phase<EpiMoeDown, SchedMoeDown, false, true>(lds, DFF / 128, DFF, DFF, S, E);
                SEAM(16);
            }
            if (IN(17)) { PHASE_LOCALS;
                for (int r0 = gw; r0 < TX; r0 += 2 * NGW) { const int rr = r0 + (lanep >> 5) * NGW; const bool valid = rr < TX; const int r = valid ? rr : r0;
                    f32x4 v[16]; float rstd; norm_row2<true, true, MK_HRES16 != 0, false>(MK_HRES16 ? (const void*)(HRES16 + (size_t)r * DM) : (const void*)(HRES + (size_t)r * DM), nullptr, norm_final, nullptr, lanep, valid, v, rstd, (const bf16_t*)(wsp + WS_OUT2A) + (size_t)r * DM, (const bf16_t*)(wsp + WS_OUT2B) + (size_t)r * DM);
                    if (valid) { f32x4* op = (f32x4*)((float*)(GAS float*)args.out + (size_t)r * DM) + (lanep & 31);
#pragma unroll
                        for (int j = 0; j < 16; ++j) op[32 * j] = v[j]; } }
            }
        }
    }
    if (MK_PROBE_BUF != 0 && IN(20)) { PHASE_LOCALS;
        for (int r = gw; r < TX; r += NGW) {
            float* op = (float*)(GAS float*)args.out + (size_t)r * DM; const int rs = MK_PROBE_META ? TX + (r & 255) : r;
            for (int c = lanep; c < DM; c += 64) { bf16_t v;
                if (MK_PROBE_BUF == 1) v = c < 1024 ? QB[(size_t)rs * 1024 + c] : KB[(size_t)rs * 1024 + c - 1024];
                else if (MK_PROBE_BUF == 2) v = c < 1024 ? VB[(size_t)rs * 1024 + c] : UB[(size_t)rs * 1024 + c - 1024];
                else if (MK_PROBE_BUF == 3) v = GB[(size_t)rs * 4096 + c];
                else if (MK_PROBE_BUF == 4) v = GB[(size_t)rs * 4096 + 2048 + c];
                else if (MK_PROBE_BUF == 5) v = c < 1024 ? QB[(size_t)rs * 1024 + c] : MB[(size_t)rs * 1024 + c - 1024];
                else if (MK_PROBE_BUF == 7) v = c < 1024 ? QB[(size_t)rs * 1024 + c] : (bf16_t)0;
                else if (MK_PROBE_BUF == 8) v = c < 1024 ? MB[(size_t)rs * 1024 + c] : (bf16_t)0;
                else v = YB[(size_t)rs * 2048 + c];
                float fv = __uint_as_float((unsigned)v << 16); if (!(fabsf(fv) < 1e30f)) fv = 12345.0f;
                op[c] = fv; } }
    }
#undef IN
#undef SEAM
#undef PHASE_LOCALS
}

extern "C" void kernel_launch(void* const* d_in, const int* in_sizes, int n_in, void* d_out, int out_size, void* d_ws, size_t ws_size, hipStream_t stream) {
    static int grid = 0;
    if (grid == 0) {
        if (n_in != 24 || out_size != TX * DM || ws_size < WS_END) { fprintf(stderr, "kernel_launch: unexpected shapes (n_in %d, out %d, ws %zu < %zu)\n", n_in, out_size, ws_size, (size_t)WS_END); grid = -1; return; }
        int dev = 0, cus = 0;
        if (hipGetDevice(&dev) != hipSuccess || hipDeviceGetAttribute(&cus, hipDeviceAttributeMultiprocessorCount, dev) != hipSuccess) { grid = -1; return; }
        if (hipFuncSetAttribute((const void*)fwd_kernel, hipFuncAttributeMaxDynamicSharedMemorySize, LDS_BYTES) != hipSuccess) { fprintf(stderr, "kernel_launch: hipFuncSetAttribute failed\n"); grid = -1; return; }
        int per_cu = 0;
        if (hipOccupancyMaxActiveBlocksPerMultiprocessor(&per_cu, (const void*)fwd_kernel, NWAVES * 64, LDS_BYTES) != hipSuccess || per_cu < 1) fprintf(stderr, "kernel_launch: occupancy query reports %d\n", per_cu);
        (void)hipGetLastError();
        grid = cus;
    }
    if (grid < 0) return;
    (void)hipMemsetAsync((char*)d_ws + WS_CTL, 0, CTL_ZERO_BYTES, stream);
    Args a{};
    for (int i = 0; i < 24; ++i) a.in[i] = (const float*)d_in[i];
    a.out = (float*)d_out; a.ws = (unsigned char*)d_ws;
#if MK_ONE_LAUNCH
    a.ph_lo = 0; a.ph_hi = NPHASE;
    hipLaunchKernelGGL(fwd_kernel, dim3(grid), dim3(NWAVES * 64), LDS_BYTES, stream, a);
#else
    for (int p = 0; p <= MK_LAST_PHASE; ++p) { a.ph_lo = p; a.ph_hi = p + 1; hipLaunchKernelGGL(fwd_kernel, dim3(grid), dim3(NWAVES * 64), LDS_BYTES, stream, a); }
    if (MK_PROBE_BUF != 0) { a.ph_lo = 20; a.ph_hi = 21; hipLaunchKernelGGL(fwd_kernel, dim3(grid), dim3(NWAVES * 64), LDS_BYTES, stream, a); }
    else if (MK_LAST_PHASE < 17) { a.ph_lo = 17; a.ph_hi = 18; hipLaunchKernelGGL(fwd_kernel, dim3(grid), dim3(NWAVES * 64), LDS_BYTES, stream, a); }
#endif
}
```
